# Optimizing an MI355X kernel written in HIP

```python
import jax, jax.numpy as jnp
from jax import lax
import numpy as np

D_MODEL = 2048
BATCH = 1
SEQ = 16384
DEPTH = 4

N_BRANCH = 4
BRANCH_WIDTH = D_MODEL // 2
HEAD_DIM = 128
HG_HEADS = BRANCH_WIDTH // HEAD_DIM
HG_CHUNK = 64
LRU_HEADS = 8
LRU_BLOCK = BRANCH_WIDTH // LRU_HEADS
LRU_CONV = 4
LRU_C = 8.0
POOL_WINDOWS = (2, 4, 8, 16)
POOL_GROUP = BRANCH_WIDTH // len(POOL_WINDOWS)
ATTN_HEADS = BRANCH_WIDTH // HEAD_DIM
DILATED = ((128, 1), (512, 4), (2048, 16))
ROPE_THETA = 10000.0
NEG_BIG = -1e30
D_FF = ((8 * D_MODEL // 3) + 127) // 128 * 128
FFN_CONV = 3
RMS_EPS = 1e-6
IN_SIZES = (BRANCH_WIDTH,) * 5 + (BRANCH_WIDTH,) * 2 + (BRANCH_WIDTH,) + (3 * BRANCH_WIDTH,) + (N_BRANCH * D_MODEL,)
N_IN = sum(IN_SIZES)

kernel_name = 'hybrid_gated_parallel_mixer_encoder'


def _rmsnorm(x, g):
    xf = x.astype(jnp.float32)
    y = xf * lax.rsqrt(jnp.mean(xf * xf, axis=-1, keepdims=True) + RMS_EPS)
    return (y * g.astype(jnp.float32)).astype(x.dtype)


def _rotary(t, positions):
    half = HEAD_DIM // 2
    inv_freq = ROPE_THETA ** (-jnp.arange(half, dtype=jnp.float32) / half)
    ang = positions.astype(jnp.float32)[..., None] * inv_freq
    cos = jnp.cos(ang)[:, :, None, :]
    sin = jnp.sin(ang)[:, :, None, :]
    t1 = t[..., :half].astype(jnp.float32)
    t2 = t[..., half:].astype(jnp.float32)
    return jnp.concatenate([t1 * cos - t2 * sin, t2 * cos + t1 * sin], axis=-1).astype(t.dtype)


def _hgrn2(q, f_fwd, f_bwd, i, g, lb, onorm_g):
    B, S, W = q.shape
    f32 = jnp.float32
    q = jax.nn.silu(q.astype(f32))
    i = i.astype(f32)
    zf = jnp.stack([f_fwd, f_bwd[:, ::-1]], axis=1).astype(f32)
    lbd = lb.astype(f32)[None, :, None, :]
    f = lbd + (1.0 - lbd) * jax.nn.sigmoid(zf)
    log_f = jnp.log(f)
    k = 1.0 - f
    qd = jnp.stack([q, q[:, ::-1]], axis=1)
    idir = jnp.stack([i, i[:, ::-1]], axis=1)
    nc = S // HG_CHUNK

    def chunked(t):
        return t.reshape(B, 2, nc, HG_CHUNK, HG_HEADS, HEAD_DIM).transpose(2, 0, 1, 4, 3, 5)

    tri = jnp.tril(jnp.ones((HG_CHUNK, HG_CHUNK), dtype=bool))

    def step(state, inp):
        qc, kc, ic, lfc = inp
        b = jnp.cumsum(lfc, axis=-2)
        o_inter = jnp.einsum('bdhtk,bdhkv->bdhtv', qc * jnp.exp(b), state)
        diff = b[..., :, None, :] - b[..., None, :, :]
        decay = jnp.exp(jnp.where(tri[:, :, None], diff, -jnp.inf))
        scores = jnp.einsum('bdhtk,bdhsk,bdhtsk->bdhts', qc, kc, decay)
        o_intra = jnp.einsum('bdhts,bdhsv->bdhtv', scores, ic)
        b_last = b[..., -1:, :]
        state = (jnp.exp(b_last[..., 0, :])[..., None] * state
                 + jnp.einsum('bdhsk,bdhsv->bdhkv', kc * jnp.exp(b_last - b), ic))
        return state, o_inter + o_intra

    s0 = jnp.zeros((B, 2, HG_HEADS, HEAD_DIM, HEAD_DIM), f32)
    _, o = lax.scan(step, s0, (chunked(qd), chunked(k), chunked(idir), chunked(log_f)))
    o = o.transpose(1, 2, 0, 4, 3, 5).reshape(B, 2, S, HG_HEADS, HEAD_DIM)
    o = o[:, 0] + o[:, 1, ::-1]
    o = o * lax.rsqrt(jnp.mean(o * o, axis=-1, keepdims=True) + RMS_EPS)
    o = o.reshape(B, S, W) * onorm_g.astype(f32) * jax.nn.silu(g.astype(f32))
    return o.astype(g.dtype)


def _rglru(xb, gb, conv_w, conv_b, wa, ba, wx, bx, lam):
    B, S, W = xb.shape
    f32 = jnp.float32
    xd = jnp.stack([xb, xb[:, ::-1]], axis=1).astype(f32)
    xp = jnp.pad(xd, ((0, 0), (0, 0), (LRU_CONV - 1, 0), (0, 0)))
    xc = conv_b.astype(f32)[None, :, None, :] + sum(
        xp[:, :, j:j + S, :] * conv_w[:, j].astype(f32)[None, :, None, :] for j in range(LRU_CONV))
    xh = xc.reshape(B, 2, S, LRU_HEADS, LRU_BLOCK)
    r = jax.nn.sigmoid(jnp.einsum('bdshi,dhij->bdshj', xh, wa.astype(f32)).reshape(B, 2, S, W)
                       + ba.astype(f32)[None, :, None, :])
    ig = jax.nn.sigmoid(jnp.einsum('bdshi,dhij->bdshj', xh, wx.astype(f32)).reshape(B, 2, S, W)
                        + bx.astype(f32)[None, :, None, :])
    log_a = -LRU_C * r * jax.nn.softplus(-lam.astype(f32))[None, :, None, :]
    a = jnp.exp(log_a)
    u = jnp.sqrt(-jnp.expm1(2.0 * log_a)) * (ig * xc)

    def combine(left, right):
        a1, b1 = left
        a2, b2 = right
        return a1 * a2, a2 * b1 + b2

    _, h = lax.associative_scan(combine, (a, u), axis=2)
    y = h[:, 0] + h[:, 1, ::-1]
    return (y * jax.nn.gelu(gb.astype(f32))).astype(gb.dtype)


def _pool_mixer(xp, pool_w, pool_scale):
    B, S, W = xp.shape
    xf = xp.astype(jnp.float32)
    prefix = jnp.concatenate([jnp.zeros((B, 1, W), jnp.float32), jnp.cumsum(xf, axis=1)], axis=1)
    t = jnp.arange(S)
    outs = []
    for gi, w in enumerate(POOL_WINDOWS):
        lo = jnp.clip(t - w // 2, 0, S)
        hi = jnp.clip(t + w // 2, 0, S)
        sl = slice(gi * POOL_GROUP, (gi + 1) * POOL_GROUP)
        pg = prefix[:, :, sl]
        wsum = jnp.take(pg, hi, axis=1) - jnp.take(pg, lo, axis=1)
        cnt = (hi - lo).astype(jnp.float32)[None, :, None]
        d = wsum / cnt - xf[:, :, sl]
        outs.append(d @ pool_w[gi].astype(jnp.float32))
    y = jnp.concatenate(outs, axis=-1) * pool_scale.astype(jnp.float32)
    return y.astype(xp.dtype)


def _band_attention(q, k, v, half):
    N, L, hd = q.shape
    blk = half
    nb = -(-L // blk)
    lp = nb * blk
    qb = jnp.pad(q, ((0, 0), (0, lp - L), (0, 0))).reshape(N, nb, blk, hd)

    def windows(t):
        tp = jnp.pad(t, ((0, 0), (blk, lp - L + blk), (0, 0))).reshape(N, nb + 2, blk, hd)
        return jnp.concatenate([tp[:, :-2], tp[:, 1:-1], tp[:, 2:]], axis=2)

    kw = windows(k)
    vw = windows(v)
    s = jnp.einsum('nbqd,nbkd->nbqk', qb, kw).astype(jnp.float32)
    kj = jnp.arange(3 * blk)
    rel = kj[None, :] - blk - jnp.arange(blk)[:, None]
    key_abs = jnp.arange(nb)[:, None, None] * blk - blk + kj[None, None, :]
    valid = (jnp.abs(rel) <= half)[None] & (key_abs >= 0) & (key_abs < L)
    s = jnp.where(valid[None], s, NEG_BIG)
    m = jnp.max(s, axis=-1)
    p = jnp.exp(s - m[..., None])
    l = jnp.sum(p, axis=-1)
    acc = jnp.einsum('nbqk,nbkd->nbqd', p.astype(v.dtype), vw).astype(jnp.float32)
    return (acc.reshape(N, lp, hd)[:, :L], m.reshape(N, lp)[:, :L], l.reshape(N, lp)[:, :L])


def _dilated_group(q, k, v, window, dil):
    B, S, H, hd = q.shape
    L = S // dil

    def to_strided(t):
        return t.reshape(B, L, dil, H, hd).transpose(0, 2, 3, 1, 4).reshape(B * dil * H, L, hd)

    acc, m, l = _band_attention(to_strided(q), to_strided(k), to_strided(v), window // (2 * dil))
    acc = acc.reshape(B, dil, H, L, hd).transpose(0, 3, 1, 2, 4).reshape(B, S, H, hd)
    m = m.reshape(B, dil, H, L).transpose(0, 3, 1, 2).reshape(B, S, H)
    l = l.reshape(B, dil, H, L).transpose(0, 3, 1, 2).reshape(B, S, H)
    return acc, m, l


def _dilated_attention(qkv, positions):
    B, S, _ = qkv.shape
    q, k, v = jnp.split(qkv, 3, axis=-1)
    q = q.reshape(B, S, ATTN_HEADS, HEAD_DIM)
    k = k.reshape(B, S, ATTN_HEADS, HEAD_DIM)
    v = v.reshape(B, S, ATTN_HEADS, HEAD_DIM)
    q = _rotary(q, positions) * (HEAD_DIM ** -0.5)
    k = _rotary(k, positions)
    parts = [_dilated_group(q, k, v, w, d) for (w, d) in DILATED]
    m_all = jnp.stack([p[1] for p in parts])
    l_all = jnp.stack([p[2] for p in parts])
    wts = jnp.exp(m_all - jnp.max(m_all, axis=0, keepdims=True))
    den = jnp.sum(wts * l_all, axis=0)
    num = sum(wts[gi][..., None] * parts[gi][0] for gi in range(len(DILATED)))
    o = num / den[..., None]
    return o.reshape(B, S, BRANCH_WIDTH).astype(qkv.dtype)


def _mixer_block(h, positions, w_in, lb, onorm_g, conv_w, conv_b, wa, ba, wx, bx, lam,
                 pool_w, pool_scale, w_branch, w_out):
    B, S, _ = h.shape
    z = h @ w_in
    split_at = np.cumsum(IN_SIZES)[:-1].tolist()
    (hg_q, hg_ff, hg_fb, hg_i, hg_g, lru_x, lru_g, pool_in, attn_qkv, gate_logits) = jnp.split(z, split_at, axis=-1)
    branches = (
        _hgrn2(hg_q, hg_ff, hg_fb, hg_i, hg_g, lb, onorm_g),
        _rglru(lru_x, lru_g, conv_w, conv_b, wa, ba, wx, bx, lam),
        _pool_mixer(pool_in, pool_w, pool_scale),
        _dilated_attention(attn_qkv, positions),
    )
    gates = jax.nn.sigmoid(gate_logits.reshape(B, S, N_BRANCH, D_MODEL))
    merged = sum(gates[:, :, gi, :] * (branches[gi] @ w_branch[gi]) for gi in range(N_BRANCH))
    return merged @ w_out


def _conv_ffn(h, up, cw, cb, down):
    S = h.shape[1]
    u = h @ up
    pad = FFN_CONV // 2
    up_pad = jnp.pad(u, ((0, 0), (pad, pad), (0, 0)))
    uc = cb + sum(up_pad[:, j:j + S, :] * cw[j] for j in range(FFN_CONV))
    gate, val = jnp.split(uc, 2, axis=-1)
    return (jax.nn.silu(gate) * val) @ down


def setup_inputs(seed: int = 0) -> dict:
    key = jax.random.key(seed)
    ks = jax.random.split(key, 24)
    f32 = jnp.float32
    bw = BRANCH_WIDTH

    def nrm(k, shape, scale):
        return jax.random.normal(k, shape, f32) * scale

    x = nrm(ks[0], (BATCH, SEQ, D_MODEL), 1.0)
    c = nrm(ks[1], (BATCH, D_MODEL), 1.0)
    offset = jax.random.randint(ks[2], (BATCH, 1), 0, 1024, dtype=jnp.int32)
    positions = offset + jnp.arange(SEQ, dtype=jnp.int32)[None, :]
    ada_w = nrm(ks[3], (DEPTH, D_MODEL, 6 * D_MODEL), 0.5 * D_MODEL ** -0.5)
    ada_b = nrm(ks[4], (DEPTH, 6 * D_MODEL), 0.02)
    norm_g = 1.0 + nrm(ks[5], (DEPTH, 4, D_MODEL), 0.1)
    w_in = nrm(ks[6], (DEPTH, D_MODEL, N_IN), D_MODEL ** -0.5)
    hgrn_lb = nrm(ks[7], (DEPTH, 2, bw), 0.1)
    hgrn_onorm = 1.0 + nrm(ks[8], (DEPTH, bw), 0.1)
    lru_conv_w = nrm(ks[9], (DEPTH, 2, LRU_CONV, bw), LRU_CONV ** -0.5)
    lru_conv_b = nrm(ks[10], (DEPTH, 2, bw), 0.02)
    lru_wa = nrm(ks[11], (DEPTH, 2, LRU_HEADS, LRU_BLOCK, LRU_BLOCK), LRU_BLOCK ** -0.5)
    lru_ba = nrm(ks[12], (DEPTH, 2, bw), 0.02)
    lru_wx = nrm(ks[13], (DEPTH, 2, LRU_HEADS, LRU_BLOCK, LRU_BLOCK), LRU_BLOCK ** -0.5)
    lru_bx = nrm(ks[14], (DEPTH, 2, bw), 0.02)
    a_c = jax.random.uniform(ks[15], (DEPTH, 2, bw), f32, 0.9, 0.999)
    a0 = a_c ** (1.0 / LRU_C)
    lru_lambda = jnp.log(a0) - jnp.log1p(-a0)
    pool_w = nrm(ks[16], (DEPTH, len(POOL_WINDOWS), POOL_GROUP, POOL_GROUP), POOL_GROUP ** -0.5)
    pool_scale = 1.0 + nrm(ks[17], (DEPTH, bw), 0.1)
    w_branch = nrm(ks[18], (DEPTH, N_BRANCH, bw, D_MODEL), bw ** -0.5)
    w_out = nrm(ks[19], (DEPTH, D_MODEL, D_MODEL), D_MODEL ** -0.5)
    ffn_up = nrm(ks[20], (DEPTH, D_MODEL, 2 * D_FF), D_MODEL ** -0.5)
    ffn_conv_w = nrm(ks[21], (DEPTH, FFN_CONV, 2 * D_FF), FFN_CONV ** -0.5)
    ffn_conv_b = nrm(ks[22], (DEPTH, 2 * D_FF), 0.02)
    ffn_down = nrm(ks[23], (DEPTH, D_FF, D_MODEL), D_FF ** -0.5)
    return {'x': x, 'c': c, 'positions': positions, 'ada_w': ada_w, 'ada_b': ada_b,
            'norm_g': norm_g, 'w_in': w_in, 'hgrn_lb': hgrn_lb, 'hgrn_onorm': hgrn_onorm,
            'lru_conv_w': lru_conv_w, 'lru_conv_b': lru_conv_b, 'lru_wa': lru_wa, 'lru_ba': lru_ba,
            'lru_wx': lru_wx, 'lru_bx': lru_bx, 'lru_lambda': lru_lambda, 'pool_w': pool_w,
            'pool_scale': pool_scale, 'w_branch': w_branch, 'w_out': w_out, 'ffn_up': ffn_up,
            'ffn_conv_w': ffn_conv_w, 'ffn_conv_b': ffn_conv_b, 'ffn_down': ffn_down}


def reference(x, c, positions, ada_w, ada_b, norm_g, w_in, hgrn_lb, hgrn_onorm,
              lru_conv_w, lru_conv_b, lru_wa, lru_ba, lru_wx, lru_bx, lru_lambda,
              pool_w, pool_scale, w_branch, w_out, ffn_up, ffn_conv_w, ffn_conv_b, ffn_down):
    lbw = jax.nn.softmax(hgrn_lb.astype(jnp.float32), axis=0)
    lb_all = jnp.cumsum(lbw, axis=0) - lbw[0:1]
    cond = jax.nn.silu(c)
    for layer in range(DEPTH):
        mod = cond @ ada_w[layer] + ada_b[layer]
        sh_a, sc_a, g_a, sh_f, sc_f, g_f = jnp.split(mod[:, None, :], 6, axis=-1)
        h = _rmsnorm(x, norm_g[layer, 0]) * (1.0 + sc_a) + sh_a
        y = _mixer_block(h, positions, w_in[layer], lb_all[layer], hgrn_onorm[layer],
                         lru_conv_w[layer], lru_conv_b[layer], lru_wa[layer], lru_ba[layer],
                         lru_wx[layer], lru_bx[layer], lru_lambda[layer],
                         pool_w[layer], pool_scale[layer], w_branch[layer], w_out[layer])
        x = x + g_a * _rmsnorm(y, norm_g[layer, 1])
        h = _rmsnorm(x, norm_g[layer, 2]) * (1.0 + sc_f) + sh_f
        y = _conv_ffn(h, ffn_up[layer], ffn_conv_w[layer], ffn_conv_b[layer], ffn_down[layer])
        x = x + g_f * _rmsnorm(y, norm_g[layer, 3])
    return x
```

```cpp
#include <hip/hip_runtime.h>
#include <cstdio>
#include <cstdint>
#ifndef MK_MULTI_LAUNCH
#define MK_MULTI_LAUNCH 0
#endif
#ifndef GATE_EXP
#define GATE_EXP 0
#endif
__device__ __forceinline__ int mk_lane_id() { int l; asm volatile("v_mbcnt_lo_u32_b32 %0, -1, 0\n\tv_mbcnt_hi_u32_b32 %0, -1, %0" : "=v"(l)); return l; }
#define GAS __attribute__((address_space(1)))
#define LAS __attribute__((address_space(3)))
namespace pg8 {
#define PG8_LAS __attribute__((address_space(3)))
typedef unsigned short bf16_t;
typedef short bf16x8 __attribute__((ext_vector_type(8)));
typedef float f32x4 __attribute__((ext_vector_type(4)));
typedef unsigned u32x4 __attribute__((ext_vector_type(4)));
constexpr int BM = 256, BK = 64, HALF = 128, HTB = HALF * BK * 2  , STAGE_BYTES = 8 * HTB, NXCD = 8, WGM = 8;

__host__ __device__ __forceinline__ int lds_byte(int r, int c) { const int st = (r >> 4) * 2 + (c >> 5), rr = r & 15, cc = c & 31, ob = rr * 64 + cc * 2; return st * 1024 + (ob ^ (((ob >> 9) & 1) << 5)); }
__host__ __device__ __forceinline__ void stage_rc(int b, int& R, int& C) { const int st = b / 1024, sb = b % 1024, swz = sb ^ (((sb >> 9) & 1) << 5); R = (st >> 1) * 16 + swz / 64; C = (st & 1) * 32 + (swz % 64) / 2; }
__host__ __device__ __forceinline__ int perm32(int rho) { const int n = rho >> 4, i = rho & 15; return 8 * (i >> 2) + 4 * n + (i & 3); }

struct Unit { int pm, pn; };
struct Gemm { const bf16_t* A; const bf16_t* Bt; int M, N, K; };

struct StaticOrder {
    int nM, nN, nwg, G, c;
    __host__ __device__ void init(int M, int N, int G_, int c_) { nM = M / BM; nN = N / BM; nwg = nM * nN; G = G_; c = c_; }
    __host__ __device__ bool next(int i, Unit& u) const {
        const long L = (long)i * G + c; if (L >= nwg) return false;
        int wgid = (int)L; { const int q = nwg / NXCD, r = nwg % NXCD, xcd = wgid % NXCD, off = wgid / NXCD; wgid = (xcd < r ? xcd * (q + 1) : r * (q + 1) + (xcd - r) * q) + off; }
        const int nig = WGM * nN, gid = wgid / nig, fm = gid * WGM, gsz = (nM - fm) < WGM ? (nM - fm) : WGM;
        u.pm = fm + ((wgid % nig) % gsz); u.pn = (wgid % nig) / gsz; return true;
    }
    __device__ __forceinline__ void a_ready(const Unit&) const {}
    __device__ __forceinline__ void done(const Unit&) const {}
};

typedef __bf16 bf16x2_t __attribute__((ext_vector_type(2)));
typedef float f32x2_t __attribute__((ext_vector_type(2)));
__device__ __forceinline__ unsigned cvt_pk_bf16(float lo, float hi) { const f32x2_t v = {lo, hi}; return __builtin_bit_cast(unsigned, __builtin_convertvector(v, bf16x2_t)); }

struct EpiBf16R {
    static constexpr bool PERM = true, AFTER_DRAIN = false, INPLACE = false;
    bf16_t* O; int ldc_seg; int tiles_per_seg; int nseg_tiles; size_t seg_stride; bf16_t* O2; int ldc2;
    __device__ __forceinline__ void operator()(const f32x4 (&acc)[2][2][4][2], const Unit& u, int wr, int wc, int fr, int fq) const {
        const int row0 = u.pm * BM + wr * 64 + fr; bf16_t* base; int ldc, colt;
        if (u.pn < nseg_tiles) { const int sg = u.pn / tiles_per_seg; base = O + (size_t)sg * seg_stride; ldc = ldc_seg; colt = (u.pn - sg * tiles_per_seg) * BM; }
        else { base = O2; ldc = ldc2; colt = (u.pn - nseg_tiles) * BM; }
        const int col0 = colt + wc * 32 + 8 * fq;
#pragma unroll
        for (int ai = 0; ai < 2; ++ai)
#pragma unroll
            for (int m = 0; m < 4; ++m) { bf16_t* rowp = base + (size_t)(row0 + ai * HALF + m * 16) * ldc + col0;
#pragma unroll
                for (int bj = 0; bj < 2; ++bj) { const f32x4 v0 = acc[ai][bj][m][0], v1 = acc[ai][bj][m][1];
                    u32x4 w; w.x = cvt_pk_bf16(v0[0], v0[1]); w.y = cvt_pk_bf16(v0[2], v0[3]); w.z = cvt_pk_bf16(v1[0], v1[1]); w.w = cvt_pk_bf16(v1[2], v1[3]);
                    *(u32x4*)(rowp + bj * HALF) = w; } }
    }
};
struct EpiZ8 {
    static constexpr bool PERM = true, AFTER_DRAIN = false, INPLACE = false;
    bf16_t* O; int ldc_seg; int tiles_per_seg; int nseg_tiles; size_t seg_stride; bf16_t* O2; int ldc2;
    __device__ __forceinline__ void operator()(const f32x4 (&acc)[2][2][4][2], const Unit& u, int wr, int wc, int fr, int fq) const {
        const int row0 = u.pm * BM + wr * 64 + fr; bf16_t* base; int ldc, colt;
        if (u.pn < nseg_tiles) { const int sg = u.pn / tiles_per_seg; base = O + (size_t)sg * seg_stride; ldc = ldc_seg; colt = (u.pn - sg * tiles_per_seg) * BM; }
        else { base = O2; ldc = ldc2; colt = (u.pn - nseg_tiles) * BM; }
        const int col0 = colt + wc * 32 + 8 * fq;
        if (u.pn >= nseg_tiles) {
            unsigned char* gb = (unsigned char*)O2;
#pragma unroll
            for (int ai = 0; ai < 2; ++ai)
#pragma unroll
                for (int m = 0; m < 4; ++m) { unsigned char* rowp = gb + (size_t)(u.pm * 32 + (u.pn - nseg_tiles)) * 65536 + (unsigned)(((wr * 4 + wc) * 64 + fq * 16 + fr) * 8);
#pragma unroll
                    for (int bj = 0; bj < 2; ++bj) { unsigned w2[2];
#pragma unroll
                        for (int hh = 0; hh < 2; ++hh) { const f32x4 v = acc[ai][bj][m][hh]; unsigned q = 0;
#pragma unroll
                            for (int j = 0; j < 4; ++j) q |= (unsigned)max((int)(255.0f * __builtin_amdgcn_rcpf(1.0f + __expf(-v[j])) + 0.5f), 1) << (8 * j);
                            w2[hh] = q; }
                        typedef unsigned u32x2 __attribute__((ext_vector_type(2))); u32x2 w; w.x = w2[0]; w.y = w2[1];
                        *(u32x2*)(rowp + ((ai * 4 + m) * 2 + bj) * 4096) = w; } }
            return; }
#pragma unroll
        for (int ai = 0; ai < 2; ++ai)
#pragma unroll
            for (int m = 0; m < 4; ++m) { bf16_t* rowp = base + (size_t)(row0 + ai * HALF + m * 16) * ldc + col0;
#pragma unroll
                for (int bj = 0; bj < 2; ++bj) { const f32x4 v0 = acc[ai][bj][m][0], v1 = acc[ai][bj][m][1];
                    u32x4 w; w.x = cvt_pk_bf16(v0[0], v0[1]); w.y = cvt_pk_bf16(v0[2], v0[3]); w.z = cvt_pk_bf16(v1[0], v1[1]); w.w = cvt_pk_bf16(v1[2], v1[3]);
                    *(u32x4*)(rowp + bj * HALF) = w; } }
    }
};

struct GateOrder { StaticOrder so;
    __device__ __forceinline__ bool next(int i, Unit& u) const { Unit t; if (!so.next(i >> 2, t)) return false; const int g = i & 3; u.pm = g * 64 + t.pm; u.pn = g * 8 + t.pn; return true; }
    __device__ __forceinline__ void a_ready(const Unit&) const {}
    __device__ __forceinline__ void done(const Unit&) const {}
};
struct EpiGate {
    static constexpr bool PERM = true, AFTER_DRAIN = false, INPLACE = true;
    const unsigned char* ZG; bf16_t* MG;
    static __device__ __forceinline__ bool keep(const Unit& u) { return (u.pn >> 3) < 3; }
    __device__ __forceinline__ void operator()(f32x4 (&acc)[2][2][4][2], const Unit& u, int wr, int wc, int fr, int fq) const {
        typedef unsigned u32x2 __attribute__((ext_vector_type(2)));
        const int g = u.pn >> 3, pn0 = u.pn & 7, pm0 = u.pm - g * 64;
        const unsigned tix = (unsigned)((wr * 4 + wc) * 64 + fq * 16 + fr);
        const unsigned char* gtile = ZG + (size_t)(pm0 * 32 + g * 8 + pn0) * 65536 + tix * 8;
        if (g < 3) { u32x2 gwa[2][4][2], gna[2][4][2];
#pragma unroll
            for (int ai = 0; ai < 2; ++ai)
#pragma unroll
                for (int m = 0; m < 4; ++m)
#pragma unroll
                    for (int bj = 0; bj < 2; ++bj) { gwa[ai][m][bj] = *(const u32x2*)(gtile + ((ai * 4 + m) * 2 + bj) * 4096); gna[ai][m][bj] = *(const u32x2*)(gtile + 8 * 65536 + ((ai * 4 + m) * 2 + bj) * 4096); }
#pragma unroll
            for (int ai = 0; ai < 2; ++ai) { const u32x2 (&gw)[4][2] = gwa[ai]; const u32x2 (&gn)[4][2] = gna[ai];
#pragma unroll
                for (int m = 0; m < 4; ++m)
#pragma unroll
                    for (int bj = 0; bj < 2; ++bj)
#pragma unroll
                        for (int j = 0; j < 4; ++j) { const unsigned gword = (j < 2) ? gw[m][bj].x : gw[m][bj].y, nword = (j < 2) ? gn[m][bj].x : gn[m][bj].y; const int sh = 16 * (j & 1);
                            const float r0 = (float)((gword >> sh) & 0xffu) * __builtin_amdgcn_rcpf((float)((nword >> sh) & 0xffu)), r1 = (float)((gword >> (sh + 8)) & 0xffu) * __builtin_amdgcn_rcpf((float)((nword >> (sh + 8)) & 0xffu));
                            if (j < 2) { acc[ai][bj][m][0][2 * j] *= r0; acc[ai][bj][m][0][2 * j + 1] *= r1; } else { acc[ai][bj][m][1][2 * j - 4] *= r0; acc[ai][bj][m][1][2 * j - 3] *= r1; } } }
        } else {
            const int row0 = pm0 * BM + wr * 64 + fr, col0 = pn0 * BM + wc * 32 + 8 * fq;
#pragma unroll
            for (int ai = 0; ai < 2; ++ai) { u32x2 gw[4][2];
#pragma unroll
                for (int m = 0; m < 4; ++m)
#pragma unroll
                    for (int bj = 0; bj < 2; ++bj) gw[m][bj] = *(const u32x2*)(gtile + ((ai * 4 + m) * 2 + bj) * 4096);
#pragma unroll
                for (int m = 0; m < 4; ++m)
#pragma unroll
                    for (int bj = 0; bj < 2; ++bj) { const size_t row = (size_t)(row0 + ai * HALF + m * 16); const int col = col0 + bj * HALF; float v[8];
#pragma unroll
                        for (int j = 0; j < 4; ++j) { const unsigned gword = (j < 2) ? gw[m][bj].x : gw[m][bj].y; const int sh = 16 * (j & 1);
                            const float g0 = (float)((gword >> sh) & 0xffu) * (1.0f / 255.0f), g1 = (float)((gword >> (sh + 8)) & 0xffu) * (1.0f / 255.0f);
                            const float a0 = (j < 2) ? acc[ai][bj][m][0][2 * j] : acc[ai][bj][m][1][2 * j - 4], a1 = (j < 2) ? acc[ai][bj][m][0][2 * j + 1] : acc[ai][bj][m][1][2 * j - 3];
                            v[2 * j] = a0 * g0; v[2 * j + 1] = a1 * g1; }
                        u32x4 w; w.x = cvt_pk_bf16(v[0], v[1]); w.y = cvt_pk_bf16(v[2], v[3]); w.z = cvt_pk_bf16(v[4], v[5]); w.w = cvt_pk_bf16(v[6], v[7]);
                        *(u32x4*)(MG + row * 2048 + col) = w; } }
        }
    }
};

template <int ROT> __device__ __forceinline__ float dpp_ror(float v) { return __builtin_bit_cast(float, __builtin_amdgcn_update_dpp(0, __builtin_bit_cast(int, v), 0x120 | ROT, 0xf, 0xf, true)); }
struct EpiConvAct {
    static constexpr bool PERM = true, AFTER_DRAIN = false, INPLACE = false;
    bf16_t* ACT; bf16_t* RAW; const float* cwt; PG8_LAS float* XA;
    __device__ __forceinline__ void operator()(const f32x4 (&acc)[2][2][4][2], const Unit& u, int wr, int wc, int fr, int fq) const {
        const int FFc = 5504;
        PG8_LAS float* CW = XA + 2048;
        { const int t8 = ((wr * 4 + wc) * 64 + fq * 16 + fr) * 2; typedef float f32x2l __attribute__((ext_vector_type(2)));
          const f32x2l v = *(const f32x2l*)(cwt + (unsigned)(u.pn * 1024 + t8)); *(PG8_LAS f32x2l*)(CW + t8) = v; }
#pragma unroll
        for (int ai = 0; ai < 2; ++ai) { PG8_LAS float* xs = XA + (((ai * 2 + wr) * 4 + wc) * 2) * 64 + fq * 8;
            if (fr == 0) {
#pragma unroll
                for (int bj = 0; bj < 2; ++bj) { *(PG8_LAS f32x4*)(xs + bj * 32) = acc[ai][bj][0][0]; *(PG8_LAS f32x4*)(xs + bj * 32 + 4) = acc[ai][bj][0][1]; } }
            if (fr == 15) {
#pragma unroll
                for (int bj = 0; bj < 2; ++bj) { *(PG8_LAS f32x4*)(xs + 64 + bj * 32) = acc[ai][bj][3][0]; *(PG8_LAS f32x4*)(xs + 64 + bj * 32 + 4) = acc[ai][bj][3][1]; } } }
        asm volatile("s_waitcnt lgkmcnt(0)" ::: "memory"); __builtin_amdgcn_s_barrier(); asm volatile("" ::: "memory");
        int fqw = fq; asm volatile("" : "+v"(fqw));
        const int chan0 = u.pn * 128 + wc * 32 + fq * 8;
#pragma unroll
        for (int ai = 0; ai < 2; ++ai) {
            const bool has_top = (ai == 1) || (wr == 1), has_bot = (ai == 0) || (wr == 0);
            const int ts = (wr == 1) ? ((ai * 2 + 0) * 4 + wc) * 2 + 1 : (((ai - 1) * 2 + 1) * 4 + wc) * 2 + 1;
            const int bs = (wr == 0) ? ((ai * 2 + 1) * 4 + wc) * 2 + 0 : (((ai + 1) * 2 + 0) * 4 + wc) * 2 + 0;
#pragma unroll
            for (int nn = 0; nn < 2; ++nn) {
                float actv[4][4];
#pragma unroll
                for (int bj = 0; bj < 2; ++bj) {
                    __builtin_amdgcn_sched_barrier(0);
                    const PG8_LAS float* wp = CW + (bj * 512 + wc * 32 + fqw * 8 + 4 * nn);
                    const f32x4 bb = *(const PG8_LAS f32x4*)wp, w0 = *(const PG8_LAS f32x4*)(wp + 128), w1 = *(const PG8_LAS f32x4*)(wp + 256), w2 = *(const PG8_LAS f32x4*)(wp + 384);
                    f32x4 ht = (f32x4){0.f, 0.f, 0.f, 0.f}, hb = ht;
                    if (has_top) ht = *(const PG8_LAS f32x4*)(XA + ts * 64 + bj * 32 + fq * 8 + 4 * nn);
                    if (has_bot) hb = *(const PG8_LAS f32x4*)(XA + bs * 64 + bj * 32 + fq * 8 + 4 * nn);
#pragma unroll
                    for (int e = 0; e < 4; ++e) {
                        float r1[4], r15[4];
#pragma unroll
                        for (int m = 0; m < 4; ++m) { r1[m] = dpp_ror<1>(acc[ai][bj][m][nn][e]); r15[m] = dpp_ror<15>(acc[ai][bj][m][nn][e]); }
#pragma unroll
                        for (int m = 0; m < 4; ++m) {
                            const float pv = (fr != 0) ? r1[m] : (m > 0 ? r1[m > 0 ? m - 1 : 0] : ht[e]), nx = (fr != 15) ? r15[m] : (m < 3 ? r15[m < 3 ? m + 1 : 3] : hb[e]);
                            const float uc = bb[e] + w0[e] * pv + w1[e] * acc[ai][bj][m][nn][e] + w2[e] * nx;
                            if (bj == 0) actv[m][e] = uc * __builtin_amdgcn_rcpf(1.0f + __expf(-uc)); else actv[m][e] *= uc; } } }
#pragma unroll
                for (int m = 0; m < 4; ++m) { const unsigned aoff = (unsigned)(u.pm * BM + ai * HALF + wr * 64 + m * 16 + fr) * (unsigned)FFc + (unsigned)(chan0 + 4 * nn);
                    typedef unsigned u32x2 __attribute__((ext_vector_type(2))); u32x2 w; w.x = cvt_pk_bf16(actv[m][0], actv[m][1]); w.y = cvt_pk_bf16(actv[m][2], actv[m][3]);
                    *(u32x2*)(ACT + aoff) = w; } } }
        { int frl = fr, fql = fq; asm volatile("" : "+v"(frl), "+v"(fql));
          if (wr == 0 && frl < 2) { bf16_t* rp = RAW + (unsigned)(((u.pm * 4 + frl) * 43 + u.pn) * 256 + wc * 32 + fql * 8);
#pragma unroll
              for (int bj = 0; bj < 2; ++bj) { const f32x4 v0 = acc[0][bj][0][0], v1 = acc[0][bj][0][1]; u32x4 w; w.x = cvt_pk_bf16(v0[0], v0[1]); w.y = cvt_pk_bf16(v0[2], v0[3]); w.z = cvt_pk_bf16(v1[0], v1[1]); w.w = cvt_pk_bf16(v1[2], v1[3]); *(u32x4*)(rp + bj * 128) = w; } }
          if (wr == 1 && frl >= 14) { bf16_t* rp = RAW + (unsigned)(((u.pm * 4 + frl - 12) * 43 + u.pn) * 256 + wc * 32 + fql * 8);
#pragma unroll
              for (int bj = 0; bj < 2; ++bj) { const f32x4 v0 = acc[1][bj][3][0], v1 = acc[1][bj][3][1]; u32x4 w; w.x = cvt_pk_bf16(v0[0], v0[1]); w.y = cvt_pk_bf16(v0[2], v0[3]); w.z = cvt_pk_bf16(v1[0], v1[1]); w.w = cvt_pk_bf16(v1[2], v1[3]); *(u32x4*)(rp + bj * 128) = w; } } }
    }
};
struct EpiF32 {
    static constexpr bool PERM = false, AFTER_DRAIN = false, INPLACE = false;
    float* C; int ldc; const float* bias;
    __device__ __forceinline__ void operator()(const f32x4 (&acc)[2][2][4][2], const Unit& u, int wr, int wc, int fr, int fq) const {
        const int row0 = u.pm * BM + wr * 64 + fr, col0 = u.pn * BM + wc * 32 + 4 * fq;
        f32x4 bv[2][2];
#pragma unroll
        for (int bj = 0; bj < 2; ++bj)
#pragma unroll
            for (int n = 0; n < 2; ++n) bv[bj][n] = bias ? *(const f32x4*)(bias + col0 + bj * HALF + n * 16) : (f32x4){0.f, 0.f, 0.f, 0.f};
#pragma unroll
        for (int ai = 0; ai < 2; ++ai)
#pragma unroll
            for (int m = 0; m < 4; ++m) { float* rowp = C + (size_t)(row0 + ai * HALF + m * 16) * ldc + col0;
#pragma unroll
                for (int bj = 0; bj < 2; ++bj)
#pragma unroll
                    for (int n = 0; n < 2; ++n) *(f32x4*)(rowp + bj * HALF + n * 16) = acc[ai][bj][m][n] + bv[bj][n]; }
    }
};
template <class Epi, class Sched, bool ALIGN_EPI = false, bool SP2 = false>
__device__ __forceinline__ void gemm_phase(PG8_LAS unsigned char* lds, const Gemm g, const Sched& S, const Epi& E, const int wave_in) {
    int tid = wave_in * 64 + mk_lane_id(); asm volatile("" : "+v"(tid));
    const int wid = __builtin_amdgcn_readfirstlane(tid >> 6), lane = tid & 63, wr = wid >> 2, wc = wid & 3, fr = lane & 15, fq = lane >> 4;
    const int K = g.K, nt = K / BK;
    unsigned voffA[2], voffB[2];
#pragma unroll
    for (int i = 0; i < 2; ++i) { int R, C; stage_rc(tid * 16 + i * 8192, R, C); const int Rb = Epi::PERM ? ((R & ~31) + perm32(R & 31)) : R;
        voffA[i] = (unsigned)(R * K + C) * 2u; voffB[i] = (unsigned)(Rb * K + C) * 2u; }
    const size_t kstep = (size_t)(BK * 2);
    const size_t hstep = (size_t)HALF * K * 2;
    const size_t tstep = 2 * hstep;
    const unsigned ldsw = (unsigned)wid * 1024u;
    const int aoff = lds_byte(wr * 64 + fr, fq * 8), boff = lds_byte(wc * 32 + fr, fq * 8);
#define PG8_SA(b, h) (((b) * 2 + (h)) * HTB)
#define PG8_SB(b, h) ((4 + (b) * 2 + (h)) * HTB)
#define PG8_STAGE(bufoff, gbase, voff) do { _Pragma("unroll") for (int _i = 0; _i < 2; ++_i) \
        __builtin_amdgcn_global_load_lds((const unsigned*)((const char*)(gbase) + (voff)[_i]), (PG8_LAS unsigned*)(lds + (bufoff) + ldsw + _i * 8192), 16, 0, 0); } while (0)
#define PG8_LDA(dst, b, h) do { _Pragma("unroll") for (int m = 0; m < 4; ++m) _Pragma("unroll") for (int k = 0; k < 2; ++k) dst[m][k] = *(const PG8_LAS bf16x8*)(lds + PG8_SA(b, h) + aoff + m * 2048 + k * 1024); } while (0)
#define PG8_LDB(dst, b, h) do { _Pragma("unroll") for (int n = 0; n < 2; ++n) _Pragma("unroll") for (int k = 0; k < 2; ++k) dst[n][k] = *(const PG8_LAS bf16x8*)(lds + PG8_SB(b, h) + boff + n * 2048 + k * 1024); } while (0)
#define PG8_MMA(ai, bj, At, Bt) do { __builtin_amdgcn_s_setprio(1); _Pragma("unroll") for (int m = 0; m < 4; ++m) _Pragma("unroll") for (int n = 0; n < 2; ++n) _Pragma("unroll") for (int k = 0; k < 2; ++k) \
        acc[ai][bj][m][n] = __builtin_amdgcn_mfma_f32_16x16x32_bf16(Bt[n][k], At[m][k], acc[ai][bj][m][n], 0, 0, 0); __builtin_amdgcn_s_setprio(0); } while (0)
#define PG8_WAIT_V(n) asm volatile("s_waitcnt vmcnt(" #n ")" ::: "memory")
#define PG8_WAIT_L(n) asm volatile("s_waitcnt lgkmcnt(" #n ")" ::: "memory")
#define PG8_BAR __builtin_amdgcn_s_barrier()
#define PG8_SCHED __builtin_amdgcn_sched_barrier(0)
    Unit cur, nxt; int ui = 0;
    if (!S.next(0, cur)) return;
    f32x4 acc[2][2][4][2];
#pragma unroll
    for (int a = 0; a < 2; ++a)
#pragma unroll
        for (int b = 0; b < 2; ++b)
#pragma unroll
            for (int m = 0; m < 4; ++m)
#pragma unroll
                for (int n = 0; n < 2; ++n) acc[a][b][m][n] = (f32x4){0.f, 0.f, 0.f, 0.f};
    bf16x8 At[4][2], B0[2][2], B1[2][2];
    const char* cA = (const char*)g.A + (size_t)cur.pm * tstep; const char* cB = (const char*)g.Bt + (size_t)cur.pn * tstep;
    S.a_ready(cur);
    if constexpr (SP2) {
        PG8_STAGE(PG8_SB(0, 0), cB, voffB); PG8_STAGE(PG8_SB(0, 1), cB + hstep, voffB); PG8_STAGE(PG8_SA(0, 0), cA, voffA); PG8_STAGE(PG8_SA(0, 1), cA + hstep, voffA);
        if (wr == 1) PG8_BAR;
        PG8_WAIT_V(2); PG8_BAR;
        PG8_STAGE(PG8_SB(1, 0), cB + kstep, voffB); PG8_STAGE(PG8_SA(1, 0), cA + kstep, voffA); PG8_STAGE(PG8_SB(1, 1), cB + hstep + kstep, voffB);
        PG8_WAIT_V(6); PG8_BAR;
    } else {
        PG8_STAGE(PG8_SB(0, 0), cB, voffB); PG8_STAGE(PG8_SA(0, 0), cA, voffA); PG8_STAGE(PG8_SB(0, 1), cB + hstep, voffB); PG8_STAGE(PG8_SA(0, 1), cA + hstep, voffA);
        if (wr == 1) PG8_BAR;
        PG8_WAIT_V(4); PG8_BAR;
        PG8_STAGE(PG8_SB(1, 0), cB + kstep, voffB); PG8_STAGE(PG8_SA(1, 0), cA + kstep, voffA); PG8_STAGE(PG8_SB(1, 1), cB + hstep + kstep, voffB);
        PG8_WAIT_V(6); PG8_BAR;
    }
    for (;;) {
        const bool has_next = S.next(ui + 1, nxt);
        const char* nA = has_next ? (const char*)g.A + (size_t)nxt.pm * tstep : cA; const char* nB = has_next ? (const char*)g.Bt + (size_t)nxt.pn * tstep : cB;
        for (int t = 0; t < nt; t += 2) {
            const bool last = (t == nt - 2);
            const char* a1 = cA + (size_t)(t + 1) * kstep;
            const char* a2 = last ? nA : cA + (size_t)(t + 2) * kstep; const char* b2 = last ? nB : cB + (size_t)(t + 2) * kstep;
            const char* a3 = a2 + kstep; const char* b3 = b2 + kstep;
            if (last && has_next) S.a_ready(nxt);
            if constexpr (SP2) {
            PG8_LDB(B0, 0, 0); PG8_LDB(B1, 0, 1); PG8_SCHED; PG8_LDA(At, 0, 0); PG8_STAGE(PG8_SA(1, 1), a1 + hstep, voffA);
            PG8_WAIT_V(8); PG8_WAIT_L(0); PG8_BAR; PG8_MMA(0, 0, At, B0); PG8_MMA(0, 1, At, B1); PG8_BAR; PG8_SCHED;
            PG8_LDA(At, 0, 1); PG8_STAGE(PG8_SB(0, 0), b2, voffB); PG8_STAGE(PG8_SB(0, 1), b2 + hstep, voffB); PG8_STAGE(PG8_SA(0, 0), a2, voffA);
            PG8_WAIT_V(8); PG8_WAIT_L(0); PG8_BAR; PG8_MMA(1, 0, At, B0); PG8_MMA(1, 1, At, B1); PG8_BAR; PG8_SCHED;
            PG8_LDB(B0, 1, 0); PG8_LDB(B1, 1, 1); PG8_SCHED; PG8_LDA(At, 1, 0); PG8_STAGE(PG8_SA(0, 1), a2 + hstep, voffA);
            PG8_WAIT_V(8); PG8_WAIT_L(0); PG8_BAR; PG8_MMA(0, 0, At, B0); PG8_MMA(0, 1, At, B1); PG8_BAR; PG8_SCHED;
            PG8_LDA(At, 1, 1); PG8_STAGE(PG8_SB(1, 0), b3, voffB); PG8_STAGE(PG8_SB(1, 1), b3 + hstep, voffB); PG8_STAGE(PG8_SA(1, 0), a3, voffA);
            PG8_WAIT_V(8); PG8_WAIT_L(0); PG8_BAR; PG8_MMA(1, 0, At, B0); PG8_MMA(1, 1, At, B1); PG8_BAR; PG8_SCHED;
            } else {
            PG8_LDB(B0, 0, 0); PG8_SCHED; PG8_LDA(At, 0, 0); PG8_STAGE(PG8_SA(1, 1), a1 + hstep, voffA);
            PG8_WAIT_L(8); PG8_BAR; PG8_WAIT_L(0); PG8_MMA(0, 0, At, B0); PG8_BAR; PG8_SCHED;
            PG8_LDB(B1, 0, 1); PG8_STAGE(PG8_SB(0, 0), b2, voffB);
            PG8_BAR; PG8_WAIT_L(0); PG8_MMA(0, 1, At, B1); PG8_BAR;
            PG8_LDA(At, 0, 1); PG8_STAGE(PG8_SA(0, 0), a2, voffA);
            PG8_BAR; PG8_WAIT_L(0); PG8_MMA(1, 0, At, B0); PG8_BAR; PG8_SCHED;
            PG8_STAGE(PG8_SB(0, 1), b2 + hstep, voffB);
            PG8_WAIT_V(6); PG8_BAR; PG8_MMA(1, 1, At, B1); PG8_BAR;
            PG8_LDB(B0, 1, 0); PG8_SCHED; PG8_LDA(At, 1, 0); PG8_STAGE(PG8_SA(0, 1), a2 + hstep, voffA);
            PG8_WAIT_L(8); PG8_BAR; PG8_WAIT_L(0); PG8_MMA(0, 0, At, B0); PG8_BAR; PG8_SCHED;
            PG8_LDB(B1, 1, 1); PG8_STAGE(PG8_SB(1, 0), b3, voffB);
            PG8_BAR; PG8_WAIT_L(0); PG8_MMA(0, 1, At, B1); PG8_BAR;
            PG8_LDA(At, 1, 1); PG8_STAGE(PG8_SA(1, 0), a3, voffA);
            PG8_BAR; PG8_WAIT_L(0); PG8_MMA(1, 0, At, B0); PG8_BAR; PG8_SCHED;
            PG8_STAGE(PG8_SB(1, 1), b3 + hstep, voffB);
            PG8_WAIT_V(6); PG8_BAR; PG8_MMA(1, 1, At, B1); PG8_BAR;
            }
        }
        if constexpr (ALIGN_EPI) { if (wr == 0) PG8_BAR; }
        if constexpr (!Epi::AFTER_DRAIN) { E(acc, cur, wr, wc, fr, fq); S.done(cur); }
        if (!has_next) break;
        bool keep = false; if constexpr (Epi::INPLACE) keep = Epi::keep(cur);
        if (!keep) {
#pragma unroll
        for (int a = 0; a < 2; ++a)
#pragma unroll
            for (int b = 0; b < 2; ++b)
#pragma unroll
                for (int m = 0; m < 4; ++m)
#pragma unroll
                    for (int n = 0; n < 2; ++n) acc[a][b][m][n] = (f32x4){0.f, 0.f, 0.f, 0.f};
        }
        cur = nxt; cA = nA; cB = nB; ++ui;
        if constexpr (ALIGN_EPI) { if (wr == 1) PG8_BAR; }
    }
    PG8_WAIT_V(0);
    if constexpr (!ALIGN_EPI) { if (wr == 0) PG8_BAR; }
    PG8_BAR;
    if constexpr (Epi::AFTER_DRAIN) { E.fused(acc, cur, wr, wc, fr, fq, lds, wid, lane); S.done(cur); }
#undef PG8_SA
#undef PG8_SB
#undef PG8_STAGE
#undef PG8_LDA
#undef PG8_LDB
#undef PG8_MMA
#undef PG8_WAIT_V
#undef PG8_WAIT_L
#undef PG8_BAR
#undef PG8_SCHED
}
}

#define XB_TMO      128
#define XB_XCNT(j)  (256  + 64 * (j))
#define XB_XSUB(j)  (1280 + 64 * (j))
#define XB_XGEN(j)  (2304 + 64 * (j))
#define XB_TOP      3328
#define XB_TOPGEN   3392
#define XCD_BAR_WORDS 3456
#define XB_SPIN_CAP (1u << 18)

__device__ __forceinline__ unsigned xb_ld(unsigned* p)              { return __hip_atomic_load(p, __ATOMIC_RELAXED, __HIP_MEMORY_SCOPE_AGENT); }
__device__ __forceinline__ unsigned xb_add(unsigned* p, unsigned v) { return __hip_atomic_fetch_add(p, v, __ATOMIC_RELAXED, __HIP_MEMORY_SCOPE_AGENT); }
__device__ __forceinline__ unsigned xb_xcc_id() { return (unsigned)__builtin_amdgcn_s_getreg((3 << 11) | 20) & 0xFu; }
#define XB_SPIN(cond, bar) do { unsigned _sp = 0; while (cond) { __builtin_amdgcn_s_sleep(1); \
    if ((++_sp & 255u) == 0u) { if (xb_ld(&(bar)[XB_TMO])) break; if (_sp > XB_SPIN_CAP) { atomicAdd(&(bar)[XB_TMO], 1u); break; } } } } while (0)

struct XcdBarrier {
    unsigned w0;
    unsigned* bar; unsigned x;
    volatile LAS unsigned* st;
};

__device__ __forceinline__ XcdBarrier xcd_barrier_post(unsigned* bar, volatile LAS unsigned* st) {
    XcdBarrier b; b.w0 = 0u; b.bar = bar; b.x = xb_xcc_id(); b.st = st;
    if (threadIdx.x == 0) (void)xb_add(&bar[XB_XCNT(b.x)], 1u);
    return b;
}
__device__ __forceinline__ void xcd_barrier_complete(unsigned* bar, unsigned x, unsigned& nloc, unsigned& nx) {
    const unsigned G = gridDim.x * gridDim.y * gridDim.z;
    unsigned sum, cnt, mine, sp = 0u;
    for (;;) {
        sum = 0u; cnt = 0u; mine = 0u;
#pragma unroll
        for (unsigned j = 0; j < 16; ++j) { const unsigned c = xb_ld(&bar[XB_XCNT(j)]); sum += c; cnt += (c > 0u) ? 1u : 0u; mine = (j == x) ? c : mine; }
        if (sum == G) break;
        __builtin_amdgcn_s_sleep(1);
        if ((++sp & 255u) == 0u) { if (xb_ld(&bar[XB_TMO])) break; if (sp > XB_SPIN_CAP) { atomicAdd(&bar[XB_TMO], 1u); break; } }
    }
    nloc = mine > 0u ? mine : 1u; nx = cnt > 0u ? cnt : 1u;
}

__device__ __forceinline__ void xcd_barrier(const XcdBarrier& b) {
    asm volatile("s_waitcnt vmcnt(0)" ::: "memory");
    __syncthreads();
    if (b.w0 != 0u && (unsigned)mk_lane_id() == 0u) {
        unsigned* bar = b.bar;
        __builtin_amdgcn_s_waitcnt(0);
        unsigned nloc = b.st[0], nx = b.st[1];
        if (nloc == 0u) { xcd_barrier_complete(bar, b.x, nloc, nx); b.st[0] = nloc; b.st[1] = nx; }
        const unsigned old = xb_add(&bar[XB_XSUB(b.x)], 1u);
        const unsigned gen = old / nloc;
        if (old + 1u == (gen + 1u) * nloc) {
            __builtin_amdgcn_fence(__ATOMIC_RELEASE, "agent");
            asm volatile("s_waitcnt vmcnt(0)" ::: "memory");
            const unsigned og = xb_add(&bar[XB_TOP], 1u);
            const unsigned tg = og / nx;
            if (og + 1u == (tg + 1u) * nx) xb_add(&bar[XB_TOPGEN], 1u);
            else XB_SPIN(xb_ld(&bar[XB_TOPGEN]) == tg, bar);
            __builtin_amdgcn_fence(__ATOMIC_ACQUIRE, "agent");
            xb_add(&bar[XB_XGEN(b.x)], 1u);
            asm volatile("s_waitcnt vmcnt(0)" ::: "memory");
        } else {
            XB_SPIN(xb_ld(&bar[XB_XGEN(b.x)]) == gen, bar);
            __builtin_amdgcn_fence(__ATOMIC_ACQUIRE, "agent");
            asm volatile("s_waitcnt vmcnt(0)" ::: "memory");
        }
    }
    __syncthreads();
}

#ifndef ATT_EXP
#define ATT_EXP 0
#endif
#ifndef HG_EXP
#define HG_EXP 0
#endif
constexpr int S_ = 16384, D_ = 2048, W_ = 1024, NIN = 19456, FF = 5504, FF2 = 11008, DEPTH = 4, NHEAD = 8, HD = 128;
constexpr float RMS_EPS = 1e-6f;
constexpr int NWAVES = 8, NTHR = 512;
constexpr size_t MiB = 1u << 20;
constexpr size_t WS_CTL = 0, CTL_ZERO_BYTES = 1 * MiB;
constexpr size_t WS_MOD = 1 * MiB;
constexpr size_t WS_LB = WS_MOD + 256 * 1024;
constexpr size_t WS_ROT = 2 * MiB;
constexpr size_t WS_WIN = 10 * MiB;
constexpr size_t WS_WBR = WS_WIN + 304 * MiB;
constexpr size_t WS_WOUT = WS_WBR + 64 * MiB;
constexpr size_t WS_WUP = WS_WOUT + 32 * MiB;
constexpr size_t WS_WDN = WS_WUP + 172 * MiB;
constexpr size_t WS_H = WS_WDN + 86 * MiB;
constexpr size_t WS_Z = WS_H + 64 * MiB;
constexpr size_t WS_ZG = WS_Z + 352 * MiB;
constexpr size_t WS_BR = WS_Z + 608 * MiB;
constexpr size_t WS_P = WS_BR + 128 * MiB;
constexpr size_t WS_MERGED = WS_P + 256 * MiB;
constexpr size_t WS_Y = WS_MERGED + 64 * MiB;
constexpr size_t WS_N2 = WS_Y + 128 * MiB;
constexpr size_t WS_VT = WS_N2 + 384 * MiB;
constexpr size_t WS_LRUW = WS_VT + 96 * MiB;
constexpr size_t WS_POOLW = WS_LRUW + 4 * MiB;
constexpr size_t WS_RAW = WS_POOLW + 2 * MiB;
constexpr size_t WS_CWT = WS_RAW + 6 * MiB;
constexpr size_t WS_END = WS_CWT + 1 * MiB;
constexpr size_t WS_LSUM = WS_N2;
constexpr size_t WS_LCIN = WS_N2 + 4 * MiB;
constexpr size_t WS_LSU = WS_N2 + 8 * MiB;
constexpr size_t WS_LAF = WS_N2 + 40 * MiB;
constexpr size_t WS_LAB = WS_N2 + 72 * MiB;
constexpr size_t WS_XR = WS_N2 + 128 * MiB;
constexpr size_t WS_OP01 = WS_H;
constexpr size_t WS_OP2 = WS_Y + 64 * MiB;
constexpr size_t WS_ML = WS_Y + 96 * MiB;
constexpr size_t SEG = (size_t)S_ * W_;
constexpr size_t WS_HQS = WS_P;
constexpr size_t WS_HF = WS_P + 64 * MiB;
constexpr size_t WS_HO = WS_P + 192 * MiB;
constexpr size_t WS_PD = WS_P + 320 * MiB;
constexpr size_t WS_HST = WS_P;
constexpr size_t WS_HDEC = WS_P + 128 * MiB;
constexpr int CW_BAR = 4096;
constexpr int RING_BYTES = 131072, MISC_OFF = 143360, LDS_BYTES = 147456;

typedef unsigned short bf16;
typedef unsigned v4u __attribute__((ext_vector_type(4)));
typedef unsigned v2u __attribute__((ext_vector_type(2)));
typedef float f32x4 __attribute__((ext_vector_type(4)));
#define LDS_WAIT() asm volatile("s_waitcnt lgkmcnt(0)" ::: "memory")
__device__ __forceinline__ unsigned f2bf(float f) { unsigned u = __builtin_bit_cast(unsigned, f); return (u + 0x7fffu + ((u >> 16) & 1u)) >> 16; }
__device__ __forceinline__ unsigned pk2(float lo, float hi) { return f2bf(lo) | (f2bf(hi) << 16); }
typedef __bf16 bf16x2_t __attribute__((ext_vector_type(2)));
typedef float f32x2_t __attribute__((ext_vector_type(2)));
__device__ __forceinline__ unsigned cvtpk(float lo, float hi) { const f32x2_t v = {lo, hi}; return __builtin_bit_cast(unsigned, __builtin_convertvector(v, bf16x2_t)); }
__device__ __forceinline__ float bf2f(unsigned b) { return __builtin_bit_cast(float, b << 16); }
__device__ __forceinline__ float bflo(unsigned w) { return __builtin_bit_cast(float, w << 16); }
__device__ __forceinline__ float bfhi(unsigned w) { return __builtin_bit_cast(float, w & 0xffff0000u); }
__device__ __forceinline__ void unpack8(const v4u w, float (&o)[8]) { o[0] = bflo(w.x); o[1] = bfhi(w.x); o[2] = bflo(w.y); o[3] = bfhi(w.y); o[4] = bflo(w.z); o[5] = bfhi(w.z); o[6] = bflo(w.w); o[7] = bfhi(w.w); }
__device__ __forceinline__ float sigmoidf_(float x) { return __builtin_amdgcn_rcpf(1.0f + __expf(-x)); }
__device__ __forceinline__ float siluf_(float x) { return x * __builtin_amdgcn_rcpf(1.0f + __expf(-x)); }
__device__ __forceinline__ float gelu_tanh(float x) { const float u = 0.7978845608028654f * (x + 0.044715f * x * x * x); const float e = __expf(-2.0f * u); return x * __builtin_amdgcn_rcpf(1.0f + e); }
__device__ __forceinline__ float mk_bperm(int srclane, float v) { return __builtin_bit_cast(float, __builtin_amdgcn_ds_bpermute(srclane << 2, __builtin_bit_cast(int, v))); }
__device__ __forceinline__ float wave_sum(float v) { const int l = mk_lane_id();
#pragma unroll
    for (int o = 1; o < 64; o <<= 1) v += mk_bperm(l ^ o, v);
    return v;
}
__device__ __forceinline__ float wave_max(float v) { const int l = mk_lane_id();
#pragma unroll
    for (int o = 1; o < 64; o <<= 1) v = fmaxf(v, mk_bperm(l ^ o, v));
    return v;
}

struct Args {
    const float *x, *c; const int* pos; const float *ada_w, *ada_b, *norm_g, *w_in, *hgrn_lb, *hgrn_onorm, *lru_conv_w, *lru_conv_b, *lru_wa, *lru_ba, *lru_wx, *lru_bx, *lru_lambda,
        *pool_w, *pool_scale, *w_branch, *w_out, *ffn_up, *ffn_conv_w, *ffn_conv_b, *ffn_down;
    float* out; unsigned char* ws; int ph_lo, ph_hi;
};

struct TJob { const float* W; bf16* WT; int K, N, item, up; };
__device__ __forceinline__ void tr_load(const TJob& j, f32x4 (&v)[16], int lane) { const int nblk = j.N / 64, kb = j.item / nblk, nb = j.item % nblk, k0 = 64 * kb, n0 = 64 * nb;
#pragma unroll
    for (int i = 0; i < 16; ++i) v[i] = *(const f32x4*)(j.W + (size_t)(k0 + 4 * i + (lane >> 4)) * j.N + n0 + 4 * (lane & 15)); }
__device__ __forceinline__ void tr_to_lds(const f32x4 (&v)[16], LAS float* scr, int lane) {
#pragma unroll
    for (int i = 0; i < 16; ++i) { LAS float* s = scr + (4 * i + (lane >> 4)) * 65 + 4 * (lane & 15); s[0] = v[i][0]; s[1] = v[i][1]; s[2] = v[i][2]; s[3] = v[i][3]; }
    LDS_WAIT(); asm volatile("" ::: "memory"); }
__device__ __forceinline__ void tr_store(const TJob& j, LAS float* scr, int lane) { const int nblk = j.N / 64, kb = j.item / nblk, nb = j.item % nblk, k0 = 64 * kb, n0 = 64 * nb;
    int d0 = n0; if (j.up) { const int isv = n0 >= FF ? 1 : 0, c = n0 - isv * FF; d0 = 256 * (c >> 7) + 128 * isv + (c & 127); }
    const int c = lane & 7;
#pragma unroll
    for (int jj = 0; jj < 8; ++jj) { const int n = (lane >> 3) + 8 * jj; const LAS float* s = scr + (8 * c) * 65 + n;
        v4u o; o.x = cvtpk(s[0 * 65], s[1 * 65]); o.y = cvtpk(s[2 * 65], s[3 * 65]); o.z = cvtpk(s[4 * 65], s[5 * 65]); o.w = cvtpk(s[6 * 65], s[7 * 65]);
        *(GAS v4u*)(j.WT + (size_t)(d0 + n) * j.K + k0 + 8 * c) = o; }
    LDS_WAIT(); asm volatile("" ::: "memory"); }
__device__ __forceinline__ TJob tr_job(const Args& a, unsigned char* ws, int it) {
    constexpr int I_IN = (D_ / 64) * (NIN / 64), I_BR1 = (W_ / 64) * (D_ / 64), I_BR = 4 * I_BR1, I_OUT = (D_ / 64) * (D_ / 64), I_UP = (D_ / 64) * (FF2 / 64), I_DN = (FF / 64) * (D_ / 64);
    constexpr int I_LAYER = I_IN + I_BR + I_OUT + I_UP + I_DN, I_BIG = DEPTH * I_LAYER;
    TJob j; j.up = 0;
    if (it < I_BIG) { const int L = it / I_LAYER; int r = it - L * I_LAYER;
        if (r < I_IN) { j.W = a.w_in + (size_t)L * D_ * NIN; j.K = D_; j.N = NIN; j.WT = (bf16*)(ws + WS_WIN) + (size_t)L * NIN * D_; j.item = r; return j; } r -= I_IN;
        if (r < I_BR) { const int g = r / I_BR1; j.W = a.w_branch + ((size_t)L * 4 + g) * W_ * D_; j.K = W_; j.N = D_; j.WT = (bf16*)(ws + WS_WBR) + ((size_t)L * 4 + g) * D_ * W_; j.item = r - g * I_BR1; return j; } r -= I_BR;
        if (r < I_OUT) { j.W = a.w_out + (size_t)L * D_ * D_; j.K = D_; j.N = D_; j.WT = (bf16*)(ws + WS_WOUT) + (size_t)L * D_ * D_; j.item = r; return j; } r -= I_OUT;
        if (r < I_UP) { j.W = a.ffn_up + (size_t)L * D_ * FF2; j.K = D_; j.N = FF2; j.WT = (bf16*)(ws + WS_WUP) + (size_t)L * FF2 * D_; j.item = r; j.up = 1; return j; } r -= I_UP;
        j.W = a.ffn_down + (size_t)L * FF * D_; j.K = FF; j.N = D_; j.WT = (bf16*)(ws + WS_WDN) + (size_t)L * D_ * FF; j.item = r; return j; }
    const int s = it - I_BIG;
    if (s < 512) { const int blk = s >> 2, sel = blk >> 6, rest = blk & 63;
        j.W = (sel ? a.lru_wx : a.lru_wa) + (size_t)rest * 16384; j.K = 128; j.N = 128; j.WT = (bf16*)(ws + WS_LRUW) + (size_t)blk * 16384; j.item = s & 3; return j; }
    const int r = s - 512, blk = r >> 4; j.W = a.pool_w + (size_t)blk * 65536; j.K = 256; j.N = 256; j.WT = (bf16*)(ws + WS_POOLW) + (size_t)blk * 65536; j.item = r & 15; return j;
}
__device__ __forceinline__ void ph_prologue(const Args& a, LAS unsigned char* lds, int bid, int nb, int tid, int wave, int lane) {
    unsigned char* ws = a.ws;
    LAS float* scr = (LAS float*)(lds + wave * 16640);
    const int gw = bid * NWAVES + wave, NGW = nb * NWAVES;
    constexpr int N_ITEMS = DEPTH * ((D_ / 64) * (NIN / 64) + 4 * (W_ / 64) * (D_ / 64) + (D_ / 64) * (D_ / 64) + (D_ / 64) * (FF2 / 64) + (FF / 64) * (D_ / 64)) + 512 + 256;
    if (gw < N_ITEMS) { f32x4 v[16]; TJob cur = tr_job(a, ws, gw); tr_load(cur, v, lane);
        for (int it = gw; it < N_ITEMS; it += NGW) { tr_to_lds(v, scr, lane);
            const bool hn = it + NGW < N_ITEMS; TJob nx = cur; if (hn) { nx = tr_job(a, ws, it + NGW); tr_load(nx, v, lane); }
            tr_store(cur, scr, lane); cur = nx; } }
    __syncthreads();
    LAS float* red = (LAS float*)lds;
    float* mod = (float*)(ws + WS_MOD);
    for (int it = bid; it < DEPTH * 192; it += nb) {
        const int L = it / 192, j0 = (it % 192) * 64;
        const float* wp = a.ada_w + (size_t)L * D_ * 6 * D_ + (size_t)(wave * 256) * 6 * D_ + j0 + lane;
        float acc = 0.f;
        for (int k0 = 0; k0 < 256; k0 += 32) { float wv[32];
#pragma unroll
            for (int k = 0; k < 32; ++k) wv[k] = wp[(size_t)(k0 + k) * 6 * D_];
#pragma unroll
            for (int k = 0; k < 32; ++k) { const float cv = a.c[wave * 256 + k0 + k]; acc += siluf_(cv) * wv[k]; } }
        red[wave * 64 + lane] = acc;
        __syncthreads();
        if (wave == 0) { float s = a.ada_b[L * 6 * D_ + j0 + lane];
#pragma unroll
            for (int w = 0; w < 8; ++w) s += red[w * 64 + lane];
            mod[L * 6 * D_ + j0 + lane] = s; }
        __syncthreads();
    }
    { float* cwt = (float*)(ws + WS_CWT);
      for (int i = bid * NTHR + tid; i < DEPTH * 43 * 8 * 128; i += nb * NTHR) { const int c = i & 127, r = (i >> 7) & 7, pn = (i >> 10) % 43, L = (i >> 10) / 43, ch = (r >> 2) * FF + pn * 128 + c, k = r & 3;
          cwt[i] = k == 0 ? a.ffn_conv_b[(size_t)L * FF2 + ch] : a.ffn_conv_w[((size_t)L * 3 + (k - 1)) * FF2 + ch]; } }
    if (bid == 0) { float* lb = (float*)(ws + WS_LB);
        for (int i = tid; i < 2 * W_; i += NTHR) { float e[DEPTH], s = 0.f;
#pragma unroll
            for (int L = 0; L < DEPTH; ++L) e[L] = a.hgrn_lb[L * 2 * W_ + i];
            const float mx = fmaxf(fmaxf(e[0], e[1]), fmaxf(e[2], e[3]));
#pragma unroll
            for (int L = 0; L < DEPTH; ++L) { e[L] = expf(e[L] - mx); s += e[L]; }
            float cum = 0.f; lb[i] = 0.f;
#pragma unroll
            for (int L = 1; L < DEPTH; ++L) { cum += e[L] / s; lb[L * 2 * W_ + i] = cum; } } }
    { float2* rot = (float2*)(ws + WS_ROT);
      for (int i = bid * NTHR + tid; i < S_ * 64; i += nb * NTHR) { const int t = i >> 6, d = i & 63;
          const float inv = powf(10000.0f, -(float)d / 64.0f); const float ang = (float)a.pos[t] * inv; float sn, cs; sincosf(ang, &sn, &cs); rot[i] = make_float2(cs, sn); } }
}

template <bool HAS_Y>
__device__ __forceinline__ void ph_resnorm(const Args& a, LAS unsigned char* lds, int bid, int nb, int tid, int wave, int lane,
                                           const float* xsrc, float* xdst, const bf16* y, bf16* hdst, int L, int gsel, int ysel, int Lh, int hsel, int scsel, int shsel, const bf16* xsrcb = nullptr, bf16* xdstb = nullptr) {
    const float* mod = (const float*)(a.ws + WS_MOD);
    LAS float* cy = (LAS float*)lds; LAS float* ca = cy + D_; LAS float* cb = ca + D_;
    for (int c = tid; c < D_; c += NTHR) {
        if (HAS_Y) cy[c] = mod[L * 6 * D_ + gsel * D_ + c] * a.norm_g[(L * 4 + ysel) * D_ + c];
        if (hdst) { ca[c] = a.norm_g[(Lh * 4 + hsel) * D_ + c] * (1.0f + mod[Lh * 6 * D_ + scsel * D_ + c]); cb[c] = mod[Lh * 6 * D_ + shsel * D_ + c]; }
    }
    __syncthreads();
#pragma unroll 2
    for (int row = bid * NWAVES + wave; row < S_; row += nb * NWAVES) {
        f32x4 xv[8];
        if (xsrcb) { const v2u* xb = (const v2u*)(xsrcb + (size_t)row * D_) + lane;
#pragma unroll
            for (int j = 0; j < 8; ++j) { const v2u w = __builtin_nontemporal_load(&xb[64 * j]); xv[j] = (f32x4){bflo(w.x), bfhi(w.x), bflo(w.y), bfhi(w.y)}; } }
        else { const f32x4* xr = (const f32x4*)(xsrc + (size_t)row * D_) + lane;
#pragma unroll
            for (int j = 0; j < 8; ++j) xv[j] = __builtin_nontemporal_load(&xr[64 * j]); }
        if (HAS_Y) {
            const v2u* yr = (const v2u*)(y + (size_t)row * D_) + lane; f32x4 yv[8]; float ss = 0.f;
#pragma unroll
            for (int j = 0; j < 8; ++j) { const v2u yw = __builtin_nontemporal_load(&yr[64 * j]); yv[j] = (f32x4){bflo(yw.x), bfhi(yw.x), bflo(yw.y), bfhi(yw.y)}; ss += (yv[j].x * yv[j].x + yv[j].y * yv[j].y) + (yv[j].z * yv[j].z + yv[j].w * yv[j].w); }
            const float r = rsqrtf(wave_sum(ss) * (1.0f / D_) + RMS_EPS);
            if (xdstb) { v2u* xo = (v2u*)(xdstb + (size_t)row * D_) + lane;
#pragma unroll
                for (int j = 0; j < 8; ++j) { const f32x4 cv = *(const LAS f32x4*)(cy + 4 * (lane + 64 * j)); xv[j] = xv[j] + yv[j] * r * cv; v2u w; w.x = pk2(xv[j].x, xv[j].y); w.y = pk2(xv[j].z, xv[j].w); __builtin_nontemporal_store(w, &xo[64 * j]); } }
            else { f32x4* xo = (f32x4*)(xdst + (size_t)row * D_) + lane;
#pragma unroll
                for (int j = 0; j < 8; ++j) { const f32x4 cv = *(const LAS f32x4*)(cy + 4 * (lane + 64 * j)); xv[j] = xv[j] + yv[j] * r * cv; __builtin_nontemporal_store(xv[j], &xo[64 * j]); } }
        }
        if (hdst) {
            float ss = 0.f;
#pragma unroll
            for (int j = 0; j < 8; ++j) ss += (xv[j].x * xv[j].x + xv[j].y * xv[j].y) + (xv[j].z * xv[j].z + xv[j].w * xv[j].w);
            const float r = rsqrtf(wave_sum(ss) * (1.0f / D_) + RMS_EPS);
            v2u* ho = (v2u*)(hdst + (size_t)row * D_) + lane;
#pragma unroll
            for (int j = 0; j < 8; ++j) { const f32x4 av = *(const LAS f32x4*)(ca + 4 * (lane + 64 * j)), bv = *(const LAS f32x4*)(cb + 4 * (lane + 64 * j)); const f32x4 h = xv[j] * r * av + bv;
                v2u w; w.x = pk2(h.x, h.y); w.y = pk2(h.z, h.w); ho[64 * j] = w; }
        }
    }
    __syncthreads();
}

__device__ __forceinline__ void ph_hgrn_prep(const Args& a, int L, int bid, int nb, int tid) {
    const bf16* z = (const bf16*)(a.ws + WS_Z); const float* lb = (const float*)(a.ws + WS_LB) + L * 2 * W_;
    float* QS = (float*)(a.ws + WS_HQS); float* F = (float*)(a.ws + WS_HF);
    for (size_t i = (size_t)bid * NTHR + tid; i < SEG; i += (size_t)nb * NTHR) { const int ch = (int)(i & (W_ - 1));
        QS[i] = siluf_(bf2f(z[0 * SEG + i]));
        const float l0 = lb[ch], l1 = lb[W_ + ch];
        F[i] = l0 + (1.0f - l0) * sigmoidf_(bf2f(z[1 * SEG + i])); F[SEG + i] = l1 + (1.0f - l1) * sigmoidf_(bf2f(z[2 * SEG + i])); }
}
__device__ __forceinline__ void ph_hgrn_rec(const Args& a, LAS unsigned char* lds, int bid, int tid) {
    if (bid >= 16) return;
    const int dir = bid >> 3, head = bid & 7, kq = tid >> 7, v = tid & 127;
    const bf16* zi = (const bf16*)(a.ws + WS_Z) + 3 * SEG; const float* QS = (const float*)(a.ws + WS_HQS); const float* F = (const float*)(a.ws + WS_HF) + (size_t)dir * SEG;
    float* HO = (float*)(a.ws + WS_HO) + (size_t)dir * SEG;
    LAS float* part = (LAS float*)lds;
    float st[32];
#pragma unroll
    for (int j = 0; j < 32; ++j) st[j] = 0.f;
    for (int n0 = 0; n0 < S_; n0 += 8) {
#pragma unroll 1
        for (int s = 0; s < 8; ++s) { const int n = n0 + s, t = dir ? S_ - 1 - n : n;
            const float iv = bf2f(zi[(size_t)t * W_ + head * HD + v]);
            const f32x4* fp = (const f32x4*)(F + (size_t)t * W_ + head * HD + kq * 32); const f32x4* qp = (const f32x4*)(QS + (size_t)t * W_ + head * HD + kq * 32);
            float o = 0.f;
#pragma unroll
            for (int j = 0; j < 8; ++j) { const f32x4 f = fp[j], q = qp[j];
                st[4 * j + 0] = f.x * st[4 * j + 0] + (1.0f - f.x) * iv; o += q.x * st[4 * j + 0];
                st[4 * j + 1] = f.y * st[4 * j + 1] + (1.0f - f.y) * iv; o += q.y * st[4 * j + 1];
                st[4 * j + 2] = f.z * st[4 * j + 2] + (1.0f - f.z) * iv; o += q.z * st[4 * j + 2];
                st[4 * j + 3] = f.w * st[4 * j + 3] + (1.0f - f.w) * iv; o += q.w * st[4 * j + 3]; }
            part[(kq * 8 + s) * 128 + v] = o; }
        __syncthreads();
#pragma unroll
        for (int h = 0; h < 2; ++h) { const int s = (tid >> 7) + 4 * h; const int n = n0 + s, t = dir ? S_ - 1 - n : n;
            HO[(size_t)t * W_ + head * HD + v] = (part[(0 * 8 + s) * 128 + v] + part[(1 * 8 + s) * 128 + v]) + (part[(2 * 8 + s) * 128 + v] + part[(3 * 8 + s) * 128 + v]); }
        __syncthreads();
    }
}
__device__ __forceinline__ void ph_hgrn_fin(const Args& a, int L, int bid, int nb, int wave, int lane) {
    const float* HO = (const float*)(a.ws + WS_HO); const bf16* zg = (const bf16*)(a.ws + WS_Z) + 4 * SEG; bf16* br = (bf16*)(a.ws + WS_BR);
    for (int it = bid * NWAVES + wave; it < S_ * NHEAD; it += nb * NWAVES) { const int t = it >> 3, h = it & 7; const size_t o0 = (size_t)t * W_ + h * HD + 2 * lane;
        const float o_a = HO[o0] + HO[SEG + o0], o_b = HO[o0 + 1] + HO[SEG + o0 + 1];
        const float r = rsqrtf(wave_sum(o_a * o_a + o_b * o_b) * (1.0f / HD) + RMS_EPS);
        const unsigned gw = *(const unsigned*)(zg + o0); const float* on = a.hgrn_onorm + L * W_ + h * HD + 2 * lane;
        *(unsigned*)(br + o0) = pk2(o_a * r * on[0] * siluf_(bflo(gw)), o_b * r * on[1] * siluf_(bfhi(gw))); }
}
__device__ __forceinline__ void ph_lru_xc(const Args& a, int L, int bid, int nb, int tid) {
    const bf16* zx = (const bf16*)(a.ws + WS_Z) + 5 * SEG; float* XC = (float*)(a.ws + WS_N2);
    const float* cw = a.lru_conv_w + (size_t)L * 2 * 4 * W_; const float* cbp = a.lru_conv_b + (size_t)L * 2 * W_;
    for (size_t i = (size_t)bid * NTHR + tid; i < SEG; i += (size_t)nb * NTHR) { const int ch = (int)(i & (W_ - 1)), t = (int)(i >> 10);
        float f = cbp[ch], b = cbp[W_ + ch];
#pragma unroll
        for (int j = 0; j < 4; ++j) { const int tf = t - 3 + j, tb = t + 3 - j;
            if (tf >= 0) f += cw[(0 * 4 + j) * W_ + ch] * bf2f(zx[(size_t)tf * W_ + ch]);
            if (tb < S_) b += cw[(1 * 4 + j) * W_ + ch] * bf2f(zx[(size_t)tb * W_ + ch]); }
        XC[i] = f; XC[SEG + i] = b; }
}
__device__ __forceinline__ void ph_lru_gates(const Args& a, int L, int bid, int nb, int tid) {
    const float* XC = (const float*)(a.ws + WS_N2); float* A = (float*)(a.ws + WS_N2 + 128 * MiB); float* U = (float*)(a.ws + WS_N2 + 256 * MiB);
    for (size_t i = (size_t)bid * NTHR + tid; i < 2 * SEG; i += (size_t)nb * NTHR) { const int dir = (int)(i / SEG); const size_t r = i - (size_t)dir * SEG; const int t = (int)(r >> 10), ch = (int)(r & (W_ - 1)), hh = ch >> 7, jj = ch & 127;
        const float* xr = XC + (size_t)dir * SEG + (size_t)t * W_ + hh * 128;
        const float* wa = a.lru_wa + (((size_t)L * 2 + dir) * 8 + hh) * 128 * 128 + jj; const float* wx = a.lru_wx + (((size_t)L * 2 + dir) * 8 + hh) * 128 * 128 + jj;
        float ra = a.lru_ba[(L * 2 + dir) * W_ + ch], rx = a.lru_bx[(L * 2 + dir) * W_ + ch];
#pragma unroll 8
        for (int k = 0; k < 128; ++k) { const float xv = xr[k]; ra += xv * wa[k * 128]; rx += xv * wx[k * 128]; }
        const float rg = sigmoidf_(ra), ig = sigmoidf_(rx);
        const float lam = a.lru_lambda[(L * 2 + dir) * W_ + ch]; const float sp = log1pf(expf(-lam));
        const float la = -8.0f * rg * sp;
        A[i] = expf(la); U[i] = sqrtf(-expm1f(2.0f * la)) * (ig * xr[jj]); }
}
__device__ __forceinline__ void ph_lru_scan(const Args& a, int bid, int tid) {
    const int id = bid * NTHR + tid; if (id >= 2 * W_) return;
    const int dir = id >> 10, ch = id & (W_ - 1);
    const float* A = (const float*)(a.ws + WS_N2 + 128 * MiB) + (size_t)dir * SEG + ch; float* U = (float*)(a.ws + WS_N2 + 256 * MiB) + (size_t)dir * SEG + ch;
    float h = 0.f;
    for (int n0 = 0; n0 < S_; n0 += 8) { float av[8], uv[8];
#pragma unroll
        for (int s = 0; s < 8; ++s) { const int n = n0 + s, t = dir ? S_ - 1 - n : n; av[s] = A[(size_t)t * W_]; uv[s] = U[(size_t)t * W_]; }
#pragma unroll
        for (int s = 0; s < 8; ++s) { const int n = n0 + s, t = dir ? S_ - 1 - n : n; h = av[s] * h + uv[s]; U[(size_t)t * W_] = h; } }
}
__device__ __forceinline__ void ph_lru_fin(const Args& a, int bid, int nb, int tid) {
    const float* U = (const float*)(a.ws + WS_N2 + 256 * MiB); const bf16* zg = (const bf16*)(a.ws + WS_Z) + 6 * SEG; bf16* br = (bf16*)(a.ws + WS_BR) + SEG;
    for (size_t i = (size_t)bid * NTHR + tid; i < SEG; i += (size_t)nb * NTHR) br[i] = (bf16)f2bf((U[i] + U[SEG + i]) * gelu_tanh(bf2f(zg[i])));
}
__device__ __forceinline__ void ph_pool_d(const Args& a, int bid, int nb, int tid) {
    const bf16* zp = (const bf16*)(a.ws + WS_Z) + 7 * SEG; float* PD = (float*)(a.ws + WS_PD);
    for (size_t i = (size_t)bid * NTHR + tid; i < SEG; i += (size_t)nb * NTHR) { const int ch = (int)(i & (W_ - 1)), t = (int)(i >> 10), w2 = 1 << (ch >> 8);
        const int lo = max(t - w2, 0), hi = min(t + w2, S_); float s = 0.f;
        for (int tt = lo; tt < hi; ++tt) s += bf2f(zp[(size_t)tt * W_ + ch]);
        PD[i] = s / (float)(hi - lo) - bf2f(zp[i]); }
}
__device__ __forceinline__ void ph_pool_mm(const Args& a, int L, int bid, int nb, int tid) {
    const float* PD = (const float*)(a.ws + WS_PD); bf16* br = (bf16*)(a.ws + WS_BR) + 2 * SEG;
    for (size_t i = (size_t)bid * NTHR + tid; i < SEG; i += (size_t)nb * NTHR) { const int ch = (int)(i & (W_ - 1)), t = (int)(i >> 10), gi = ch >> 8, jj = ch & 255;
        const float* dr = PD + (size_t)t * W_ + gi * 256; const float* pw = a.pool_w + ((size_t)L * 4 + gi) * 256 * 256 + jj; float s = 0.f;
#pragma unroll 8
        for (int k = 0; k < 256; ++k) s += dr[k] * pw[k * 256];
        br[i] = (bf16)f2bf(s * a.pool_scale[L * W_ + ch]); }
}
__device__ __forceinline__ void ph_attn_prep(unsigned char* ws, int bid, int nb, int tid) {
    bf16* zq = (bf16*)(ws + WS_Z) + 8 * SEG; bf16* zk = zq + SEG; const float2* rot = (const float2*)(ws + WS_ROT);
#pragma unroll 4
    for (int i = bid * NTHR + tid; i < S_ * NHEAD * 8; i += nb * NTHR) { const int d8 = (i & 7) * 8, h = (i >> 3) & 7, t = i >> 6;
        const size_t o = (size_t)t * W_ + h * HD + d8;
        const v4u q1 = *(const v4u*)(zq + o), q2 = *(const v4u*)(zq + o + 64), k1 = *(const v4u*)(zk + o), k2 = *(const v4u*)(zk + o + 64);
        const f32x4* rp = (const f32x4*)(rot + t * 64 + d8); const f32x4 r0 = rp[0], r1 = rp[1], r2 = rp[2], r3 = rp[3];
        const float cs[8] = {r0[0], r0[2], r1[0], r1[2], r2[0], r2[2], r3[0], r3[2]}, sn[8] = {r0[1], r0[3], r1[1], r1[3], r2[1], r2[3], r3[1], r3[3]};
        const unsigned qa[4] = {q1.x, q1.y, q1.z, q1.w}, qb[4] = {q2.x, q2.y, q2.z, q2.w}, ka[4] = {k1.x, k1.y, k1.z, k1.w}, kb[4] = {k2.x, k2.y, k2.z, k2.w};
        unsigned oq1[4], oq2[4], ok1[4], ok2[4]; const float sc = 0.08838834764831845f;
#pragma unroll
        for (int j = 0; j < 4; ++j) { const float c0 = cs[2 * j], s0 = sn[2 * j], c1 = cs[2 * j + 1], s1 = sn[2 * j + 1];
            const float a0 = bflo(qa[j]), a1 = bfhi(qa[j]), b0 = bflo(qb[j]), b1 = bfhi(qb[j]);
            oq1[j] = cvtpk((a0 * c0 - b0 * s0) * sc, (a1 * c1 - b1 * s1) * sc); oq2[j] = cvtpk((b0 * c0 + a0 * s0) * sc, (b1 * c1 + a1 * s1) * sc);
            const float e0 = bflo(ka[j]), e1 = bfhi(ka[j]), f0 = bflo(kb[j]), f1 = bfhi(kb[j]);
            ok1[j] = cvtpk(e0 * c0 - f0 * s0, e1 * c1 - f1 * s1); ok2[j] = cvtpk(f0 * c0 + e0 * s0, f1 * c1 + e1 * s1); }
        *(v4u*)(zq + o) = (v4u){oq1[0], oq1[1], oq1[2], oq1[3]}; *(v4u*)(zq + o + 64) = (v4u){oq2[0], oq2[1], oq2[2], oq2[3]};
        *(v4u*)(zk + o) = (v4u){ok1[0], ok1[1], ok1[2], ok1[3]}; *(v4u*)(zk + o + 64) = (v4u){ok2[0], ok2[1], ok2[2], ok2[3]}; }
}
__device__ __forceinline__ void ph_attn_naive(const Args& a, LAS unsigned char* lds, int bid, int nb, int wave, int lane) {
    const bf16* zq = (const bf16*)(a.ws + WS_Z) + 8 * SEG; const bf16* zk = zq + SEG; const bf16* zv = zk + SEG; bf16* br = (bf16*)(a.ws + WS_BR) + 3 * SEG;
    LAS float* qs = (LAS float*)(lds + wave * 4096); LAS float* ps = qs + 128;
    for (int it = bid * NWAVES + wave; it < S_ * NHEAD; it += nb * NWAVES) { const int t = it >> 3, h = it & 7;
        { const unsigned qw = *(const unsigned*)(zq + (size_t)t * W_ + h * HD + 2 * lane); qs[2 * lane] = bflo(qw); qs[2 * lane + 1] = bfhi(qw); }
        LDS_WAIT(); asm volatile("" ::: "memory");
        float sv[7]; float mx = -1e30f;
#pragma unroll
        for (int i = 0; i < 7; ++i) { const int e = lane + 64 * i; float s = -1e30f;
            if (e < 387) { const int g = e / 129, o = e - g * 129 - 64, dil = (g == 0) ? 1 : (g == 1 ? 4 : 16), p = t + dil * o;
                if (p >= 0 && p < S_) { const v4u* kr = (const v4u*)(zk + (size_t)p * W_ + h * HD); float d = 0.f;
#pragma unroll 4
                    for (int c = 0; c < 16; ++c) { const v4u kw = kr[c]; const LAS float* qq = qs + 8 * c;
                        d += qq[0] * bflo(kw.x) + qq[1] * bfhi(kw.x) + qq[2] * bflo(kw.y) + qq[3] * bfhi(kw.y) + qq[4] * bflo(kw.z) + qq[5] * bfhi(kw.z) + qq[6] * bflo(kw.w) + qq[7] * bfhi(kw.w); }
                    s = d; } }
            sv[i] = s; mx = fmaxf(mx, s); }
        mx = wave_max(mx); float l = 0.f;
#pragma unroll
        for (int i = 0; i < 7; ++i) { const float p = (sv[i] > -1e29f) ? __expf(sv[i] - mx) : 0.f; l += p; ps[lane + 64 * i] = p; }
        l = wave_sum(l);
        LDS_WAIT(); asm volatile("" ::: "memory");
        float o0 = 0.f, o1 = 0.f;
        for (int e = 0; e < 387; ++e) { const float p = ps[e]; if (p != 0.f) { const int g = e / 129, o = e - g * 129 - 64, dil = (g == 0) ? 1 : (g == 1 ? 4 : 16), pp = t + dil * o;
                const unsigned vw = *(const unsigned*)(zv + (size_t)pp * W_ + h * HD + 2 * lane); o0 += p * bflo(vw); o1 += p * bfhi(vw); } }
        const float il = 1.0f / l;
        *(unsigned*)(br + (size_t)t * W_ + h * HD + 2 * lane) = pk2(o0 * il, o1 * il);
        LDS_WAIT(); asm volatile("" ::: "memory");
    }
}

typedef short bf16x8 __attribute__((ext_vector_type(8)));
__device__ __forceinline__ bf16* op_ptr(unsigned char* ws, int g) { return g < 2 ? (bf16*)(ws + WS_OP01) + (size_t)g * SEG : (bf16*)(ws + WS_OP2); }
typedef short s16x4 __attribute__((ext_vector_type(4)));
__device__ __forceinline__ bf16x8 tr_frag(const LAS bf16* T, int pitch, int r0, int c0, int lane) {
    const LAS bf16* p = T + (r0 + 8 * (lane >> 4) + ((lane & 15) >> 2)) * pitch + c0 + 4 * (lane & 3);
    const s16x4 x = __builtin_amdgcn_ds_read_tr16_b64_v4i16((LAS s16x4*)p), y = __builtin_amdgcn_ds_read_tr16_b64_v4i16((LAS s16x4*)(p + 4 * pitch));
    return __builtin_shufflevector(x, y, 0, 1, 2, 3, 4, 5, 6, 7);
}
__device__ __forceinline__ bf16x8 tr_frag_rs(const LAS bf16* T, int pitch, int r0, int rs, int c0, int lane) {
    const LAS bf16* p = T + (r0 + rs * (8 * (lane >> 4) + ((lane & 15) >> 2))) * pitch + c0 + 4 * (lane & 3);
    const s16x4 x = __builtin_amdgcn_ds_read_tr16_b64_v4i16((LAS s16x4*)p), y = __builtin_amdgcn_ds_read_tr16_b64_v4i16((LAS s16x4*)(p + 4 * rs * pitch));
    return __builtin_shufflevector(x, y, 0, 1, 2, 3, 4, 5, 6, 7);
}
__device__ __forceinline__ size_t vt_off(int g, int h, int d, int rr, int Lg, int l) { return ((size_t)g * NHEAD + h) * ((size_t)S_ * HD) + (size_t)rr * Lg * HD + (size_t)(l >> 5) * (32 * HD) + d * 32 + (l & 31); }
__device__ __forceinline__ void ph_attn_vt(unsigned char* ws, LAS unsigned char* lds, int bid, int nb, int tid, int wave, int lane) {
    const bf16* zv = (const bf16*)(ws + WS_Z) + 10 * SEG; bf16* VT = (bf16*)(ws + WS_VT);
    LAS bf16* T = (LAS bf16*)lds; const int n = lane & 15, G = lane >> 4;
    for (int unit = bid; unit < NHEAD * (S_ / 256); unit += nb) { const int h = unit & 7, t0 = (unit >> 3) * 256;
#pragma unroll
        for (int ps = 0; ps < 8; ++ps) { const int i = (tid >> 4) + 32 * ps, c = tid & 15;
            *(LAS v4u*)(T + i * 136 + 8 * c) = *(const v4u*)(zv + (size_t)(t0 + i) * W_ + h * HD + 8 * c); }
        __syncthreads();
#pragma unroll
        for (int g = 0; g < 3; ++g) { const int dsh = 2 * g, dil = 1 << dsh, Lg = S_ >> dsh;
#pragma unroll
            for (int q = 0; q < 8; ++q) {
                const int runs = 8 >> dsh;
                if (g < 2) { const int rr = q / runs, run = q % runs;
                    const bf16x8 v = tr_frag_rs(T, 136, rr + 32 * run * dil, dil, 16 * wave, lane);
                    *(v4u*)(VT + vt_off(g, h, 16 * wave + n, rr, Lg, (t0 >> dsh) + 32 * run + 8 * G)) = __builtin_bit_cast(v4u, v); }
                else {
                    const int rr = 2 * q + (G >> 1);
                    const LAS bf16* p = T + (rr + 16 * (8 * (G & 1) + ((lane & 15) >> 2))) * 136 + 16 * wave + 4 * (lane & 3);
                    const s16x4 x = __builtin_amdgcn_ds_read_tr16_b64_v4i16((LAS s16x4*)p), y = __builtin_amdgcn_ds_read_tr16_b64_v4i16((LAS s16x4*)(p + 4 * 16 * 136));
                    const bf16x8 v = __builtin_shufflevector(x, y, 0, 1, 2, 3, 4, 5, 6, 7);
                    *(v4u*)(VT + vt_off(g, h, 16 * wave + n, rr, Lg, (t0 >> dsh) + 8 * (G & 1))) = __builtin_bit_cast(v4u, v); } } }
        __syncthreads();
    }
}
__device__ __forceinline__ void ph_attn_main(unsigned char* ws, int bid, int nb, int wave, int lane) {
    const bf16* QR = (const bf16*)(ws + WS_Z) + 8 * SEG; const bf16* KR = QR + SEG; const bf16* VT = (const bf16*)(ws + WS_VT); float2* ML = (float2*)(ws + WS_ML);
    const int n = lane & 15, G = lane >> 4;
    const int vb = (nb & 7) == 0 ? (bid & 7) * (nb >> 3) + (bid >> 3) : bid;
    for (int unit = vb * NWAVES + wave; unit < 3 * 4096; unit += nb * NWAVES) {
        const int g = unit >> 12, u = unit & 4095, dsh = 2 * g, Lg = S_ >> dsh, nqb = Lg >> 5, h = u >> 9, rr = (u & 511) / nqb, qb = (u & 511) - rr * nqb;
        bf16x8 bq[2][4];
#pragma unroll
        for (int qk = 0; qk < 2; ++qk) { const unsigned qofs = (unsigned)((((32 * qb + 16 * qk + n) << dsh) + rr) * (W_ * 2) + h * (HD * 2) + 16 * G);
#pragma unroll
            for (int kk = 0; kk < 4; ++kk) bq[qk][kk] = *(const bf16x8*)((const char*)QR + qofs + 64 * kk); }
        f32x4 acc[8][2]; float mrun[2] = {-1e30f, -1e30f}, lsum[2] = {0.f, 0.f};
#pragma unroll
        for (int db = 0; db < 8; ++db) { acc[db][0] = (f32x4){0.f, 0.f, 0.f, 0.f}; acc[db][1] = (f32x4){0.f, 0.f, 0.f, 0.f}; }
        const bf16* vtb = VT + vt_off(g, h, n, rr, Lg, 8 * G);
#define ATT_LDK(dst, kbase_) do { _Pragma("unroll") for (int b = 0; b < 2; ++b) { int lk = (kbase_) + 8 * (n >> 2) + 4 * b + (n & 3); lk = lk < 0 ? 0 : (lk >= Lg ? Lg - 1 : lk); \
            const unsigned kofs_ = (unsigned)(((lk << dsh) + rr) * (W_ * 2) + h * (HD * 2) + 16 * G); _Pragma("unroll") for (int kk = 0; kk < 4; ++kk) dst[b][kk] = *(const bf16x8*)((const char*)KR + kofs_ + 64 * kk); } } while (0)
        bf16x8 ak[2][2][4];
        const int koff = (5 - qb % 5) % 5;
#define ATT_SIDX(i_) (((i_) + koff) >= 5 ? (i_) + koff - 5 : (i_) + koff)
        ATT_LDK(ak[0], 32 * qb - 64 + 32 * ATT_SIDX(0));
#pragma unroll
        for (int step = 0; step < 5; ++step) { const int kbase = 32 * qb - 64 + 32 * ATT_SIDX(step), cb = step & 1;
            int kblk = kbase >> 5; kblk = kblk < 0 ? 0 : (kblk > (Lg >> 5) - 1 ? (Lg >> 5) - 1 : kblk);
            bf16x8 av[8]; const bf16* vstep = vtb + (size_t)kblk * (32 * HD);
#pragma unroll
            for (int db = 0; db < 8; ++db) av[db] = *(const bf16x8*)(vstep + db * 512);
#if ATT_EXP == 1
            if (step < 4) { _Pragma("unroll") for (int b_ = 0; b_ < 2; ++b_) _Pragma("unroll") for (int k_ = 0; k_ < 4; ++k_) ak[cb ^ 1][b_][k_] = ak[cb][b_][k_]; }
#else
            if (step < 4) ATT_LDK(ak[cb ^ 1], 32 * qb - 64 + 32 * ATT_SIDX(step + 1));
#endif
            f32x4 st[2][2];
#pragma unroll
            for (int b = 0; b < 2; ++b)
#pragma unroll
                for (int qk = 0; qk < 2; ++qk) { f32x4 s = (f32x4){0.f, 0.f, 0.f, 0.f};
#pragma unroll
                    for (int kk = 0; kk < 4; ++kk) s = __builtin_amdgcn_mfma_f32_16x16x32_bf16(ak[cb][b][kk], bq[qk][kk], s, 0, 0, 0);
                    st[qk][b] = s; }
            bf16x8 pb[2];
#pragma unroll
            for (int qk = 0; qk < 2; ++qk) { const int lq = 32 * qb + 16 * qk + n; float sv[8]; float mx = mrun[qk];
#pragma unroll
                for (int j = 0; j < 8; ++j) { const int lk = kbase + 8 * G + j; const int df = lk - lq; const bool valid = (lk >= 0) && (lk < Lg) && (df <= 64) && (df >= -64);
                    sv[j] = valid ? st[qk][j >> 2][j & 3] : -1e30f; mx = fmaxf(mx, sv[j]); }
                mx = fmaxf(mx, mk_bperm(lane ^ 16, mx)); mx = fmaxf(mx, mk_bperm(lane ^ 32, mx));
                const float alpha = __expf(mrun[qk] - mx); mrun[qk] = mx; float ps = 0.f; float p[8];
#pragma unroll
                for (int j = 0; j < 8; ++j) { p[j] = sv[j] > -1e29f ? __expf(sv[j] - mx) : 0.f; ps += p[j]; }
                lsum[qk] = lsum[qk] * alpha + ps;
                v4u pw; pw.x = cvtpk(p[0], p[1]); pw.y = cvtpk(p[2], p[3]); pw.z = cvtpk(p[4], p[5]); pw.w = cvtpk(p[6], p[7]); pb[qk] = __builtin_bit_cast(bf16x8, pw);
#pragma unroll
                for (int db = 0; db < 8; ++db) acc[db][qk] = acc[db][qk] * alpha; }
#pragma unroll
            for (int db = 0; db < 8; ++db) {
                acc[db][0] = __builtin_amdgcn_mfma_f32_16x16x32_bf16(av[db], pb[0], acc[db][0], 0, 0, 0); acc[db][1] = __builtin_amdgcn_mfma_f32_16x16x32_bf16(av[db], pb[1], acc[db][1], 0, 0, 0); }
        }
#undef ATT_LDK
#undef ATT_SIDX
        bf16* OP = op_ptr(ws, g);
#pragma unroll
        for (int qk = 0; qk < 2; ++qk) { float l = lsum[qk]; l += mk_bperm(lane ^ 16, l); l += mk_bperm(lane ^ 32, l); const float il = 1.0f / l;
            const size_t tq = ((size_t)(32 * qb + 16 * qk + n) << dsh) + rr;
#pragma unroll
            for (int db = 0; db < 8; ++db) { const f32x4 o = acc[db][qk] * il; v2u w; w.x = cvtpk(o[0], o[1]); w.y = cvtpk(o[2], o[3]); *(v2u*)(OP + tq * W_ + h * HD + 16 * db + 4 * G) = w; }
            if (G == 0) ML[((size_t)g * S_ + tq) * NHEAD + h] = make_float2(mrun[qk], l); }
    }
}
__device__ __forceinline__ void ph_attn_comb(unsigned char* ws, int bid, int nb, int tid) {
    const float2* ML = (const float2*)(ws + WS_ML); bf16* br = (bf16*)(ws + WS_BR) + 3 * SEG;
    const bf16* O0 = op_ptr(ws, 0); const bf16* O1 = op_ptr(ws, 1); const bf16* O2 = op_ptr(ws, 2);
#pragma unroll 4
    for (size_t i = (size_t)bid * NTHR + tid; i < SEG / 8; i += (size_t)nb * NTHR) { const size_t e = i * 8; const int t = (int)(e >> 10), h = (int)((e >> 7) & 7);
        const float2 a0 = ML[((size_t)0 * S_ + t) * NHEAD + h], a1 = ML[((size_t)1 * S_ + t) * NHEAD + h], a2 = ML[((size_t)2 * S_ + t) * NHEAD + h];
        const float M = fmaxf(a0.x, fmaxf(a1.x, a2.x)); float w0 = __expf(a0.x - M) * a0.y, w1 = __expf(a1.x - M) * a1.y, w2 = __expf(a2.x - M) * a2.y; const float iw = 1.0f / (w0 + w1 + w2); w0 *= iw; w1 *= iw; w2 *= iw;
        const v4u x0 = *(const v4u*)(O0 + e), x1 = *(const v4u*)(O1 + e), x2 = *(const v4u*)(O2 + e); v4u o;
        o.x = pk2(w0 * bflo(x0.x) + w1 * bflo(x1.x) + w2 * bflo(x2.x), w0 * bfhi(x0.x) + w1 * bfhi(x1.x) + w2 * bfhi(x2.x));
        o.y = pk2(w0 * bflo(x0.y) + w1 * bflo(x1.y) + w2 * bflo(x2.y), w0 * bfhi(x0.y) + w1 * bfhi(x1.y) + w2 * bfhi(x2.y));
        o.z = pk2(w0 * bflo(x0.z) + w1 * bflo(x1.z) + w2 * bflo(x2.z), w0 * bfhi(x0.z) + w1 * bfhi(x1.z) + w2 * bfhi(x2.z));
        o.w = pk2(w0 * bflo(x0.w) + w1 * bflo(x1.w) + w2 * bflo(x2.w), w0 * bfhi(x0.w) + w1 * bfhi(x1.w) + w2 * bfhi(x2.w));
        *(v4u*)(br + e) = o; }
}

__device__ __forceinline__ void unpack16(const v4u w0, const v4u w1, float (&o)[16]) { const unsigned ww[8] = {w0.x, w0.y, w0.z, w0.w, w1.x, w1.y, w1.z, w1.w};
#pragma unroll
    for (int i = 0; i < 8; ++i) { o[2 * i] = bflo(ww[i]); o[2 * i + 1] = bfhi(ww[i]); } }
__device__ __forceinline__ void pack16_store(LAS bf16* dst, const float (&v)[16]) { v4u o0, o1; o0.x = cvtpk(v[0], v[1]); o0.y = cvtpk(v[2], v[3]); o0.z = cvtpk(v[4], v[5]); o0.w = cvtpk(v[6], v[7]);
    o1.x = cvtpk(v[8], v[9]); o1.y = cvtpk(v[10], v[11]); o1.z = cvtpk(v[12], v[13]); o1.w = cvtpk(v[14], v[15]); *(LAS v4u*)dst = o0; *(LAS v4u*)(dst + 8) = o1; }
__device__ __forceinline__ void pack8_store(LAS bf16* dst, const float* v) { v4u o; o.x = cvtpk(v[0], v[1]); o.y = cvtpk(v[2], v[3]); o.z = cvtpk(v[4], v[5]); o.w = cvtpk(v[6], v[7]); *(LAS v4u*)dst = o; }
__device__ __forceinline__ void hg_gate_scan(const v4u za, const v4u zb, const LAS float* lb8, int lane, float (&lf)[16], float (&kk)[16]) {
    float zv[16]; unpack16(za, zb, zv);
    const f32x4 l0 = *(const LAS f32x4*)lb8, l1 = *(const LAS f32x4*)(lb8 + 4); const float lb[8] = {l0[0], l0[1], l0[2], l0[3], l1[0], l1[1], l1[2], l1[3]};
#pragma unroll
    for (int e = 0; e < 16; ++e) { const float l = lb[e & 7]; const float f = l + (1.0f - l) * __builtin_amdgcn_rcpf(1.0f + __expf(-zv[e])); kk[e] = 1.0f - f; lf[e] = __logf(f); }
#pragma unroll
    for (int i = 0; i < 8; ++i) { lf[8 + i] += lf[i]; float t = lf[8 + i];
        float v = mk_bperm((lane - 16) & 63, t); t += (lane >= 16) ? v : 0.f; v = mk_bperm((lane - 32) & 63, t); t += (lane >= 32) ? v : 0.f;
        const float ex = t - lf[8 + i]; lf[i] += ex; lf[8 + i] = t; }
}
__device__ __forceinline__ void ph_hgrn_h1(unsigned char* ws, LAS unsigned char* lds, int L, int bid, int nb, int tid, int wave, int lane) {
    const bf16* z = (const bf16*)(ws + WS_Z); const float* lbp = (const float*)(ws + WS_LB) + L * 2 * W_;
    bf16* HST = (bf16*)(ws + WS_HST); float* HDEC = (float*)(ws + WS_HDEC);
    LAS float* WT = (LAS float*)lds; LAS bf16* KD = (LAS bf16*)(lds + 4096); LAS bf16* IS = (LAS bf16*)(lds + 21504); LAS float* LB = (LAS float*)(lds + 38912);
    const int jp = tid >> 4, ja = 2 * jp, k0 = (tid & 15) * 8, n = lane & 15, G = lane >> 4;
    if (bid >= 256 * NHEAD) return;
    const bool fixed_head = (nb & 7) == 0;
    if (fixed_head && tid < 256) LB[tid] = lbp[(tid >> 7) * W_ + (bid & 7) * HD + (tid & 127)];
    v4u pf[4];
#define H1_FETCH(item_, dir_) do { const int c_ = (item_) >> 3, h_ = (item_) & 7; const size_t oa_ = (size_t)(c_ * 64 + ((dir_) ? 63 - ja : ja)) * W_ + h_ * HD + k0, ob_ = (size_t)(c_ * 64 + ((dir_) ? 62 - ja : ja + 1)) * W_ + h_ * HD + k0; \
        pf[0] = *(const v4u*)(z + (size_t)(1 + (dir_)) * SEG + oa_); pf[1] = *(const v4u*)(z + (size_t)(1 + (dir_)) * SEG + ob_); pf[2] = *(const v4u*)(z + (size_t)3 * SEG + oa_); pf[3] = *(const v4u*)(z + (size_t)3 * SEG + ob_); } while (0)
    H1_FETCH(bid, 0);
    for (int item = bid; item < 256 * NHEAD; item += nb) { const int c = item >> 3, h = item & 7;
        if (!fixed_head) { __syncthreads(); if (tid < 256) LB[tid] = lbp[(tid >> 7) * W_ + h * HD + (tid & 127)]; __syncthreads(); }
#pragma unroll 1
        for (int dir = 0; dir < 2; ++dir) {
            const v4u f0 = pf[0], f1 = pf[1], i0 = pf[2], i1 = pf[3];
            if (dir == 0) H1_FETCH(item, 1); else if (item + nb < 256 * NHEAD) H1_FETCH(item + nb, 0);
            if (dir == 0 && item == bid) __syncthreads();
            float lf[16], kk[16]; hg_gate_scan(f0, f1, LB + dir * 128 + k0, lane, lf, kk);
            if (G == 3) { *(LAS f32x4*)(WT + wave * 128 + k0) = (f32x4){lf[8], lf[9], lf[10], lf[11]}; *(LAS f32x4*)(WT + wave * 128 + k0 + 4) = (f32x4){lf[12], lf[13], lf[14], lf[15]}; }
            __syncthreads();
            *(LAS v4u*)(IS + ja * 136 + k0) = i0; *(LAS v4u*)(IS + (ja + 1) * 136 + k0) = i1;
            { float pre[8], tot[8];
#pragma unroll
              for (int i = 0; i < 8; ++i) { pre[i] = 0.f; tot[i] = 0.f; }
#pragma unroll
              for (int w = 0; w < 8; ++w)
#pragma unroll
                  for (int q = 0; q < 2; ++q) { const f32x4 t4 = *(const LAS f32x4*)(WT + w * 128 + k0 + 4 * q);
#pragma unroll
                      for (int e = 0; e < 4; ++e) { tot[4 * q + e] += t4[e]; if (w < wave) pre[4 * q + e] += t4[e]; } }
              float kd[16];
#pragma unroll
              for (int e = 0; e < 16; ++e) kd[e] = kk[e] * __expf(tot[e & 7] - (lf[e] + pre[e & 7]));
              pack8_store(KD + ja * 136 + k0, kd); pack8_store(KD + (ja + 1) * 136 + k0, kd + 8);
              if (jp == 0) { float* hd = HDEC + (((size_t)dir * 256 + c) * 8 + h) * 128 + k0;
                  *(f32x4*)hd = (f32x4){__expf(tot[0]), __expf(tot[1]), __expf(tot[2]), __expf(tot[3])}; *(f32x4*)(hd + 4) = (f32x4){__expf(tot[4]), __expf(tot[5]), __expf(tot[6]), __expf(tot[7])}; } }
            __syncthreads();
            if (HG_EXP != 2) { const bf16x8 a0 = tr_frag(KD, 136, 0, 16 * wave, lane), a1 = tr_frag(KD, 136, 32, 16 * wave, lane);
              bf16* dst = HST + ((((size_t)dir * 256 + c) * 8 + h) * 128) * 128 + (wave >> 1) * 4096 + 16 * (wave & 1) + 4 * G;
#pragma unroll
              for (int vb = 0; vb < 8; ++vb) { const bf16x8 b0 = tr_frag(IS, 136, 0, 16 * vb, lane), b1 = tr_frag(IS, 136, 32, 16 * vb, lane);
                  f32x4 u = (f32x4){0.f, 0.f, 0.f, 0.f}; u = __builtin_amdgcn_mfma_f32_16x16x32_bf16(a0, b0, u, 0, 0, 0); u = __builtin_amdgcn_mfma_f32_16x16x32_bf16(a1, b1, u, 0, 0, 0);
                  v2u w; w.x = cvtpk(u[0], u[1]); w.y = cvtpk(u[2], u[3]); *(v2u*)(dst + (16 * vb + n) * 32) = w; } }
        }
    }
    __syncthreads();
#undef H1_FETCH
}
__device__ __forceinline__ void ph_hgrn_h2(unsigned char* ws, int bid, int nb, int tid) {
    unsigned* HST = (unsigned*)(ws + WS_HST); const float2* HDEC = (const float2*)(ws + WS_HDEC);
    for (int g = bid * NTHR + tid; g < 131072; g += nb * NTHR) { const int kp = g & 63, v = (g >> 6) & 127, h = (g >> 13) & 7, dir = g >> 16;
        const int kq = (((v >> 5) & 3) << 4) | (kp & 15);
        unsigned* base = HST + ((size_t)dir * 256 * 8 + h) * 8192 + v * 64 + kp; const float2* dec = HDEC + ((size_t)dir * 256 * 8 + h) * 64 + kq;
        float s0 = 0.f, s1 = 0.f;
        for (int cc = 0; cc < 256; cc += 8) { unsigned u[8]; float2 d[8];
#pragma unroll
            for (int j = 0; j < 8; ++j) { const int c = dir ? 255 - (cc + j) : cc + j; u[j] = base[(size_t)c * 65536]; d[j] = dec[(size_t)c * 512]; }
#pragma unroll
            for (int j = 0; j < 8; ++j) { const int c = dir ? 255 - (cc + j) : cc + j; s0 = d[j].x * s0 + bflo(u[j]); s1 = d[j].y * s1 + bfhi(u[j]); base[(size_t)c * 65536] = pk2(s0, s1); } }
    }
}
__device__ __forceinline__ void ph_hgrn_h3(unsigned char* ws, LAS unsigned char* lds, const float* onorm, int L, int bid, int nb, int tid, int wave, int lane) {
    const bf16* z = (const bf16*)(ws + WS_Z); const float* lbp = (const float*)(ws + WS_LB) + L * 2 * W_; const bf16* HST = (const bf16*)(ws + WS_HST); bf16* br = (bf16*)(ws + WS_BR);
    LAS float* WT = (LAS float*)lds; LAS bf16* QB = (LAS bf16*)(lds + 4096); LAS bf16* QT = (LAS bf16*)(lds + 21504); LAS bf16* KT = (LAS bf16*)(lds + 38912); LAS bf16* IS = (LAS bf16*)(lds + 82432);
    LAS float* RED = (LAS float*)(lds + 99840); LAS float* LB = (LAS float*)(lds + 101888);
    const int jp = tid >> 4, ja = 2 * jp, k0 = (tid & 15) * 8, n = lane & 15, G = lane >> 4, si = wave >> 1;
    if (bid >= 256 * NHEAD) return;
    const bool fixed_head = (nb & 7) == 0;
    if (fixed_head && tid < 256) LB[tid] = lbp[(tid >> 7) * W_ + (bid & 7) * HD + (tid & 127)];
    v4u pf[6];
#define H3_FETCH(item_, dir_) do { const int c_ = (item_) >> 3, h_ = (item_) & 7; const size_t oa_ = (size_t)(c_ * 64 + ((dir_) ? 63 - ja : ja)) * W_ + h_ * HD + k0, ob_ = (size_t)(c_ * 64 + ((dir_) ? 62 - ja : ja + 1)) * W_ + h_ * HD + k0; \
        pf[0] = *(const v4u*)(z + (size_t)(1 + (dir_)) * SEG + oa_); pf[1] = *(const v4u*)(z + (size_t)(1 + (dir_)) * SEG + ob_); pf[2] = *(const v4u*)(z + oa_); pf[3] = *(const v4u*)(z + ob_); \
        pf[4] = *(const v4u*)(z + (size_t)3 * SEG + oa_); pf[5] = *(const v4u*)(z + (size_t)3 * SEG + ob_); } while (0)
    H3_FETCH(bid, 0);
    for (int item = bid; item < 256 * NHEAD; item += nb) { const int c = item >> 3, h = item & 7, t0 = c * 64;
        if (!fixed_head) { __syncthreads(); if (tid < 256) LB[tid] = lbp[(tid >> 7) * W_ + h * HD + (tid & 127)]; __syncthreads(); }
        v2u gpre[4];
#pragma unroll
        for (int x = 0; x < 4; ++x) gpre[x] = *(const v2u*)(z + (size_t)4 * SEG + (size_t)(t0 + 16 * x + n) * W_ + h * HD + 16 * wave + 4 * G);
        f32x4 acc[4];
#pragma unroll
        for (int x = 0; x < 4; ++x) acc[x] = (f32x4){0.f, 0.f, 0.f, 0.f};
#pragma unroll 1
        for (int dir = 0; dir < 2; ++dir) {
            const v4u f0 = pf[0], f1 = pf[1], q0 = pf[2], q1 = pf[3], i0 = pf[4], i1 = pf[5];
            if (dir == 0) H3_FETCH(item, 1); else if (item + nb < 256 * NHEAD) H3_FETCH(item + nb, 0);
            const int cs = dir ? c + 1 : c - 1; const bool has_state = (cs >= 0 && cs < 256);
            bf16x8 as[4];
            if (has_state) { const bf16* sp = HST + (((size_t)dir * 256 + cs) * 8 + h) * 16384 + (16 * wave + n) * 32 + 8 * G;
#pragma unroll
                for (int ks = 0; ks < 4; ++ks) as[ks] = *(const bf16x8*)(sp + 4096 * ks); }
            if (dir == 0 && item == bid) __syncthreads();
            float lf[16], kk[16]; hg_gate_scan(f0, f1, LB + dir * 128 + k0, lane, lf, kk);
            if (G == 3) { *(LAS f32x4*)(WT + wave * 128 + k0) = (f32x4){lf[8], lf[9], lf[10], lf[11]}; *(LAS f32x4*)(WT + wave * 128 + k0 + 4) = (f32x4){lf[12], lf[13], lf[14], lf[15]}; }
            __syncthreads();
            *(LAS v4u*)(IS + ja * 136 + k0) = i0; *(LAS v4u*)(IS + (ja + 1) * 136 + k0) = i1;
            { float qs[16]; unpack16(q0, q1, qs);
#pragma unroll
              for (int e = 0; e < 16; ++e) qs[e] = qs[e] * __builtin_amdgcn_rcpf(1.0f + __expf(-qs[e]));
#pragma unroll
              for (int w = 0; w < 7; ++w) { if (w < wave) {
#pragma unroll
                  for (int q = 0; q < 2; ++q) { const f32x4 t4 = *(const LAS f32x4*)(WT + w * 128 + k0 + 4 * q);
#pragma unroll
                      for (int e = 0; e < 4; ++e) { lf[4 * q + e] += t4[e]; lf[8 + 4 * q + e] += t4[e]; } } } }
              float tmp[16];
#pragma unroll
              for (int e = 0; e < 16; ++e) tmp[e] = qs[e] * __expf(lf[e]);
              pack8_store(QB + ja * 136 + k0, tmp); pack8_store(QB + (ja + 1) * 136 + k0, tmp + 8);
              float ref[8];
#pragma unroll
              for (int i = 0; i < 8; ++i) ref[i] = 0.f;
#pragma unroll
              for (int it = 0; it < 4; ++it) {
                  if (it > 0) {
#pragma unroll
                      for (int w = 2 * it - 2; w < 2 * it; ++w)
#pragma unroll
                          for (int q = 0; q < 2; ++q) { const f32x4 t4 = *(const LAS f32x4*)(WT + w * 128 + k0 + 4 * q); ref[4 * q] += t4[0]; ref[4 * q + 1] += t4[1]; ref[4 * q + 2] += t4[2]; ref[4 * q + 3] += t4[3]; } }
                  if (si == it) {
#pragma unroll
                      for (int e = 0; e < 16; ++e) tmp[e] = qs[e] * __expf(lf[e] - ref[e & 7]);
                      pack8_store(QT + ja * 136 + k0, tmp); pack8_store(QT + (ja + 1) * 136 + k0, tmp + 8); }
                  if (si <= it) {
#pragma unroll
                      for (int e = 0; e < 16; ++e) tmp[e] = kk[e] * __expf(fminf(ref[e & 7] - lf[e], 80.f));
                      pack8_store(KT + (8 * it * (it + 1) + ja) * 136 + k0, tmp); pack8_store(KT + (8 * it * (it + 1) + ja + 1) * 136 + k0, tmp + 8); } } }
            __syncthreads();
            if (has_state) {
#pragma unroll
                for (int x = 0; x < 4; ++x) { const int jt = dir ? 63 - 16 * x - n : 16 * x + n;
#pragma unroll
                    for (int ks = 0; ks < 4; ++ks) { const bf16x8 b = *(const LAS bf16x8*)(QB + jt * 136 + 32 * ks + 8 * G); acc[x] = __builtin_amdgcn_mfma_f32_16x16x32_bf16(as[ks], b, acc[x], 0, 0, 0); } } }
#pragma unroll
            for (int x = 0; x < 4; ++x) { const int jt = dir ? 63 - 16 * x - n : 16 * x + n; const int it = dir ? 3 - x : x; const int kb = 8 * it * (it + 1);
                bf16x8 bqt[4];
#pragma unroll
                for (int ks = 0; ks < 4; ++ks) bqt[ks] = *(const LAS bf16x8*)(QT + jt * 136 + 32 * ks + 8 * G);
#pragma unroll
                for (int p = 0; p < 2; ++p) { if (p <= (it >> 1)) {
                    float pv[8];
#pragma unroll
                    for (int b = 0; b < 2; ++b) { const int js = 32 * p + 8 * (n >> 2) + 4 * b + (n & 3); f32x4 sc = (f32x4){0.f, 0.f, 0.f, 0.f};
#pragma unroll
                        for (int ks = 0; ks < 4; ++ks) { const bf16x8 ak = *(const LAS bf16x8*)(KT + (kb + js) * 136 + 32 * ks + 8 * G); sc = __builtin_amdgcn_mfma_f32_16x16x32_bf16(ak, bqt[ks], sc, 0, 0, 0); }
#pragma unroll
                        for (int r = 0; r < 4; ++r) { const int jsr = 32 * p + 8 * G + 4 * b + r; pv[4 * b + r] = (jsr <= jt) ? sc[r] : 0.f; } }
                    v4u pw; pw.x = cvtpk(pv[0], pv[1]); pw.y = cvtpk(pv[2], pv[3]); pw.z = cvtpk(pv[4], pv[5]); pw.w = cvtpk(pv[6], pv[7]);
                    const bf16x8 av = tr_frag(IS, 136, 32 * p, 16 * wave, lane);
                    acc[x] = __builtin_amdgcn_mfma_f32_16x16x32_bf16(av, __builtin_bit_cast(bf16x8, pw), acc[x], 0, 0, 0); } } }
        }
#pragma unroll
        for (int x = 0; x < 4; ++x) { float ss = acc[x][0] * acc[x][0] + acc[x][1] * acc[x][1] + acc[x][2] * acc[x][2] + acc[x][3] * acc[x][3]; ss += mk_bperm(lane ^ 16, ss); ss += mk_bperm(lane ^ 32, ss); if (G == 0) RED[wave * 64 + 16 * x + n] = ss; }
        __syncthreads();
        { const int ch = h * HD + 16 * wave + 4 * G; const f32x4 on = *(const f32x4*)(onorm + ch);
#pragma unroll
          for (int x = 0; x < 4; ++x) { const int tl = 16 * x + n; float tot = 0.f;
#pragma unroll
            for (int w = 0; w < 8; ++w) tot += RED[w * 64 + tl];
            const float rs = rsqrtf(tot * (1.0f / HD) + RMS_EPS); const size_t o = (size_t)(t0 + tl) * W_ + ch; const v2u gw = gpre[x];
            v2u w; w.x = cvtpk(acc[x][0] * rs * on[0] * siluf_(bflo(gw.x)), acc[x][1] * rs * on[1] * siluf_(bfhi(gw.x))); w.y = cvtpk(acc[x][2] * rs * on[2] * siluf_(bflo(gw.y)), acc[x][3] * rs * on[3] * siluf_(bfhi(gw.y)));
            *(v2u*)(br + o) = w; } }
    }
    __syncthreads();
#undef H3_FETCH
}
template <int D> __device__ __forceinline__ float dpp_shr(float v, float old) { return __builtin_bit_cast(float, __builtin_amdgcn_update_dpp(__builtin_bit_cast(int, old), __builtin_bit_cast(int, v), 0x110 | D, 0xf, 0xf, false)); }
template <int D> __device__ __forceinline__ float dpp_shl(float v, float old) { return __builtin_bit_cast(float, __builtin_amdgcn_update_dpp(__builtin_bit_cast(int, old), __builtin_bit_cast(int, v), 0x100 | D, 0xf, 0xf, false)); }
template <bool BWD, int D> __device__ __forceinline__ void scan_step(float& av, float& uv) { const float al = BWD ? dpp_shl<D>(av, 1.0f) : dpp_shr<D>(av, 1.0f), ul = BWD ? dpp_shl<D>(uv, 0.0f) : dpp_shr<D>(uv, 0.0f); uv = av * ul + uv; av = al * av; }
template <bool FINAL>
__device__ __forceinline__ void ph_lru(const Args& a, unsigned char* ws, LAS unsigned char* lds, int L, int bid, int nb, int tid, int wave, int lane) {
    const bf16* zx = (const bf16*)(ws + WS_Z) + 5 * SEG; const bf16* zg = (const bf16*)(ws + WS_Z) + 6 * SEG; bf16* br = (bf16*)(ws + WS_BR) + SEG;
    const bf16* LW = (const bf16*)(ws + WS_LRUW); float2* LSUM = (float2*)(ws + WS_LSUM); const float* LCIN = (const float*)(ws + WS_LCIN);
    LAS bf16* XT = (LAS bf16*)lds; LAS bf16* XCB = (LAS bf16*)(lds + 19040); LAS float* CW = (LAS float*)(lds + 36448);
    const int tr = tid >> 3, c0 = (tid & 7) * 16, n = lane & 15, G = lane >> 4;
    if (bid >= 256 * NHEAD) return;
    const bool fixed_head = (nb & 7) == 0;
#define LRU_LOAD_PARAMS(hh_) do { for (int q = tid; q < 2 * 8 * 128; q += NTHR) { const int dir_ = q >> 10, j_ = (q >> 7) & 7, c_ = q & 127, ch_ = (hh_) * HD + c_, pi_ = (L * 2 + dir_) * W_ + ch_; float v_; \
            if (j_ < 4) v_ = a.lru_conv_w[((size_t)(L * 2 + dir_) * 4 + j_) * W_ + ch_]; else if (j_ == 4) v_ = a.lru_conv_b[pi_]; else if (j_ == 5) v_ = a.lru_ba[pi_]; else if (j_ == 6) v_ = a.lru_bx[pi_]; else v_ = log1pf(__expf(-a.lru_lambda[pi_])); \
            CW[q] = v_; } } while (0)
    if (fixed_head) LRU_LOAD_PARAMS(bid & 7);
    v4u xpre[3];
#define LRU_FETCH_X(item_) do { const int tile_ = (item_) >> 3, hh_ = (item_) & 7, t0_ = tile_ * 64; \
        _Pragma("unroll") for (int p = 0; p < 3; ++p) { const int q = tid + p * NTHR, row = q >> 4, c = q & 15, t = t0_ - 3 + row; xpre[p] = (v4u){0u, 0u, 0u, 0u}; \
            if (q < 70 * 16 && t >= 0 && t < S_) xpre[p] = *(const v4u*)(zx + (size_t)t * W_ + hh_ * HD + 8 * c); } } while (0)
    LRU_FETCH_X(bid);
    for (int item = bid; item < 256 * NHEAD; item += nb) { const int tile = item >> 3, hh = item & 7, t0 = tile * 64;
        if (!fixed_head) { __syncthreads(); LRU_LOAD_PARAMS(hh); }
#pragma unroll
        for (int p = 0; p < 3; ++p) { const int q = tid + p * NTHR, row = q >> 4, c = q & 15; if (q < 70 * 16) *(LAS v4u*)(XT + row * 136 + 8 * c) = xpre[p]; }
        if (item + nb < 256 * NHEAD) LRU_FETCH_X(item + nb);
        const int chl = hh * HD + 16 * wave + 4 * G;
        v2u gpre[4]; f32x4 cin[2];
        if (FINAL) {
#pragma unroll
            for (int tb = 0; tb < 4; ++tb) gpre[tb] = *(const v2u*)(zg + (size_t)(t0 + 16 * tb + n) * W_ + chl);
            cin[0] = *(const f32x4*)(LCIN + (size_t)(tile * 2 + 0) * W_ + chl); cin[1] = *(const f32x4*)(LCIN + (size_t)(tile * 2 + 1) * W_ + chl); }
        __syncthreads();
        f32x4 yacc[4];
#pragma unroll
        for (int tb = 0; tb < 4; ++tb) yacc[tb] = (f32x4){0.f, 0.f, 0.f, 0.f};
#pragma unroll 1
        for (int dir = 0; dir < 2; ++dir) {
            const bf16* wap = LW + ((size_t)((L * 2 + dir) * 8 + hh)) * 16384 + (16 * wave + n) * 128 + 8 * G; const bf16* wxp = wap + (size_t)64 * 16384;
            bf16x8 wA[4], wX[4];
#pragma unroll
            for (int ks = 0; ks < 4; ++ks) { wA[ks] = *(const bf16x8*)(wap + 32 * ks); wX[ks] = *(const bf16x8*)(wxp + 32 * ks); }
            { float xc[16]; const LAS float* cwl = CW + dir * 1024 + c0;
#pragma unroll
              for (int q = 0; q < 4; ++q) { const f32x4 b4 = *(const LAS f32x4*)(cwl + 4 * 128 + 4 * q); xc[4 * q] = b4[0]; xc[4 * q + 1] = b4[1]; xc[4 * q + 2] = b4[2]; xc[4 * q + 3] = b4[3]; }
#pragma unroll
              for (int j = 0; j < 4; ++j) { const int row = dir ? tr + 6 - j : tr + j;
                  const v4u w0 = *(const LAS v4u*)(XT + row * 136 + c0), w1 = *(const LAS v4u*)(XT + row * 136 + c0 + 8); const unsigned ww[8] = {w0.x, w0.y, w0.z, w0.w, w1.x, w1.y, w1.z, w1.w};
#pragma unroll
                  for (int q = 0; q < 4; ++q) { const f32x4 w4 = *(const LAS f32x4*)(cwl + j * 128 + 4 * q);
#pragma unroll
                      for (int e = 0; e < 4; ++e) { const int i = 4 * q + e; xc[i] += w4[e] * ((i & 1) ? bfhi(ww[i >> 1]) : bflo(ww[i >> 1])); } } }
              v4u o0, o1; o0.x = cvtpk(xc[0], xc[1]); o0.y = cvtpk(xc[2], xc[3]); o0.z = cvtpk(xc[4], xc[5]); o0.w = cvtpk(xc[6], xc[7]); o1.x = cvtpk(xc[8], xc[9]); o1.y = cvtpk(xc[10], xc[11]); o1.z = cvtpk(xc[12], xc[13]); o1.w = cvtpk(xc[14], xc[15]);
              *(LAS v4u*)(XCB + tr * 136 + c0) = o0; *(LAS v4u*)(XCB + tr * 136 + c0 + 8) = o1; }
            __syncthreads();
            { f32x4 ar[4], ai[4];
#pragma unroll
              for (int tb = 0; tb < 4; ++tb) { ar[tb] = (f32x4){0.f, 0.f, 0.f, 0.f}; ai[tb] = (f32x4){0.f, 0.f, 0.f, 0.f}; }
#pragma unroll
              for (int ks = 0; ks < 4; ++ks)
#pragma unroll
                  for (int tb = 0; tb < 4; ++tb) { const bf16x8 xf = *(const LAS bf16x8*)(XCB + (16 * tb + n) * 136 + 32 * ks + 8 * G);
                      ar[tb] = __builtin_amdgcn_mfma_f32_16x16x32_bf16(wA[ks], xf, ar[tb], 0, 0, 0); ai[tb] = __builtin_amdgcn_mfma_f32_16x16x32_bf16(wX[ks], xf, ai[tb], 0, 0, 0); }
              const LAS float* pl = CW + dir * 1024 + 16 * wave + 4 * G; const f32x4 ba = *(const LAS f32x4*)(pl + 5 * 128), bx = *(const LAS f32x4*)(pl + 6 * 128), sp = *(const LAS f32x4*)(pl + 7 * 128);
#pragma unroll
              for (int tb = 0; tb < 4; ++tb) { const v2u xw = *(const LAS v2u*)(XCB + (16 * tb + n) * 136 + 16 * wave + 4 * G); const float xv[4] = {bflo(xw.x), bfhi(xw.x), bflo(xw.y), bfhi(xw.y)};
#pragma unroll
                  for (int r = 0; r < 4; ++r) { const float rg = __builtin_amdgcn_rcpf(1.0f + __expf(-(ar[tb][r] + ba[r]))), ig = __builtin_amdgcn_rcpf(1.0f + __expf(-(ai[tb][r] + bx[r]))); const float la = -8.0f * rg * sp[r];
                      const float av = __expf(la); ar[tb][r] = av; ai[tb][r] = sqrtf(fmaxf(1.0f - av * av, 0.0f)) * (ig * xv[r]); } }
#pragma unroll
              for (int tb = 0; tb < 4; ++tb)
#pragma unroll
                  for (int r = 0; r < 4; ++r) { float av = ar[tb][r], uv = ai[tb][r];
                      if (dir == 0) { scan_step<false, 1>(av, uv); scan_step<false, 2>(av, uv); scan_step<false, 4>(av, uv); scan_step<false, 8>(av, uv); }
                      else { scan_step<true, 1>(av, uv); scan_step<true, 2>(av, uv); scan_step<true, 4>(av, uv); scan_step<true, 8>(av, uv); }
                      ar[tb][r] = av; ai[tb][r] = uv; }
              const int lastlane = (lane & 48) | (dir ? 0 : 15);
              f32x4 hc, pc = (f32x4){1.f, 1.f, 1.f, 1.f};
              if (FINAL) hc = dir ? cin[1] : cin[0]; else hc = (f32x4){0.f, 0.f, 0.f, 0.f};
#pragma unroll
              for (int s = 0; s < 4; ++s) { const int tb = dir ? 3 - s : s;
                  { f32x4 at;
#pragma unroll
                  for (int r = 0; r < 4; ++r) { const float h = ar[tb][r] * hc[r] + ai[tb][r]; yacc[tb][r] += h; hc[r] = mk_bperm(lastlane, h);
                      if (!FINAL) { at[r] = ar[tb][r] * pc[r]; pc[r] = mk_bperm(lastlane, at[r]); } }
                  if (!FINAL) { v2u w; w.x = cvtpk(at[0], at[1]); w.y = cvtpk(at[2], at[3]); *(v2u*)((bf16*)(ws + (dir ? WS_LAB : WS_LAF)) + (size_t)(t0 + 16 * tb + n) * W_ + chl) = w; } } }
              if (!FINAL && n == 0) {
#pragma unroll
                  for (int r = 0; r < 4; ++r) LSUM[(size_t)(tile * 2 + dir) * W_ + chl + r] = make_float2(pc[r], hc[r]); } }
            __syncthreads();
        }
        if (!FINAL) {
#pragma unroll
            for (int tb = 0; tb < 4; ++tb) { v2u w; w.x = cvtpk(yacc[tb][0], yacc[tb][1]); w.y = cvtpk(yacc[tb][2], yacc[tb][3]); *(v2u*)((bf16*)(ws + WS_LSU) + (size_t)(t0 + 16 * tb + n) * W_ + chl) = w; } }
        if (FINAL) {
#pragma unroll
            for (int tb = 0; tb < 4; ++tb) { const size_t o = (size_t)(t0 + 16 * tb + n) * W_ + chl; const v2u gw = gpre[tb];
                v2u w; w.x = cvtpk(yacc[tb][0] * gelu_tanh(bflo(gw.x)), yacc[tb][1] * gelu_tanh(bfhi(gw.x))); w.y = cvtpk(yacc[tb][2] * gelu_tanh(bflo(gw.y)), yacc[tb][3] * gelu_tanh(bfhi(gw.y)));
                *(v2u*)(br + o) = w; } }
    }
    __syncthreads();
}

__device__ __forceinline__ void ph_lru_out(unsigned char* ws, int bid, int nb, int tid) {
    const bf16* SU = (const bf16*)(ws + WS_LSU); const bf16* AF = (const bf16*)(ws + WS_LAF); const bf16* AB = (const bf16*)(ws + WS_LAB); const float* LCIN = (const float*)(ws + WS_LCIN);
    const bf16* zg = (const bf16*)(ws + WS_Z) + 6 * SEG; bf16* br = (bf16*)(ws + WS_BR) + SEG;
#pragma unroll 4
    for (size_t i = (size_t)bid * NTHR + tid; i < SEG / 8; i += (size_t)nb * NTHR) { const size_t e = i * 8; const int t = (int)(e >> 10), ch = (int)(e & (W_ - 1)), tile = t >> 6;
        const v4u su = __builtin_nontemporal_load((const v4u*)(SU + e)), af = __builtin_nontemporal_load((const v4u*)(AF + e)), ab = __builtin_nontemporal_load((const v4u*)(AB + e)), gw = __builtin_nontemporal_load((const v4u*)(zg + e));
        const f32x4 hf0 = *(const f32x4*)(LCIN + (size_t)(tile * 2) * W_ + ch), hf1 = *(const f32x4*)(LCIN + (size_t)(tile * 2) * W_ + ch + 4), hb0 = *(const f32x4*)(LCIN + (size_t)(tile * 2 + 1) * W_ + ch), hb1 = *(const f32x4*)(LCIN + (size_t)(tile * 2 + 1) * W_ + ch + 4);
        float s[8], f[8], b[8], g[8]; unpack8(su, s); unpack8(af, f); unpack8(ab, b); unpack8(gw, g);
        const float hf[8] = {hf0[0], hf0[1], hf0[2], hf0[3], hf1[0], hf1[1], hf1[2], hf1[3]}, hb[8] = {hb0[0], hb0[1], hb0[2], hb0[3], hb1[0], hb1[1], hb1[2], hb1[3]};
        float y[8];
#pragma unroll
        for (int j = 0; j < 8; ++j) y[j] = (s[j] + f[j] * hf[j] + b[j] * hb[j]) * gelu_tanh(g[j]);
        v4u o; o.x = cvtpk(y[0], y[1]); o.y = cvtpk(y[2], y[3]); o.z = cvtpk(y[4], y[5]); o.w = cvtpk(y[6], y[7]);
        *(v4u*)(br + e) = o; }
}
__device__ __forceinline__ void ph_lru_carry(unsigned char* ws, LAS unsigned char* lds, int bid, int tid, int wave, int lane) {
    if (bid >= 32) return;
    const int chain = bid * 64 + lane, dir = chain >> 10, ch = chain & (W_ - 1), seg = wave; const float2* LSUM = (const float2*)(ws + WS_LSUM); float* LCIN = (float*)(ws + WS_LCIN);
    LAS f32x2_t* SEGS = (LAS f32x2_t*)lds;
    float2 sv[32];
#pragma unroll
    for (int i = 0; i < 32; ++i) { const int kp = 32 * seg + i, k = dir ? 255 - kp : kp; sv[i] = LSUM[(size_t)(k * 2 + dir) * W_ + ch]; }
    float p = 1.f, h = 0.f;
#pragma unroll
    for (int i = 0; i < 32; ++i) { h = sv[i].x * h + sv[i].y; p *= sv[i].x; }
    SEGS[seg * 64 + lane] = (f32x2_t){p, h};
    __syncthreads();
    float c = 0.f;
#pragma unroll
    for (int s = 0; s < 7; ++s) { if (s < seg) { const f32x2_t q = SEGS[s * 64 + lane]; c = q[0] * c + q[1]; } }
#pragma unroll
    for (int i = 0; i < 32; ++i) { const int kp = 32 * seg + i, k = dir ? 255 - kp : kp; LCIN[(size_t)(k * 2 + dir) * W_ + ch] = c; c = sv[i].x * c + sv[i].y; }
    __syncthreads();
}
__device__ __forceinline__ void ph_pool(const Args& a, unsigned char* ws, LAS unsigned char* lds, int L, int bid, int nb, int tid, int wave, int lane) {
    const bf16* zp = (const bf16*)(ws + WS_Z) + 7 * SEG; bf16* br = (bf16*)(ws + WS_BR) + 2 * SEG; const bf16* PW = (const bf16*)(ws + WS_POOLW);
    LAS bf16* XP = (LAS bf16*)lds; LAS bf16* DT = (LAS bf16*)(lds + 42240);
    const int tr = tid >> 3, c0 = (tid & 7) * 32, n = lane & 15, G = lane >> 4;
    for (int item = bid; item < 256 * 4; item += nb) { const int tile = item >> 2, gi = item & 3, t0 = tile * 64, w2 = 1 << gi;
        for (int q = tid; q < 80 * 32; q += NTHR) { const int row = q >> 5, c = q & 31, t = t0 - 8 + row; v4u v = (v4u){0u, 0u, 0u, 0u};
            if (t >= 0 && t < S_) v = *(const v4u*)(zp + (size_t)t * W_ + gi * 256 + 8 * c);
            *(LAS v4u*)(XP + row * 264 + 8 * c) = v; }
        __syncthreads();
        { const int t = t0 + tr, lo = max(t - w2, 0), hi = min(t + w2, S_); const float ic = 1.0f / (float)(hi - lo); float sm[32];
#pragma unroll
          for (int i = 0; i < 32; ++i) sm[i] = 0.f;
          for (int tt = lo; tt < hi; ++tt) { const LAS bf16* xr = XP + (tt - t0 + 8) * 264 + c0;
#pragma unroll
              for (int q = 0; q < 4; ++q) { const v4u w = *(const LAS v4u*)(xr + 8 * q);
                  sm[8 * q + 0] += bflo(w.x); sm[8 * q + 1] += bfhi(w.x); sm[8 * q + 2] += bflo(w.y); sm[8 * q + 3] += bfhi(w.y); sm[8 * q + 4] += bflo(w.z); sm[8 * q + 5] += bfhi(w.z); sm[8 * q + 6] += bflo(w.w); sm[8 * q + 7] += bfhi(w.w); } }
          const LAS bf16* xs = XP + (tr + 8) * 264 + c0;
#pragma unroll
          for (int q = 0; q < 4; ++q) { const v4u w = *(const LAS v4u*)(xs + 8 * q); v4u o;
              o.x = cvtpk(sm[8 * q + 0] * ic - bflo(w.x), sm[8 * q + 1] * ic - bfhi(w.x)); o.y = cvtpk(sm[8 * q + 2] * ic - bflo(w.y), sm[8 * q + 3] * ic - bfhi(w.y));
              o.z = cvtpk(sm[8 * q + 4] * ic - bflo(w.z), sm[8 * q + 5] * ic - bfhi(w.z)); o.w = cvtpk(sm[8 * q + 6] * ic - bflo(w.w), sm[8 * q + 7] * ic - bfhi(w.w));
              *(LAS v4u*)(DT + tr * 264 + c0 + 8 * q) = o; } }
        __syncthreads();
        { f32x4 acc[2][4];
#pragma unroll
          for (int x = 0; x < 2; ++x)
#pragma unroll
              for (int y = 0; y < 4; ++y) acc[x][y] = (f32x4){0.f, 0.f, 0.f, 0.f};
          const bf16* wp = PW + ((size_t)(L * 4 + gi) * 256 + 32 * wave + n) * 256 + 8 * G;
#pragma unroll
          for (int ks = 0; ks < 8; ++ks) { const bf16x8 a0 = *(const bf16x8*)(wp + 32 * ks), a1 = *(const bf16x8*)(wp + 16 * 256 + 32 * ks);
#pragma unroll
              for (int y = 0; y < 4; ++y) { const bf16x8 bf = *(const LAS bf16x8*)(DT + (16 * y + n) * 264 + 32 * ks + 8 * G);
                  acc[0][y] = __builtin_amdgcn_mfma_f32_16x16x32_bf16(a0, bf, acc[0][y], 0, 0, 0); acc[1][y] = __builtin_amdgcn_mfma_f32_16x16x32_bf16(a1, bf, acc[1][y], 0, 0, 0); } }
#pragma unroll
          for (int x = 0; x < 2; ++x) { const int ch = gi * 256 + 32 * wave + 16 * x + 4 * G; const f32x4 sc = *(const f32x4*)(a.pool_scale + L * W_ + ch);
#pragma unroll
              for (int y = 0; y < 4; ++y) { const f32x4 o = acc[x][y] * sc; v2u w; w.x = cvtpk(o[0], o[1]); w.y = cvtpk(o[2], o[3]); *(v2u*)(br + (size_t)(t0 + 16 * y + n) * W_ + ch) = w; } } }
        __syncthreads();
    }
}
__device__ __forceinline__ void ph_merge(const Args& a, int bid, int nb, int tid) {
    const bf16* zg = (const bf16*)(a.ws + WS_ZG); const bf16* P = (const bf16*)(a.ws + WS_P); bf16* mg = (bf16*)(a.ws + WS_MERGED);
    for (size_t i = (size_t)bid * NTHR + tid; i < (size_t)S_ * (D_ / 8); i += (size_t)nb * NTHR) { const int t = (int)(i >> 8), c8 = (int)(i & 255) * 8; float acc[8];
#pragma unroll
        for (int j = 0; j < 8; ++j) acc[j] = 0.f;
#pragma unroll
        for (int g = 0; g < 4; ++g) { const v4u gw = *(const v4u*)(zg + (size_t)t * 4 * D_ + g * D_ + c8), pw = *(const v4u*)(P + (size_t)g * S_ * D_ + (size_t)t * D_ + c8);
            acc[0] += sigmoidf_(bflo(gw.x)) * bflo(pw.x); acc[1] += sigmoidf_(bfhi(gw.x)) * bfhi(pw.x); acc[2] += sigmoidf_(bflo(gw.y)) * bflo(pw.y); acc[3] += sigmoidf_(bfhi(gw.y)) * bfhi(pw.y);
            acc[4] += sigmoidf_(bflo(gw.z)) * bflo(pw.z); acc[5] += sigmoidf_(bfhi(gw.z)) * bfhi(pw.z); acc[6] += sigmoidf_(bflo(gw.w)) * bflo(pw.w); acc[7] += sigmoidf_(bfhi(gw.w)) * bfhi(pw.w); }
        v4u o; o.x = pk2(acc[0], acc[1]); o.y = pk2(acc[2], acc[3]); o.z = pk2(acc[4], acc[5]); o.w = pk2(acc[6], acc[7]);
        *(v4u*)(mg + (size_t)t * D_ + c8) = o; }
}
__device__ __forceinline__ void ph_convact(const Args& a, unsigned char* ws, int L, int bid, int nb, int tid) {
    const bf16* u = (const bf16*)(ws + WS_Z); bf16* act = (bf16*)(ws + WS_P);
    const float* cw = a.ffn_conv_w + (size_t)L * 3 * FF2; const float* cbp = a.ffn_conv_b + (size_t)L * FF2;
    constexpr int G8 = FF / 8, ROWS = 87;
    for (int g = bid * NTHR + tid; g < G8 * 190; g += nb * NTHR) { const int cg = g % G8, strip = g / G8, c8 = cg * 8, r0 = strip * ROWS, r1 = min(r0 + ROWS, S_);
        float wg[3][8], wv[3][8], bg[8], bv[8];
#pragma unroll
        for (int k = 0; k < 3; ++k) { const f32x4 x0 = *(const f32x4*)(cw + k * FF2 + c8), x1 = *(const f32x4*)(cw + k * FF2 + c8 + 4), y0 = *(const f32x4*)(cw + k * FF2 + FF + c8), y1 = *(const f32x4*)(cw + k * FF2 + FF + c8 + 4);
#pragma unroll
            for (int j = 0; j < 4; ++j) { wg[k][j] = x0[j]; wg[k][4 + j] = x1[j]; wv[k][j] = y0[j]; wv[k][4 + j] = y1[j]; } }
        { const f32x4 x0 = *(const f32x4*)(cbp + c8), x1 = *(const f32x4*)(cbp + c8 + 4), y0 = *(const f32x4*)(cbp + FF + c8), y1 = *(const f32x4*)(cbp + FF + c8 + 4);
#pragma unroll
          for (int j = 0; j < 4; ++j) { bg[j] = x0[j]; bg[4 + j] = x1[j]; bv[j] = y0[j]; bv[4 + j] = y1[j]; } }
        const v4u zero = (v4u){0u, 0u, 0u, 0u};
        const bf16* up = u + c8;
#define LDROW(t, G, V) do { if ((t) >= 0 && (t) < S_) { G = *(const v4u*)(up + (size_t)(t) * FF2); V = *(const v4u*)(up + (size_t)(t) * FF2 + FF); } else { G = zero; V = zero; } } while (0)
        v4u gp, vp, gc, vc, gn, vn, g2, v2, g3, v3;
        LDROW(r0 - 1, gp, vp); LDROW(r0, gc, vc); LDROW(r0 + 1, gn, vn); LDROW(r0 + 2, g2, v2); LDROW(r0 + 3, g3, v3);
        for (int t = r0; t < r1; ++t) {
            v4u g4, v4; LDROW(t + 4, g4, v4);
            float gpf[8], gcf[8], gnf[8], vpf[8], vcf[8], vnf[8]; unpack8(gp, gpf); unpack8(gc, gcf); unpack8(gn, gnf); unpack8(vp, vpf); unpack8(vc, vcf); unpack8(vn, vnf);
            float o[8];
#pragma unroll
            for (int j = 0; j < 8; ++j) { const float gt = bg[j] + wg[0][j] * gpf[j] + wg[1][j] * gcf[j] + wg[2][j] * gnf[j], vl = bv[j] + wv[0][j] * vpf[j] + wv[1][j] * vcf[j] + wv[2][j] * vnf[j];
                o[j] = gt * __builtin_amdgcn_rcpf(1.0f + __expf(-gt)) * vl; }
            v4u ow; ow.x = cvtpk(o[0], o[1]); ow.y = cvtpk(o[2], o[3]); ow.z = cvtpk(o[4], o[5]); ow.w = cvtpk(o[6], o[7]);
            *(v4u*)(act + (size_t)t * FF + c8) = ow;
            gp = gc; vp = vc; gc = gn; vc = vn; gn = g2; vn = v2; g2 = g3; v2 = v3; g3 = g4; v3 = v4; }
#undef LDROW
    }
}


__device__ __forceinline__ void ph_convfix(const Args& a, unsigned char* ws, int L, int bid, int nb, int tid) {
    const bf16* RAW = (const bf16*)(ws + WS_RAW); bf16* act = (bf16*)(ws + WS_P);
    const float* cw = a.ffn_conv_w + (size_t)L * 3 * FF2; const float* cbp = a.ffn_conv_b + (size_t)L * FF2;
    for (int i = bid * NTHR + tid; i < 65 * 2 * FF; i += nb * NTHR) { const int c = i % FF, rb = i / FF, b = rb >> 1, r = 256 * b - 1 + (rb & 1);
        if (r < 0 || r >= S_) continue;
        const int pn = c >> 7, cc = c & 127; float ug = cbp[c], uv = cbp[FF + c];
#pragma unroll
        for (int k = 0; k < 3; ++k) { const int t = r + k - 1; if (t < 0 || t >= S_) continue; const int tl = t & 255, ri = tl < 2 ? tl : tl - 252;
            const bf16* rp = RAW + (((size_t)(t >> 8) * 4 + ri) * 43 + pn) * 256 + cc; ug += cw[k * FF2 + c] * bf2f(rp[0]); uv += cw[k * FF2 + FF + c] * bf2f(rp[128]); }
        act[(size_t)r * FF + c] = (bf16)f2bf(siluf_(ug) * uv); }
}
constexpr int NPH = 11;
constexpr int NPHASES = 2 + DEPTH * NPH;
__global__ void __launch_bounds__(NTHR, 2) mk_fwd(Args a) {
    extern __shared__ __attribute__((aligned(16))) unsigned char lds_raw[];
    LAS unsigned char* lds = (LAS unsigned char*)lds_raw;
    const int wave_s = __builtin_amdgcn_readfirstlane((int)threadIdx.x >> 6);
    const int lane = mk_lane_id(), wave = wave_s, tid = wave_s * 64 + lane;
    const int bid = blockIdx.x, nb = gridDim.x;
    unsigned char* ws = a.ws;
    volatile LAS unsigned* MISC = (volatile LAS unsigned*)(lds + MISC_OFF);
    for (int u = tid; u < (LDS_BYTES - MISC_OFF) / 4; u += NTHR) ((LAS unsigned*)(lds + MISC_OFF))[u] = 0u;
    __syncthreads();
    XcdBarrier bar; bar.w0 = 0u; bar.bar = (unsigned*)(ws + WS_CTL) + CW_BAR; bar.x = 0; bar.st = nullptr;
    if (!MK_MULTI_LAUNCH) bar = xcd_barrier_post((unsigned*)(ws + WS_CTL) + CW_BAR, MISC + 8);
    bar.w0 = (wave_s == 0) ? 1u : 0u;
    const int lo = a.ph_lo, hi = a.ph_hi;
#define PH_LOCALS() size_t wsoff_ = 0; asm volatile("" : "+s"(wsoff_)); unsigned char* ws = a.ws + wsoff_;     \
    int tid = wave_s * 64 + mk_lane_id(); asm volatile("" : "+v"(tid)); const int lane = tid & 63, wave = __builtin_amdgcn_readfirstlane(tid >> 6); int bid = blockIdx.x, nb = gridDim.x; asm volatile("" : "+s"(bid), "+s"(nb)); (void)ws; (void)lane; (void)wave; (void)tid
#define IN(k) (lo <= (k) && (k) < hi)
#define SEAM(k) do { if (IN((k) + 1)) xcd_barrier(bar); } while (0)

    if (IN(0)) { PH_LOCALS(); ph_prologue(a, lds, bid, nb, tid, wave, lane); SEAM(0); }
    if (IN(1)) { PH_LOCALS(); ph_resnorm<false>(a, lds, bid, nb, tid, wave, lane, a.x, nullptr, nullptr, (bf16*)(ws + WS_H), 0, 0, 0, 0, 0, 1, 0); SEAM(1); }

    for (int L = 0; L < DEPTH; ++L) {
        const int pb = 2 + L * NPH;
        if (IN(pb + 0)) { PH_LOCALS();
            pg8::Gemm g{(const bf16*)(ws + WS_H), (const bf16*)(ws + WS_WIN) + (size_t)L * NIN * D_, S_, NIN, D_}; pg8::StaticOrder so; so.init(S_, NIN, nb, bid);
            pg8::EpiZ8 E{(bf16*)(ws + WS_Z), W_, 4, 44, SEG, (bf16*)(ws + WS_ZG), 4 * D_};
            pg8::gemm_phase<pg8::EpiZ8, pg8::StaticOrder, true, true>(lds, g, so, E, wave);
            SEAM(pb + 0);
        }
        if (IN(pb + 1)) { PH_LOCALS(); ph_pool(a, ws, lds, L, bid, nb, tid, wave, lane); ph_lru<false>(a, ws, lds, L, bid, nb, tid, wave, lane); ph_hgrn_h1(ws, lds, L, bid, nb, tid, wave, lane);
            ph_attn_prep(ws, bid, nb, tid); ph_attn_vt(ws, lds, bid, nb, tid, wave, lane); SEAM(pb + 1); }
        if (IN(pb + 2)) { PH_LOCALS(); ph_attn_main(ws, bid, nb, wave, lane); ph_lru_carry(ws, lds, bid, tid, wave, lane); ph_hgrn_h2(ws, bid, nb, tid); SEAM(pb + 2); }
        if (IN(pb + 3)) { PH_LOCALS(); ph_hgrn_h3(ws, lds, a.hgrn_onorm + L * W_, L, bid, nb, tid, wave, lane); ph_lru_out(ws, bid, nb, tid); ph_attn_comb(ws, bid, nb, tid); SEAM(pb + 3); }
        if (IN(pb + 4)) { PH_LOCALS();
            pg8::Gemm g{(const bf16*)(ws + WS_BR), (const bf16*)(ws + WS_WBR) + (size_t)L * 4 * D_ * W_, 4 * S_, 4 * D_, W_}; pg8::GateOrder so; so.so.init(S_, D_, nb, bid);
            pg8::EpiGate E{(const unsigned char*)(ws + WS_ZG), (bf16*)(ws + WS_MERGED)};
            pg8::gemm_phase<pg8::EpiGate, pg8::GateOrder, true, true>(lds, g, so, E, wave);
            SEAM(pb + 4);
        }
        if (IN(pb + 5)) { PH_LOCALS();
            pg8::Gemm g{(const bf16*)(ws + WS_MERGED), (const bf16*)(ws + WS_WOUT) + (size_t)L * D_ * D_, S_, D_, D_}; pg8::StaticOrder so; so.init(S_, D_, nb, bid);
            pg8::EpiBf16R E{(bf16*)(ws + WS_Y), D_, 8, 8, 0, nullptr, 0};
            pg8::gemm_phase<pg8::EpiBf16R, pg8::StaticOrder, true, true>(lds, g, so, E, wave);
            SEAM(pb + 5);
        }
        if (IN(pb + 6)) { PH_LOCALS(); ph_resnorm<true>(a, lds, bid, nb, tid, wave, lane, a.x, a.out, (const bf16*)(ws + WS_Y), (bf16*)(ws + WS_H), L, 2, 1, L, 2, 4, 3, L == 0 ? nullptr : (const bf16*)(ws + WS_XR), (bf16*)(ws + WS_XR)); SEAM(pb + 6); }
        if (IN(pb + 7)) { PH_LOCALS();
            pg8::Gemm g{(const bf16*)(ws + WS_H), (const bf16*)(ws + WS_WUP) + (size_t)L * FF2 * D_, S_, FF2, D_}; pg8::StaticOrder so; so.init(S_, FF2, nb, bid);
            pg8::EpiConvAct E{(bf16*)(ws + WS_P), (bf16*)(ws + WS_RAW), (const float*)(ws + WS_CWT) + (size_t)L * 43 * 8 * 128, (LAS float*)(lds + RING_BYTES)};
            pg8::gemm_phase<pg8::EpiConvAct, pg8::StaticOrder, true, true>(lds, g, so, E, wave);
            SEAM(pb + 7);
        }
        if (IN(pb + 8)) { PH_LOCALS(); ph_convfix(a, ws, L, bid, nb, tid); SEAM(pb + 8); }
        if (IN(pb + 9)) { PH_LOCALS();
            pg8::Gemm g{(const bf16*)(ws + WS_P), (const bf16*)(ws + WS_WDN) + (size_t)L * D_ * FF, S_, D_, FF}; pg8::StaticOrder so; so.init(S_, D_, nb, bid);
            pg8::EpiBf16R E{(bf16*)(ws + WS_Y), D_, 8, 8, 0, nullptr, 0};
            pg8::gemm_phase<pg8::EpiBf16R, pg8::StaticOrder, true, true>(lds, g, so, E, wave);
            SEAM(pb + 9);
        }
        if (IN(pb + 10)) { PH_LOCALS(); ph_resnorm<true>(a, lds, bid, nb, tid, wave, lane, a.x, a.out, (const bf16*)(ws + WS_Y), L + 1 < DEPTH ? (bf16*)(ws + WS_H) : nullptr, L, 5, 3, L + 1 < DEPTH ? L + 1 : L, 0, 1, 0, (const bf16*)(ws + WS_XR), L + 1 < DEPTH ? (bf16*)(ws + WS_XR) : nullptr); SEAM(pb + 10); }
    }
#undef IN
#undef SEAM
}

extern "C" void kernel_launch(void* const* d_in, const int* in_sizes, int n_in, void* d_out, int out_size, void* d_ws, size_t ws_size, hipStream_t stream) {
    static int grid = 0;
    if (grid == 0) {
        if (n_in != 24 || in_sizes[0] != S_ * D_ || out_size != S_ * D_ || ws_size < WS_END) { fprintf(stderr, "kernel_launch: unexpected shapes (n_in %d, in0 %d, out %d, ws %zu < %zu); nothing launched\n", n_in, n_in > 0 ? in_sizes[0] : -1, out_size, ws_size, (size_t)WS_END); grid = -1; return; }
        int dev = 0, cus = 0, per_cu = 0;
        if (hipGetDevice(&dev) != hipSuccess || hipDeviceGetAttribute(&cus, hipDeviceAttributeMultiprocessorCount, dev) != hipSuccess) { grid = -1; return; }
        if (hipFuncSetAttribute((const void*)mk_fwd, hipFuncAttributeMaxDynamicSharedMemorySize, LDS_BYTES) != hipSuccess) { fprintf(stderr, "kernel_launch: hipFuncSetAttribute failed\n"); grid = -1; return; }
        if (hipOccupancyMaxActiveBlocksPerMultiprocessor(&per_cu, (const void*)mk_fwd, NTHR, LDS_BYTES) != hipSuccess || per_cu < 1) fprintf(stderr, "kernel_launch: occupancy query reports %d\n", per_cu);
        (void)hipGetLastError();
        grid = cus;
    }
    if (grid < 0) return;
    if (hipMemsetAsync((char*)d_ws + WS_CTL, 0, CTL_ZERO_BYTES, stream) != hipSuccess) return;
    Args a{};
    a.x = (const float*)d_in[0]; a.c = (const float*)d_in[1]; a.pos = (const int*)d_in[2]; a.ada_w = (const float*)d_in[3]; a.ada_b = (const float*)d_in[4]; a.norm_g = (const float*)d_in[5];
    a.w_in = (const float*)d_in[6]; a.hgrn_lb = (const float*)d_in[7]; a.hgrn_onorm = (const float*)d_in[8]; a.lru_conv_w = (const float*)d_in[9]; a.lru_conv_b = (const float*)d_in[10];
    a.lru_wa = (const float*)d_in[11]; a.lru_ba = (const float*)d_in[12]; a.lru_wx = (const float*)d_in[13]; a.lru_bx = (const float*)d_in[14]; a.lru_lambda = (const float*)d_in[15];
    a.pool_w = (const float*)d_in[16]; a.pool_scale = (const float*)d_in[17]; a.w_branch = (const float*)d_in[18]; a.w_out = (const float*)d_in[19]; a.ffn_up = (const float*)d_in[20];
    a.ffn_conv_w = (const float*)d_in[21]; a.ffn_conv_b = (const float*)d_in[22]; a.ffn_down = (const float*)d_in[23];
    a.out = (float*)d_out; a.ws = (unsigned char*)d_ws;
#if MK_MULTI_LAUNCH
    for (int p = 0; p < NPHASES; ++p) { a.ph_lo = p; a.ph_hi = p + 1; hipLaunchKernelGGL(mk_fwd, dim3(grid), dim3(NTHR), LDS_BYTES, stream, a); }
#else
    a.ph_lo = 0; a.ph_hi = NPHASES; hipLaunchKernelGGL(mk_fwd, dim3(grid), dim3(NTHR), LDS_BYTES, stream, a);
#endif
}
```

```cpp
#include <hip/hip_runtime.h>
#include <cstdio>
#include <cstdint>
#ifndef MK_MULTI_LAUNCH
#define MK_MULTI_LAUNCH 0
#endif
#ifndef GATE_EXP
#define GATE_EXP 0
#endif
__device__ __forceinline__ int mk_lane_id() { int l; asm volatile("v_mbcnt_lo_u32_b32 %0, -1, 0\n\tv_mbcnt_hi_u32_b32 %0, -1, %0" : "=v"(l)); return l; }
#define GAS __attribute__((address_space(1)))
#define LAS __attribute__((address_space(3)))
namespace pg8 {
#define PG8_LAS __attribute__((address_space(3)))
typedef unsigned short bf16_t;
typedef short bf16x8 __attribute__((ext_vector_type(8)));
typedef float f32x4 __attribute__((ext_vector_type(4)));
typedef unsigned u32x4 __attribute__((ext_vector_type(4)));
constexpr int BM = 256, BK = 64, HALF = 128, HTB = HALF * BK * 2  , STAGE_BYTES = 8 * HTB, NXCD = 8, WGM = 8;

__host__ __device__ __forceinline__ int lds_byte(int r, int c) { const int st = (r >> 4) * 2 + (c >> 5), rr = r & 15, cc = c & 31, ob = rr * 64 + cc * 2; return st * 1024 + (ob ^ (((ob >> 9) & 1) << 5)); }
__host__ __device__ __forceinline__ void stage_rc(int b, int& R, int& C) { const int st = b / 1024, sb = b % 1024, swz = sb ^ (((sb >> 9) & 1) << 5); R = (st >> 1) * 16 + swz / 64; C = (st & 1) * 32 + (swz % 64) / 2; }
__host__ __device__ __forceinline__ int perm32(int rho) { const int n = rho >> 4, i = rho & 15; return 8 * (i >> 2) + 4 * n + (i & 3); }

struct Unit { int pm, pn; };
struct Gemm { const bf16_t* A; const bf16_t* Bt; int M, N, K; };

struct StaticOrder {
    int nM, nN, nwg, G, c;
    __host__ __device__ void init(int M, int N, int G_, int c_) { nM = M / BM; nN = N / BM; nwg = nM * nN; G = G_; c = c_; }
    __host__ __device__ bool next(int i, Unit& u) const {
        const long L = (long)i * G + c; if (L >= nwg) return false;
        int wgid = (int)L; { const int q = nwg / NXCD, r = nwg % NXCD, xcd = wgid % NXCD, off = wgid / NXCD; wgid = (xcd < r ? xcd * (q + 1) : r * (q + 1) + (xcd - r) * q) + off; }
        const int nig = WGM * nN, gid = wgid / nig, fm = gid * WGM, gsz = (nM - fm) < WGM ? (nM - fm) : WGM;
        u.pm = fm + ((wgid % nig) % gsz); u.pn = (wgid % nig) / gsz; return true;
    }
    __device__ __forceinline__ void a_ready(const Unit&) const {}
    __device__ __forceinline__ void done(const Unit&) const {}
};

typedef __bf16 bf16x2_t __attribute__((ext_vector_type(2)));
typedef float f32x2_t __attribute__((ext_vector_type(2)));
__device__ __forceinline__ unsigned cvt_pk_bf16(float lo, float hi) { const f32x2_t v = {lo, hi}; return __builtin_bit_cast(unsigned, __builtin_convertvector(v, bf16x2_t)); }

struct EpiBf16R {
    static constexpr bool PERM = true, AFTER_DRAIN = false, INPLACE = false;
    bf16_t* O; int ldc_seg; int tiles_per_seg; int nseg_tiles; size_t seg_stride; bf16_t* O2; int ldc2;
    __device__ __forceinline__ void operator()(const f32x4 (&acc)[2][2][4][2], const Unit& u, int wr, int wc, int fr, int fq) const {
        const int row0 = u.pm * BM + wr * 64 + fr; bf16_t* base; int ldc, colt;
        if (u.pn < nseg_tiles) { const int sg = u.pn / tiles_per_seg; base = O + (size_t)sg * seg_stride; ldc = ldc_seg; colt = (u.pn - sg * tiles_per_seg) * BM; }
        else { base = O2; ldc = ldc2; colt = (u.pn - nseg_tiles) * BM; }
        const int col0 = colt + wc * 32 + 8 * fq;
#pragma unroll
        for (int ai = 0; ai < 2; ++ai)
#pragma unroll
            for (int m = 0; m < 4; ++m) { bf16_t* rowp = base + (size_t)(row0 + ai * HALF + m * 16) * ldc + col0;
#pragma unroll
                for (int bj = 0; bj < 2; ++bj) { const f32x4 v0 = acc[ai][bj][m][0], v1 = acc[ai][bj][m][1];
                    u32x4 w; w.x = cvt_pk_bf16(v0[0], v0[1]); w.y = cvt_pk_bf16(v0[2], v0[3]); w.z = cvt_pk_bf16(v1[0], v1[1]); w.w = cvt_pk_bf16(v1[2], v1[3]);
                    *(u32x4*)(rowp + bj * HALF) = w; } }
    }
};
struct EpiZ8 {
    static constexpr bool PERM = true, AFTER_DRAIN = false, INPLACE = false;
    bf16_t* O; int ldc_seg; int tiles_per_seg; int nseg_tiles; size_t seg_stride; bf16_t* O2; int ldc2;
    __device__ __forceinline__ void operator()(const f32x4 (&acc)[2][2][4][2], const Unit& u, int wr, int wc, int fr, int fq) const {
        const int row0 = u.pm * BM + wr * 64 + fr; bf16_t* base; int ldc, colt;
        if (u.pn < nseg_tiles) { const int sg = u.pn / tiles_per_seg; base = O + (size_t)sg * seg_stride; ldc = ldc_seg; colt = (u.pn - sg * tiles_per_seg) * BM; }
        else { base = O2; ldc = ldc2; colt = (u.pn - nseg_tiles) * BM; }
        const int col0 = colt + wc * 32 + 8 * fq;
        if (u.pn >= nseg_tiles) {
            unsigned char* gb = (unsigned char*)O2;
#pragma unroll
            for (int ai = 0; ai < 2; ++ai)
#pragma unroll
                for (int m = 0; m < 4; ++m) { unsigned char* rowp = gb + (size_t)(u.pm * 32 + (u.pn - nseg_tiles)) * 65536 + (unsigned)(((wr * 4 + wc) * 64 + fq * 16 + fr) * 8);
#pragma unroll
                    for (int bj = 0; bj < 2; ++bj) { unsigned w2[2];
#pragma unroll
                        for (int hh = 0; hh < 2; ++hh) { const f32x4 v = acc[ai][bj][m][hh]; unsigned q = 0;
#pragma unroll
                            for (int j = 0; j < 4; ++j) q |= (unsigned)max((int)(255.0f * __builtin_amdgcn_rcpf(1.0f + __expf(-v[j])) + 0.5f), 1) << (8 * j);
                            w2[hh] = q; }
                        typedef unsigned u32x2 __attribute__((ext_vector_type(2))); u32x2 w; w.x = w2[0]; w.y = w2[1];
                        *(u32x2*)(rowp + ((ai * 4 + m) * 2 + bj) * 4096) = w; } }
            return; }
#pragma unroll
        for (int ai = 0; ai < 2; ++ai)
#pragma unroll
            for (int m = 0; m < 4; ++m) { bf16_t* rowp = base + (size_t)(row0 + ai * HALF + m * 16) * ldc + col0;
#pragma unroll
                for (int bj = 0; bj < 2; ++bj) { const f32x4 v0 = acc[ai][bj][m][0], v1 = acc[ai][bj][m][1];
                    u32x4 w; w.x = cvt_pk_bf16(v0[0], v0[1]); w.y = cvt_pk_bf16(v0[2], v0[3]); w.z = cvt_pk_bf16(v1[0], v1[1]); w.w = cvt_pk_bf16(v1[2], v1[3]);
                    *(u32x4*)(rowp + bj * HALF) = w; } }
    }
};

struct GateOrder { StaticOrder so;
    __device__ __forceinline__ bool next(int i, Unit& u) const { Unit t; if (!so.next(i >> 2, t)) return false; const int g = i & 3; u.pm = g * 64 + t.pm; u.pn = g * 8 + t.pn; return true; }
    __device__ __forceinline__ void a_ready(const Unit&) const {}
    __device__ __forceinline__ void done(const Unit&) const {}
};
struct EpiGate {
    static constexpr bool PERM = true, AFTER_DRAIN = false, INPLACE = true;
    const unsigned char* ZG; bf16_t* MG;
    static __device__ __forceinline__ bool keep(const Unit& u) { return (u.pn >> 3) < 3; }
    __device__ __forceinline__ void operator()(f32x4 (&acc)[2][2][4][2], const Unit& u, int wr, int wc, int fr, int fq) const {
        typedef unsigned u32x2 __attribute__((ext_vector_type(2)));
        const int g = u.pn >> 3, pn0 = u.pn & 7, pm0 = u.pm - g * 64;
        const unsigned tix = (unsigned)((wr * 4 + wc) * 64 + fq * 16 + fr);
        const unsigned char* gtile = ZG + (size_t)(pm0 * 32 + g * 8 + pn0) * 65536 + tix * 8;
        if (g < 3) {
#pragma unroll
            for (int ai = 0; ai < 2; ++ai) { u32x2 gw[4][2], gn[4][2];
#pragma unroll
                for (int m = 0; m < 4; ++m)
#pragma unroll
                    for (int bj = 0; bj < 2; ++bj) { gw[m][bj] = *(const u32x2*)(gtile + ((ai * 4 + m) * 2 + bj) * 4096); gn[m][bj] = *(const u32x2*)(gtile + 8 * 65536 + ((ai * 4 + m) * 2 + bj) * 4096); }
#pragma unroll
                for (int m = 0; m < 4; ++m)
#pragma unroll
                    for (int bj = 0; bj < 2; ++bj)
#pragma unroll
                        for (int j = 0; j < 4; ++j) { const unsigned gword = (j < 2) ? gw[m][bj].x : gw[m][bj].y, nword = (j < 2) ? gn[m][bj].x : gn[m][bj].y; const int sh = 16 * (j & 1);
                            const float r0 = (float)((gword >> sh) & 0xffu) * __builtin_amdgcn_rcpf((float)((nword >> sh) & 0xffu)), r1 = (float)((gword >> (sh + 8)) & 0xffu) * __builtin_amdgcn_rcpf((float)((nword >> (sh + 8)) & 0xffu));
                            if (j < 2) { acc[ai][bj][m][0][2 * j] *= r0; acc[ai][bj][m][0][2 * j + 1] *= r1; } else { acc[ai][bj][m][1][2 * j - 4] *= r0; acc[ai][bj][m][1][2 * j - 3] *= r1; } } }
        } else {
            const int row0 = pm0 * BM + wr * 64 + fr, col0 = pn0 * BM + wc * 32 + 8 * fq;
#pragma unroll
            for (int ai = 0; ai < 2; ++ai) { u32x2 gw[4][2];
#pragma unroll
                for (int m = 0; m < 4; ++m)
#pragma unroll
                    for (int bj = 0; bj < 2; ++bj) gw[m][bj] = *(const u32x2*)(gtile + ((ai * 4 + m) * 2 + bj) * 4096);
#pragma unroll
                for (int m = 0; m < 4; ++m)
#pragma unroll
                    for (int bj = 0; bj < 2; ++bj) { const size_t row = (size_t)(row0 + ai * HALF + m * 16); const int col = col0 + bj * HALF; float v[8];
#pragma unroll
                        for (int j = 0; j < 4; ++j) { const unsigned gword = (j < 2) ? gw[m][bj].x : gw[m][bj].y; const int sh = 16 * (j & 1);
                            const float g0 = (float)((gword >> sh) & 0xffu) * (1.0f / 255.0f), g1 = (float)((gword >> (sh + 8)) & 0xffu) * (1.0f / 255.0f);
                            const float a0 = (j < 2) ? acc[ai][bj][m][0][2 * j] : acc[ai][bj][m][1][2 * j - 4], a1 = (j < 2) ? acc[ai][bj][m][0][2 * j + 1] : acc[ai][bj][m][1][2 * j - 3];
                            v[2 * j] = a0 * g0; v[2 * j + 1] = a1 * g1; }
                        u32x4 w; w.x = cvt_pk_bf16(v[0], v[1]); w.y = cvt_pk_bf16(v[2], v[3]); w.z = cvt_pk_bf16(v[4], v[5]); w.w = cvt_pk_bf16(v[6], v[7]);
                        *(u32x4*)(MG + row * 2048 + col) = w; } }
        }
    }
};

template <int ROT> __device__ __forceinline__ float dpp_ror(float v) { return __builtin_bit_cast(float, __builtin_amdgcn_update_dpp(0, __builtin_bit_cast(int, v), 0x120 | ROT, 0xf, 0xf, false)); }
struct EpiConvAct {
    static constexpr bool PERM = true, AFTER_DRAIN = false, INPLACE = false;
    bf16_t* ACT; bf16_t* RAW; const float* cwt; PG8_LAS float* XA;
    __device__ __forceinline__ void operator()(const f32x4 (&acc)[2][2][4][2], const Unit& u, int wr, int wc, int fr, int fq) const {
        const int FFc = 5504;
        PG8_LAS float* CW = XA + 2048;
        { const int t8 = ((wr * 4 + wc) * 64 + fq * 16 + fr) * 2; typedef float f32x2l __attribute__((ext_vector_type(2)));
          const f32x2l v = *(const f32x2l*)(cwt + (unsigned)(u.pn * 1024 + t8)); *(PG8_LAS f32x2l*)(CW + t8) = v; }
#pragma unroll
        for (int ai = 0; ai < 2; ++ai) { PG8_LAS float* xs = XA + (((ai * 2 + wr) * 4 + wc) * 2) * 64 + fq * 8;
            if (fr == 0) {
#pragma unroll
                for (int bj = 0; bj < 2; ++bj) { *(PG8_LAS f32x4*)(xs + bj * 32) = acc[ai][bj][0][0]; *(PG8_LAS f32x4*)(xs + bj * 32 + 4) = acc[ai][bj][0][1]; } }
            if (fr == 15) {
#pragma unroll
                for (int bj = 0; bj < 2; ++bj) { *(PG8_LAS f32x4*)(xs + 64 + bj * 32) = acc[ai][bj][3][0]; *(PG8_LAS f32x4*)(xs + 64 + bj * 32 + 4) = acc[ai][bj][3][1]; } } }
        asm volatile("s_waitcnt lgkmcnt(0)" ::: "memory"); __builtin_amdgcn_s_barrier(); asm volatile("" ::: "memory");
        int fqw = fq; asm volatile("" : "+v"(fqw));
        const int chan0 = u.pn * 128 + wc * 32 + fq * 8;
#pragma unroll
        for (int ai = 0; ai < 2; ++ai) {
            const bool has_top = (ai == 1) || (wr == 1), has_bot = (ai == 0) || (wr == 0);
            const int ts = (wr == 1) ? ((ai * 2 + 0) * 4 + wc) * 2 + 1 : (((ai - 1) * 2 + 1) * 4 + wc) * 2 + 1;
            const int bs = (wr == 0) ? ((ai * 2 + 1) * 4 + wc) * 2 + 0 : (((ai + 1) * 2 + 0) * 4 + wc) * 2 + 0;
#pragma unroll
            for (int nn = 0; nn < 2; ++nn) {
                float actv[4][4];
#pragma unroll
                for (int bj = 0; bj < 2; ++bj) {
                    __builtin_amdgcn_sched_barrier(0);
                    const PG8_LAS float* wp = CW + (bj * 512 + wc * 32 + fqw * 8 + 4 * nn);
                    const f32x4 bb = *(const PG8_LAS f32x4*)wp, w0 = *(const PG8_LAS f32x4*)(wp + 128), w1 = *(const PG8_LAS f32x4*)(wp + 256), w2 = *(const PG8_LAS f32x4*)(wp + 384);
                    f32x4 ht = (f32x4){0.f, 0.f, 0.f, 0.f}, hb = ht;
                    if (has_top) ht = *(const PG8_LAS f32x4*)(XA + ts * 64 + bj * 32 + fq * 8 + 4 * nn);
                    if (has_bot) hb = *(const PG8_LAS f32x4*)(XA + bs * 64 + bj * 32 + fq * 8 + 4 * nn);
#pragma unroll
                    for (int e = 0; e < 4; ++e) {
                        float r1[4], r15[4];
#pragma unroll
                        for (int m = 0; m < 4; ++m) { r1[m] = dpp_ror<1>(acc[ai][bj][m][nn][e]); r15[m] = dpp_ror<15>(acc[ai][bj][m][nn][e]); }
#pragma unroll
                        for (int m = 0; m < 4; ++m) {
                            const float pv = (fr != 0) ? r1[m] : (m > 0 ? r1[m > 0 ? m - 1 : 0] : ht[e]), nx = (fr != 15) ? r15[m] : (m < 3 ? r15[m < 3 ? m + 1 : 3] : hb[e]);
                            const float uc = bb[e] + w0[e] * pv + w1[e] * acc[ai][bj][m][nn][e] + w2[e] * nx;
                            if (bj == 0) actv[m][e] = uc * __builtin_amdgcn_rcpf(1.0f + __expf(-uc)); else actv[m][e] *= uc; } } }
#pragma unroll
                for (int m = 0; m < 4; ++m) { const unsigned aoff = (unsigned)(u.pm * BM + ai * HALF + wr * 64 + m * 16 + fr) * (unsigned)FFc + (unsigned)(chan0 + 4 * nn);
                    typedef unsigned u32x2 __attribute__((ext_vector_type(2))); u32x2 w; w.x = cvt_pk_bf16(actv[m][0], actv[m][1]); w.y = cvt_pk_bf16(actv[m][2], actv[m][3]);
                    *(u32x2*)(ACT + aoff) = w; } } }
        { int frl = fr, fql = fq; asm volatile("" : "+v"(frl), "+v"(fql));
          if (wr == 0 && frl < 2) { bf16_t* rp = RAW + (unsigned)(((u.pm * 4 + frl) * 43 + u.pn) * 256 + wc * 32 + fql * 8);
#pragma unroll
              for (int bj = 0; bj < 2; ++bj) { const f32x4 v0 = acc[0][bj][0][0], v1 = acc[0][bj][0][1]; u32x4 w; w.x = cvt_pk_bf16(v0[0], v0[1]); w.y = cvt_pk_bf16(v0[2], v0[3]); w.z = cvt_pk_bf16(v1[0], v1[1]); w.w = cvt_pk_bf16(v1[2], v1[3]); *(u32x4*)(rp + bj * 128) = w; } }
          if (wr == 1 && frl >= 14) { bf16_t* rp = RAW + (unsigned)(((u.pm * 4 + frl - 12) * 43 + u.pn) * 256 + wc * 32 + fql * 8);
#pragma unroll
              for (int bj = 0; bj < 2; ++bj) { const f32x4 v0 = acc[1][bj][3][0], v1 = acc[1][bj][3][1]; u32x4 w; w.x = cvt_pk_bf16(v0[0], v0[1]); w.y = cvt_pk_bf16(v0[2], v0[3]); w.z = cvt_pk_bf16(v1[0], v1[1]); w.w = cvt_pk_bf16(v1[2], v1[3]); *(u32x4*)(rp + bj * 128) = w; } } }
    }
};
struct EpiF32 {
    static constexpr bool PERM = false, AFTER_DRAIN = false, INPLACE = false;
    float* C; int ldc; const float* bias;
    __device__ __forceinline__ void operator()(const f32x4 (&acc)[2][2][4][2], const Unit& u, int wr, int wc, int fr, int fq) const {
        const int row0 = u.pm * BM + wr * 64 + fr, col0 = u.pn * BM + wc * 32 + 4 * fq;
        f32x4 bv[2][2];
#pragma unroll
        for (int bj = 0; bj < 2; ++bj)
#pragma unroll
            for (int n = 0; n < 2; ++n) bv[bj][n] = bias ? *(const f32x4*)(bias + col0 + bj * HALF + n * 16) : (f32x4){0.f, 0.f, 0.f, 0.f};
#pragma unroll
        for (int ai = 0; ai < 2; ++ai)
#pragma unroll
            for (int m = 0; m < 4; ++m) { float* rowp = C + (size_t)(row0 + ai * HALF + m * 16) * ldc + col0;
#pragma unroll
                for (int bj = 0; bj < 2; ++bj)
#pragma unroll
                    for (int n = 0; n < 2; ++n) *(f32x4*)(rowp + bj * HALF + n * 16) = acc[ai][bj][m][n] + bv[bj][n]; }
    }
};
template <class Epi, class Sched, bool ALIGN_EPI = false, bool SP2 = false>
__device__ __forceinline__ void gemm_phase(PG8_LAS unsigned char* lds, const Gemm g, const Sched& S, const Epi& E, const int wave_in) {
    int tid = wave_in * 64 + mk_lane_id(); asm volatile("" : "+v"(tid));
    const int wid = __builtin_amdgcn_readfirstlane(tid >> 6), lane = tid & 63, wr = wid >> 2, wc = wid & 3, fr = lane & 15, fq = lane >> 4;
    const int K = g.K, nt = K / BK;
    unsigned voffA[2], voffB[2];
#pragma unroll
    for (int i = 0; i < 2; ++i) { int R, C; stage_rc(tid * 16 + i * 8192, R, C); const int Rb = Epi::PERM ? ((R & ~31) + perm32(R & 31)) : R;
        voffA[i] = (unsigned)(R * K + C) * 2u; voffB[i] = (unsigned)(Rb * K + C) * 2u; }
    const size_t kstep = (size_t)(BK * 2);
    const size_t hstep = (size_t)HALF * K * 2;
    const size_t tstep = 2 * hstep;
    const unsigned ldsw = (unsigned)wid * 1024u;
    const int aoff = lds_byte(wr * 64 + fr, fq * 8), boff = lds_byte(wc * 32 + fr, fq * 8);
#define PG8_SA(b, h) (((b) * 2 + (h)) * HTB)
#define PG8_SB(b, h) ((4 + (b) * 2 + (h)) * HTB)
#define PG8_STAGE(bufoff, gbase, voff) do { _Pragma("unroll") for (int _i = 0; _i < 2; ++_i) \
        __builtin_amdgcn_global_load_lds((const unsigned*)((const char*)(gbase) + (voff)[_i]), (PG8_LAS unsigned*)(lds + (bufoff) + ldsw + _i * 8192), 16, 0, 0); } while (0)
#define PG8_LDA(dst, b, h) do { _Pragma("unroll") for (int m = 0; m < 4; ++m) _Pragma("unroll") for (int k = 0; k < 2; ++k) dst[m][k] = *(const PG8_LAS bf16x8*)(lds + PG8_SA(b, h) + aoff + m * 2048 + k * 1024); } while (0)
#define PG8_LDB(dst, b, h) do { _Pragma("unroll") for (int n = 0; n < 2; ++n) _Pragma("unroll") for (int k = 0; k < 2; ++k) dst[n][k] = *(const PG8_LAS bf16x8*)(lds + PG8_SB(b, h) + boff + n * 2048 + k * 1024); } while (0)
#define PG8_MMA(ai, bj, At, Bt) do { __builtin_amdgcn_s_setprio(1); _Pragma("unroll") for (int m = 0; m < 4; ++m) _Pragma("unroll") for (int n = 0; n < 2; ++n) _Pragma("unroll") for (int k = 0; k < 2; ++k) \
        acc[ai][bj][m][n] = __builtin_amdgcn_mfma_f32_16x16x32_bf16(Bt[n][k], At[m][k], acc[ai][bj][m][n], 0, 0, 0); __builtin_amdgcn_s_setprio(0); } while (0)
#define PG8_WAIT_V(n) asm volatile("s_waitcnt vmcnt(" #n ")" ::: "memory")
#define PG8_WAIT_L(n) asm volatile("s_waitcnt lgkmcnt(" #n ")" ::: "memory")
#define PG8_BAR __builtin_amdgcn_s_barrier()
#define PG8_SCHED __builtin_amdgcn_sched_barrier(0)
    Unit cur, nxt; int ui = 0;
    if (!S.next(0, cur)) return;
    f32x4 acc[2][2][4][2];
#pragma unroll
    for (int a = 0; a < 2; ++a)
#pragma unroll
        for (int b = 0; b < 2; ++b)
#pragma unroll
            for (int m = 0; m < 4; ++m)
#pragma unroll
                for (int n = 0; n < 2; ++n) acc[a][b][m][n] = (f32x4){0.f, 0.f, 0.f, 0.f};
    bf16x8 At[4][2], B0[2][2], B1[2][2];
    const char* cA = (const char*)g.A + (size_t)cur.pm * tstep; const char* cB = (const char*)g.Bt + (size_t)cur.pn * tstep;
    S.a_ready(cur);
    if constexpr (SP2) {
        PG8_STAGE(PG8_SB(0, 0), cB, voffB); PG8_STAGE(PG8_SB(0, 1), cB + hstep, voffB); PG8_STAGE(PG8_SA(0, 0), cA, voffA); PG8_STAGE(PG8_SA(0, 1), cA + hstep, voffA);
        if (wr == 1) PG8_BAR;
        PG8_WAIT_V(2); PG8_BAR;
        PG8_STAGE(PG8_SB(1, 0), cB + kstep, voffB); PG8_STAGE(PG8_SA(1, 0), cA + kstep, voffA); PG8_STAGE(PG8_SB(1, 1), cB + hstep + kstep, voffB);
        PG8_WAIT_V(6); PG8_BAR;
    } else {
        PG8_STAGE(PG8_SB(0, 0), cB, voffB); PG8_STAGE(PG8_SA(0, 0), cA, voffA); PG8_STAGE(PG8_SB(0, 1), cB + hstep, voffB); PG8_STAGE(PG8_SA(0, 1), cA + hstep, voffA);
        if (wr == 1) PG8_BAR;
        PG8_WAIT_V(4); PG8_BAR;
        PG8_STAGE(PG8_SB(1, 0), cB + kstep, voffB); PG8_STAGE(PG8_SA(1, 0), cA + kstep, voffA); PG8_STAGE(PG8_SB(1, 1), cB + hstep + kstep, voffB);
        PG8_WAIT_V(6); PG8_BAR;
    }
    for (;;) {
        const bool has_next = S.next(ui + 1, nxt);
        const char* nA = has_next ? (const char*)g.A + (size_t)nxt.pm * tstep : cA; const char* nB = has_next ? (const char*)g.Bt + (size_t)nxt.pn * tstep : cB;
        for (int t = 0; t < nt; t += 2) {
            const bool last = (t == nt - 2);
            const char* a1 = cA + (size_t)(t + 1) * kstep;
            const char* a2 = last ? nA : cA + (size_t)(t + 2) * kstep; const char* b2 = last ? nB : cB + (size_t)(t + 2) * kstep;
            const char* a3 = a2 + kstep; const char* b3 = b2 + kstep;
            if (last && has_next) S.a_ready(nxt);
            if constexpr (SP2) {
            PG8_LDB(B0, 0, 0); PG8_LDB(B1, 0, 1); PG8_SCHED; PG8_LDA(At, 0, 0); PG8_STAGE(PG8_SA(1, 1), a1 + hstep, voffA);
            PG8_WAIT_V(8); PG8_WAIT_L(0); PG8_BAR; PG8_MMA(0, 0, At, B0); PG8_MMA(0, 1, At, B1); PG8_BAR; PG8_SCHED;
            PG8_LDA(At, 0, 1); PG8_STAGE(PG8_SB(0, 0), b2, voffB); PG8_STAGE(PG8_SB(0, 1), b2 + hstep, voffB); PG8_STAGE(PG8_SA(0, 0), a2, voffA);
            PG8_WAIT_V(8); PG8_WAIT_L(0); PG8_BAR; PG8_MMA(1, 0, At, B0); PG8_MMA(1, 1, At, B1); PG8_BAR; PG8_SCHED;
            PG8_LDB(B0, 1, 0); PG8_LDB(B1, 1, 1); PG8_SCHED; PG8_LDA(At, 1, 0); PG8_STAGE(PG8_SA(0, 1), a2 + hstep, voffA);
            PG8_WAIT_V(8); PG8_WAIT_L(0); PG8_BAR; PG8_MMA(0, 0, At, B0); PG8_MMA(0, 1, At, B1); PG8_BAR; PG8_SCHED;
            PG8_LDA(At, 1, 1); PG8_STAGE(PG8_SB(1, 0), b3, voffB); PG8_STAGE(PG8_SB(1, 1), b3 + hstep, voffB); PG8_STAGE(PG8_SA(1, 0), a3, voffA);
            PG8_WAIT_V(8); PG8_WAIT_L(0); PG8_BAR; PG8_MMA(1, 0, At, B0); PG8_MMA(1, 1, At, B1); PG8_BAR; PG8_SCHED;
            } else {
            PG8_LDB(B0, 0, 0); PG8_SCHED; PG8_LDA(At, 0, 0); PG8_STAGE(PG8_SA(1, 1), a1 + hstep, voffA);
            PG8_WAIT_L(8); PG8_BAR; PG8_WAIT_L(0); PG8_MMA(0, 0, At, B0); PG8_BAR; PG8_SCHED;
            PG8_LDB(B1, 0, 1); PG8_STAGE(PG8_SB(0, 0), b2, voffB);
            PG8_BAR; PG8_WAIT_L(0); PG8_MMA(0, 1, At, B1); PG8_BAR;
            PG8_LDA(At, 0, 1); PG8_STAGE(PG8_SA(0, 0), a2, voffA);
            PG8_BAR; PG8_WAIT_L(0); PG8_MMA(1, 0, At, B0); PG8_BAR; PG8_SCHED;
            PG8_STAGE(PG8_SB(0, 1), b2 + hstep, voffB);
            PG8_WAIT_V(6); PG8_BAR; PG8_MMA(1, 1, At, B1); PG8_BAR;
            PG8_LDB(B0, 1, 0); PG8_SCHED; PG8_LDA(At, 1, 0); PG8_STAGE(PG8_SA(0, 1), a2 + hstep, voffA);
            PG8_WAIT_L(8); PG8_BAR; PG8_WAIT_L(0); PG8_MMA(0, 0, At, B0); PG8_BAR; PG8_SCHED;
            PG8_LDB(B1, 1, 1); PG8_STAGE(PG8_SB(1, 0), b3, voffB);
            PG8_BAR; PG8_WAIT_L(0); PG8_MMA(0, 1, At, B1); PG8_BAR;
            PG8_LDA(At, 1, 1); PG8_STAGE(PG8_SA(1, 0), a3, voffA);
            PG8_BAR; PG8_WAIT_L(0); PG8_MMA(1, 0, At, B0); PG8_BAR; PG8_SCHED;
            PG8_STAGE(PG8_SB(1, 1), b3 + hstep, voffB);
            PG8_WAIT_V(6); PG8_BAR; PG8_MMA(1, 1, At, B1); PG8_BAR;
            }
        }
        if constexpr (ALIGN_EPI) { if (wr == 0) PG8_BAR; }
        if constexpr (!Epi::AFTER_DRAIN) { E(acc, cur, wr, wc, fr, fq); S.done(cur); }
        if (!has_next) break;
        bool keep = false; if constexpr (Epi::INPLACE) keep = Epi::keep(cur);
        if (!keep) {
#pragma unroll
        for (int a = 0; a < 2; ++a)
#pragma unroll
            for (int b = 0; b < 2; ++b)
#pragma unroll
                for (int m = 0; m < 4; ++m)
#pragma unroll
                    for (int n = 0; n < 2; ++n) acc[a][b][m][n] = (f32x4){0.f, 0.f, 0.f, 0.f};
        }
        cur = nxt; cA = nA; cB = nB; ++ui;
        if constexpr (ALIGN_EPI) { if (wr == 1) PG8_BAR; }
    }
    PG8_WAIT_V(0);
    if constexpr (!ALIGN_EPI) { if (wr == 0) PG8_BAR; }
    PG8_BAR;
    if constexpr (Epi::AFTER_DRAIN) { E.fused(acc, cur, wr, wc, fr, fq, lds, wid, lane); S.done(cur); }
#undef PG8_SA
#undef PG8_SB
#undef PG8_STAGE
#undef PG8_LDA
#undef PG8_LDB
#undef PG8_MMA
#undef PG8_WAIT_V
#undef PG8_WAIT_L
#undef PG8_BAR
#undef PG8_SCHED
}
}

#define XB_TMO      128
#define XB_XCNT(j)  (256  + 64 * (j))
#define XB_XSUB(j)  (1280 + 64 * (j))
#define XB_XGEN(j)  (2304 + 64 * (j))
#define XB_TOP      3328
#define XB_TOPGEN   3392
#define XCD_BAR_WORDS 3456
#define XB_SPIN_CAP (1u << 18)

__device__ __forceinline__ unsigned xb_ld(unsigned* p)              { return __hip_atomic_load(p, __ATOMIC_RELAXED, __HIP_MEMORY_SCOPE_AGENT); }
__device__ __forceinline__ unsigned xb_add(unsigned* p, unsigned v) { return __hip_atomic_fetch_add(p, v, __ATOMIC_RELAXED, __HIP_MEMORY_SCOPE_AGENT); }
__device__ __forceinline__ unsigned xb_xcc_id() { return (unsigned)__builtin_amdgcn_s_getreg((3 << 11) | 20) & 0xFu; }
#define XB_SPIN(cond, bar) do { unsigned _sp = 0; while (cond) { __builtin_amdgcn_s_sleep(1); \
    if ((++_sp & 255u) == 0u) { if (xb_ld(&(bar)[XB_TMO])) break; if (_sp > XB_SPIN_CAP) { atomicAdd(&(bar)[XB_TMO], 1u); break; } } } } while (0)

struct XcdBarrier {
    unsigned w0;
    unsigned* bar; unsigned x;
    volatile LAS unsigned* st;
};

__device__ __forceinline__ XcdBarrier xcd_barrier_post(unsigned* bar, volatile LAS unsigned* st) {
    XcdBarrier b; b.w0 = 0u; b.bar = bar; b.x = xb_xcc_id(); b.st = st;
    if (threadIdx.x == 0) (void)xb_add(&bar[XB_XCNT(b.x)], 1u);
    return b;
}
__device__ __forceinline__ void xcd_barrier_complete(unsigned* bar, unsigned x, unsigned& nloc, unsigned& nx) {
    const unsigned G = gridDim.x * gridDim.y * gridDim.z;
    unsigned sum, cnt, mine, sp = 0u;
    for (;;) {
        sum = 0u; cnt = 0u; mine = 0u;
#pragma unroll
        for (unsigned j = 0; j < 16; ++j) { const unsigned c = xb_ld(&bar[XB_XCNT(j)]); sum += c; cnt += (c > 0u) ? 1u : 0u; mine = (j == x) ? c : mine; }
        if (sum == G) break;
        __builtin_amdgcn_s_sleep(1);
        if ((++sp & 255u) == 0u) { if (xb_ld(&bar[XB_TMO])) break; if (sp > XB_SPIN_CAP) { atomicAdd(&bar[XB_TMO], 1u); break; } }
    }
    nloc = mine > 0u ? mine : 1u; nx = cnt > 0u ? cnt : 1u;
}

__device__ __forceinline__ void xcd_barrier(const XcdBarrier& b) {
    asm volatile("s_waitcnt vmcnt(0)" ::: "memory");
    __syncthreads();
    if (b.w0 != 0u && (unsigned)mk_lane_id() == 0u) {
        unsigned* bar = b.bar;
        __builtin_amdgcn_s_waitcnt(0);
        unsigned nloc = b.st[0], nx = b.st[1];
        if (nloc == 0u) { xcd_barrier_complete(bar, b.x, nloc, nx); b.st[0] = nloc; b.st[1] = nx; }
        const unsigned old = xb_add(&bar[XB_XSUB(b.x)], 1u);
        const unsigned gen = old / nloc;
        if (old + 1u == (gen + 1u) * nloc) {
            __builtin_amdgcn_fence(__ATOMIC_RELEASE, "agent");
            asm volatile("s_waitcnt vmcnt(0)" ::: "memory");
            const unsigned og = xb_add(&bar[XB_TOP], 1u);
            const unsigned tg = og / nx;
            if (og + 1u == (tg + 1u) * nx) xb_add(&bar[XB_TOPGEN], 1u);
            else XB_SPIN(xb_ld(&bar[XB_TOPGEN]) == tg, bar);
            __builtin_amdgcn_fence(__ATOMIC_ACQUIRE, "agent");
            xb_add(&bar[XB_XGEN(b.x)], 1u);
            asm volatile("s_waitcnt vmcnt(0)" ::: "memory");
        } else {
            XB_SPIN(xb_ld(&bar[XB_XGEN(b.x)]) == gen, bar);
            __builtin_amdgcn_fence(__ATOMIC_ACQUIRE, "agent");
            asm volatile("s_waitcnt vmcnt(0)" ::: "memory");
        }
    }
    __syncthreads();
}

#ifndef ATT_EXP
#define ATT_EXP 0
#endif
#ifndef HG_EXP
#define HG_EXP 0
#endif
constexpr int S_ = 16384, D_ = 2048, W_ = 1024, NIN = 19456, FF = 5504, FF2 = 11008, DEPTH = 4, NHEAD = 8, HD = 128;
constexpr float RMS_EPS = 1e-6f;
constexpr int NWAVES = 8, NTHR = 512;
constexpr size_t MiB = 1u << 20;
constexpr size_t WS_CTL = 0, CTL_ZERO_BYTES = 1 * MiB;
constexpr size_t WS_MOD = 1 * MiB;
constexpr size_t WS_LB = WS_MOD + 256 * 1024;
constexpr size_t WS_ROT = 2 * MiB;
constexpr size_t WS_WIN = 10 * MiB;
constexpr size_t WS_WBR = WS_WIN + 304 * MiB;
constexpr size_t WS_WOUT = WS_WBR + 64 * MiB;
constexpr size_t WS_WUP = WS_WOUT + 32 * MiB;
constexpr size_t WS_WDN = WS_WUP + 172 * MiB;
constexpr size_t WS_H = WS_WDN + 86 * MiB;
constexpr size_t WS_Z = WS_H + 64 * MiB;
constexpr size_t WS_ZG = WS_Z + 352 * MiB;
constexpr size_t WS_BR = WS_Z + 608 * MiB;
constexpr size_t WS_P = WS_BR + 128 * MiB;
constexpr size_t WS_MERGED = WS_P + 256 * MiB;
constexpr size_t WS_Y = WS_MERGED + 64 * MiB;
constexpr size_t WS_N2 = WS_Y + 128 * MiB;
constexpr size_t WS_VT = WS_N2 + 384 * MiB;
constexpr size_t WS_LRUW = WS_VT + 96 * MiB;
constexpr size_t WS_POOLW = WS_LRUW + 4 * MiB;
constexpr size_t WS_RAW = WS_POOLW + 2 * MiB;
constexpr size_t WS_CWT = WS_RAW + 6 * MiB;
constexpr size_t WS_END = WS_CWT + 1 * MiB;
constexpr size_t WS_LSUM = WS_N2;
constexpr size_t WS_LCIN = WS_N2 + 4 * MiB;
constexpr size_t WS_LSU = WS_N2 + 8 * MiB;
constexpr size_t WS_LAF = WS_N2 + 40 * MiB;
constexpr size_t WS_LAB = WS_N2 + 72 * MiB;
constexpr size_t WS_XR = WS_N2 + 128 * MiB;
constexpr size_t WS_OP01 = WS_H;
constexpr size_t WS_OP2 = WS_Y + 64 * MiB;
constexpr size_t WS_ML = WS_Y + 96 * MiB;
constexpr size_t SEG = (size_t)S_ * W_;
constexpr size_t WS_HQS = WS_P;
constexpr size_t WS_HF = WS_P + 64 * MiB;
constexpr size_t WS_HO = WS_P + 192 * MiB;
constexpr size_t WS_PD = WS_P + 320 * MiB;
constexpr size_t WS_HST = WS_P;
constexpr size_t WS_HDEC = WS_P + 128 * MiB;
constexpr int CW_BAR = 4096;
constexpr int RING_BYTES = 131072, MISC_OFF = 143360, LDS_BYTES = 147456;

typedef unsigned short bf16;
typedef unsigned v4u __attribute__((ext_vector_type(4)));
typedef unsigned v2u __attribute__((ext_vector_type(2)));
typedef float f32x4 __attribute__((ext_vector_type(4)));
#define LDS_WAIT() asm volatile("s_waitcnt lgkmcnt(0)" ::: "memory")
__device__ __forceinline__ unsigned f2bf(float f) { unsigned u = __builtin_bit_cast(unsigned, f); return (u + 0x7fffu + ((u >> 16) & 1u)) >> 16; }
__device__ __forceinline__ unsigned pk2(float lo, float hi) { return f2bf(lo) | (f2bf(hi) << 16); }
typedef __bf16 bf16x2_t __attribute__((ext_vector_type(2)));
typedef float f32x2_t __attribute__((ext_vector_type(2)));
__device__ __forceinline__ unsigned cvtpk(float lo, float hi) { const f32x2_t v = {lo, hi}; return __builtin_bit_cast(unsigned, __builtin_convertvector(v, bf16x2_t)); }
__device__ __forceinline__ float bf2f(unsigned b) { return __builtin_bit_cast(float, b << 16); }
__device__ __forceinline__ float bflo(unsigned w) { return __builtin_bit_cast(float, w << 16); }
__device__ __forceinline__ float bfhi(unsigned w) { return __builtin_bit_cast(float, w & 0xffff0000u); }
__device__ __forceinline__ void unpack8(const v4u w, float (&o)[8]) { o[0] = bflo(w.x); o[1] = bfhi(w.x); o[2] = bflo(w.y); o[3] = bfhi(w.y); o[4] = bflo(w.z); o[5] = bfhi(w.z); o[6] = bflo(w.w); o[7] = bfhi(w.w); }
__device__ __forceinline__ float sigmoidf_(float x) { return __builtin_amdgcn_rcpf(1.0f + __expf(-x)); }
__device__ __forceinline__ float siluf_(float x) { return x * __builtin_amdgcn_rcpf(1.0f + __expf(-x)); }
__device__ __forceinline__ float gelu_tanh(float x) { const float u = 0.7978845608028654f * (x + 0.044715f * x * x * x); const float e = __expf(-2.0f * u); return x * __builtin_amdgcn_rcpf(1.0f + e); }
__device__ __forceinline__ float mk_bperm(int srclane, float v) { return __builtin_bit_cast(float, __builtin_amdgcn_ds_bpermute(srclane << 2, __builtin_bit_cast(int, v))); }
__device__ __forceinline__ float wave_sum(float v) { const int l = mk_lane_id();
#pragma unroll
    for (int o = 1; o < 64; o <<= 1) v += mk_bperm(l ^ o, v);
    return v;
}
__device__ __forceinline__ float wave_max(float v) { const int l = mk_lane_id();
#pragma unroll
    for (int o = 1; o < 64; o <<= 1) v = fmaxf(v, mk_bperm(l ^ o, v));
    return v;
}

struct Args {
    const float *x, *c; const int* pos; const float *ada_w, *ada_b, *norm_g, *w_in, *hgrn_lb, *hgrn_onorm, *lru_conv_w, *lru_conv_b, *lru_wa, *lru_ba, *lru_wx, *lru_bx, *lru_lambda,
        *pool_w, *pool_scale, *w_branch, *w_out, *ffn_up, *ffn_conv_w, *ffn_conv_b, *ffn_down;
    float* out; unsigned char* ws; int ph_lo, ph_hi;
};

struct TJob { const float* W; bf16* WT; int K, N, item, up; };
__device__ __forceinline__ void tr_load(const TJob& j, f32x4 (&v)[16], int lane) { const int nblk = j.N / 64, kb = j.item / nblk, nb = j.item % nblk, k0 = 64 * kb, n0 = 64 * nb;
#pragma unroll
    for (int i = 0; i < 16; ++i) v[i] = *(const f32x4*)(j.W + (size_t)(k0 + 4 * i + (lane >> 4)) * j.N + n0 + 4 * (lane & 15)); }
__device__ __forceinline__ void tr_to_lds(const f32x4 (&v)[16], LAS float* scr, int lane) {
#pragma unroll
    for (int i = 0; i < 16; ++i) { LAS float* s = scr + (4 * i + (lane >> 4)) * 65 + 4 * (lane & 15); s[0] = v[i][0]; s[1] = v[i][1]; s[2] = v[i][2]; s[3] = v[i][3]; }
    LDS_WAIT(); asm volatile("" ::: "memory"); }
__device__ __forceinline__ void tr_store(const TJob& j, LAS float* scr, int lane) { const int nblk = j.N / 64, kb = j.item / nblk, nb = j.item % nblk, k0 = 64 * kb, n0 = 64 * nb;
    int d0 = n0; if (j.up) { const int isv = n0 >= FF ? 1 : 0, c = n0 - isv * FF; d0 = 256 * (c >> 7) + 128 * isv + (c & 127); }
    const int c = lane & 7;
#pragma unroll
    for (int jj = 0; jj < 8; ++jj) { const int n = (lane >> 3) + 8 * jj; const LAS float* s = scr + (8 * c) * 65 + n;
        v4u o; o.x = cvtpk(s[0 * 65], s[1 * 65]); o.y = cvtpk(s[2 * 65], s[3 * 65]); o.z = cvtpk(s[4 * 65], s[5 * 65]); o.w = cvtpk(s[6 * 65], s[7 * 65]);
        *(GAS v4u*)(j.WT + (size_t)(d0 + n) * j.K + k0 + 8 * c) = o; }
    LDS_WAIT(); asm volatile("" ::: "memory"); }
__device__ __forceinline__ TJob tr_job(const Args& a, unsigned char* ws, int it) {
    constexpr int I_IN = (D_ / 64) * (NIN / 64), I_BR1 = (W_ / 64) * (D_ / 64), I_BR = 4 * I_BR1, I_OUT = (D_ / 64) * (D_ / 64), I_UP = (D_ / 64) * (FF2 / 64), I_DN = (FF / 64) * (D_ / 64);
    constexpr int I_LAYER = I_IN + I_BR + I_OUT + I_UP + I_DN, I_BIG = DEPTH * I_LAYER;
    TJob j; j.up = 0;
    if (it < I_BIG) { const int L = it / I_LAYER; int r = it - L * I_LAYER;
        if (r < I_IN) { j.W = a.w_in + (size_t)L * D_ * NIN; j.K = D_; j.N = NIN; j.WT = (bf16*)(ws + WS_WIN) + (size_t)L * NIN * D_; j.item = r; return j; } r -= I_IN;
        if (r < I_BR) { const int g = r / I_BR1; j.W = a.w_branch + ((size_t)L * 4 + g) * W_ * D_; j.K = W_; j.N = D_; j.WT = (bf16*)(ws + WS_WBR) + ((size_t)L * 4 + g) * D_ * W_; j.item = r - g * I_BR1; return j; } r -= I_BR;
        if (r < I_OUT) { j.W = a.w_out + (size_t)L * D_ * D_; j.K = D_; j.N = D_; j.WT = (bf16*)(ws + WS_WOUT) + (size_t)L * D_ * D_; j.item = r; return j; } r -= I_OUT;
        if (r < I_UP) { j.W = a.ffn_up + (size_t)L * D_ * FF2; j.K = D_; j.N = FF2; j.WT = (bf16*)(ws + WS_WUP) + (size_t)L * FF2 * D_; j.item = r; j.up = 1; return j; } r -= I_UP;
        j.W = a.ffn_down + (size_t)L * FF * D_; j.K = FF; j.N = D_; j.WT = (bf16*)(ws + WS_WDN) + (size_t)L * D_ * FF; j.item = r; return j; }
    const int s = it - I_BIG;
    if (s < 512) { const int blk = s >> 2, sel = blk >> 6, rest = blk & 63;
        j.W = (sel ? a.lru_wx : a.lru_wa) + (size_t)rest * 16384; j.K = 128; j.N = 128; j.WT = (bf16*)(ws + WS_LRUW) + (size_t)blk * 16384; j.item = s & 3; return j; }
    const int r = s - 512, blk = r >> 4; j.W = a.pool_w + (size_t)blk * 65536; j.K = 256; j.N = 256; j.WT = (bf16*)(ws + WS_POOLW) + (size_t)blk * 65536; j.item = r & 15; return j;
}
__device__ __forceinline__ void ph_prologue(const Args& a, LAS unsigned char* lds, int bid, int nb, int tid, int wave, int lane) {
    unsigned char* ws = a.ws;
    LAS float* scr = (LAS float*)(lds + wave * 16640);
    const int gw = bid * NWAVES + wave, NGW = nb * NWAVES;
    constexpr int N_ITEMS = DEPTH * ((D_ / 64) * (NIN / 64) + 4 * (W_ / 64) * (D_ / 64) + (D_ / 64) * (D_ / 64) + (D_ / 64) * (FF2 / 64) + (FF / 64) * (D_ / 64)) + 512 + 256;
    if (gw < N_ITEMS) { f32x4 v[16]; TJob cur = tr_job(a, ws, gw); tr_load(cur, v, lane);
        for (int it = gw; it < N_ITEMS; it += NGW) { tr_to_lds(v, scr, lane);
            const bool hn = it + NGW < N_ITEMS; TJob nx = cur; if (hn) { nx = tr_job(a, ws, it + NGW); tr_load(nx, v, lane); }
            tr_store(cur, scr, lane); cur = nx; } }
    __syncthreads();
    LAS float* red = (LAS float*)lds;
    float* mod = (float*)(ws + WS_MOD);
    for (int it = bid; it < DEPTH * 192; it += nb) {
        const int L = it / 192, j0 = (it % 192) * 64;
        const float* wp = a.ada_w + (size_t)L * D_ * 6 * D_ + (size_t)(wave * 256) * 6 * D_ + j0 + lane;
        float acc = 0.f;
        for (int k0 = 0; k0 < 256; k0 += 32) { float wv[32];
#pragma unroll
            for (int k = 0; k < 32; ++k) wv[k] = wp[(size_t)(k0 + k) * 6 * D_];
#pragma unroll
            for (int k = 0; k < 32; ++k) { const float cv = a.c[wave * 256 + k0 + k]; acc += siluf_(cv) * wv[k]; } }
        red[wave * 64 + lane] = acc;
        __syncthreads();
        if (wave == 0) { float s = a.ada_b[L * 6 * D_ + j0 + lane];
#pragma unroll
            for (int w = 0; w < 8; ++w) s += red[w * 64 + lane];
            mod[L * 6 * D_ + j0 + lane] = s; }
        __syncthreads();
    }
    { float* cwt = (float*)(ws + WS_CWT);
      for (int i = bid * NTHR + tid; i < DEPTH * 43 * 8 * 128; i += nb * NTHR) { const int c = i & 127, r = (i >> 7) & 7, pn = (i >> 10) % 43, L = (i >> 10) / 43, ch = (r >> 2) * FF + pn * 128 + c, k = r & 3;
          cwt[i] = k == 0 ? a.ffn_conv_b[(size_t)L * FF2 + ch] : a.ffn_conv_w[((size_t)L * 3 + (k - 1)) * FF2 + ch]; } }
    if (bid == 0) { float* lb = (float*)(ws + WS_LB);
        for (int i = tid; i < 2 * W_; i += NTHR) { float e[DEPTH], s = 0.f;
#pragma unroll
            for (int L = 0; L < DEPTH; ++L) e[L] = a.hgrn_lb[L * 2 * W_ + i];
            const float mx = fmaxf(fmaxf(e[0], e[1]), fmaxf(e[2], e[3]));
#pragma unroll
            for (int L = 0; L < DEPTH; ++L) { e[L] = expf(e[L] - mx); s += e[L]; }
            float cum = 0.f; lb[i] = 0.f;
#pragma unroll
            for (int L = 1; L < DEPTH; ++L) { cum += e[L] / s; lb[L * 2 * W_ + i] = cum; } } }
    { float2* rot = (float2*)(ws + WS_ROT);
      for (int i = bid * NTHR + tid; i < S_ * 64; i += nb * NTHR) { const int t = i >> 6, d = i & 63;
          const float inv = powf(10000.0f, -(float)d / 64.0f); const float ang = (float)a.pos[t] * inv; float sn, cs; sincosf(ang, &sn, &cs); rot[i] = make_float2(cs, sn); } }
}

template <bool HAS_Y>
__device__ __forceinline__ void ph_resnorm(const Args& a, LAS unsigned char* lds, int bid, int nb, int tid, int wave, int lane,
                                           const float* xsrc, float* xdst, const bf16* y, bf16* hdst, int L, int gsel, int ysel, int Lh, int hsel, int scsel, int shsel, const bf16* xsrcb = nullptr, bf16* xdstb = nullptr) {
    const float* mod = (const float*)(a.ws + WS_MOD);
    LAS float* cy = (LAS float*)lds; LAS float* ca = cy + D_; LAS float* cb = ca + D_;
    for (int c = tid; c < D_; c += NTHR) {
        if (HAS_Y) cy[c] = mod[L * 6 * D_ + gsel * D_ + c] * a.norm_g[(L * 4 + ysel) * D_ + c];
        if (hdst) { ca[c] = a.norm_g[(Lh * 4 + hsel) * D_ + c] * (1.0f + mod[Lh * 6 * D_ + scsel * D_ + c]); cb[c] = mod[Lh * 6 * D_ + shsel * D_ + c]; }
    }
    __syncthreads();
#pragma unroll 2
    for (int row = bid * NWAVES + wave; row < S_; row += nb * NWAVES) {
        f32x4 xv[8];
        if (xsrcb) { const v2u* xb = (const v2u*)(xsrcb + (size_t)row * D_) + lane;
#pragma unroll
            for (int j = 0; j < 8; ++j) { const v2u w = __builtin_nontemporal_load(&xb[64 * j]); xv[j] = (f32x4){bflo(w.x), bfhi(w.x), bflo(w.y), bfhi(w.y)}; } }
        else { const f32x4* xr = (const f32x4*)(xsrc + (size_t)row * D_) + lane;
#pragma unroll
            for (int j = 0; j < 8; ++j) xv[j] = __builtin_nontemporal_load(&xr[64 * j]); }
        if (HAS_Y) {
            const v2u* yr = (const v2u*)(y + (size_t)row * D_) + lane; f32x4 yv[8]; float ss = 0.f;
#pragma unroll
            for (int j = 0; j < 8; ++j) { const v2u yw = __builtin_nontemporal_load(&yr[64 * j]); yv[j] = (f32x4){bflo(yw.x), bfhi(yw.x), bflo(yw.y), bfhi(yw.y)}; ss += (yv[j].x * yv[j].x + yv[j].y * yv[j].y) + (yv[j].z * yv[j].z + yv[j].w * yv[j].w); }
            const float r = rsqrtf(wave_sum(ss) * (1.0f / D_) + RMS_EPS);
            if (xdstb) { v2u* xo = (v2u*)(xdstb + (size_t)row * D_) + lane;
#pragma unroll
                for (int j = 0; j < 8; ++j) { const f32x4 cv = *(const LAS f32x4*)(cy + 4 * (lane + 64 * j)); xv[j] = xv[j] + yv[j] * r * cv; v2u w; w.x = pk2(xv[j].x, xv[j].y); w.y = pk2(xv[j].z, xv[j].w); __builtin_nontemporal_store(w, &xo[64 * j]); } }
            else { f32x4* xo = (f32x4*)(xdst + (size_t)row * D_) + lane;
#pragma unroll
                for (int j = 0; j < 8; ++j) { const f32x4 cv = *(const LAS f32x4*)(cy + 4 * (lane + 64 * j)); xv[j] = xv[j] + yv[j] * r * cv; __builtin_nontemporal_store(xv[j], &xo[64 * j]); } }
        }
        if (hdst) {
            float ss = 0.f;
#pragma unroll
            for (int j = 0; j < 8; ++j) ss += (xv[j].x * xv[j].x + xv[j].y * xv[j].y) + (xv[j].z * xv[j].z + xv[j].w * xv[j].w);
            const float r = rsqrtf(wave_sum(ss) * (1.0f / D_) + RMS_EPS);
            v2u* ho = (v2u*)(hdst + (size_t)row * D_) + lane;
#pragma unroll
            for (int j = 0; j < 8; ++j) { const f32x4 av = *(const LAS f32x4*)(ca + 4 * (lane + 64 * j)), bv = *(const LAS f32x4*)(cb + 4 * (lane + 64 * j)); const f32x4 h = xv[j] * r * av + bv;
                v2u w; w.x = pk2(h.x, h.y); w.y = pk2(h.z, h.w); ho[64 * j] = w; }
        }
    }
    __syncthreads();
}

__device__ __forceinline__ void ph_hgrn_prep(const Args& a, int L, int bid, int nb, int tid) {
    const bf16* z = (const bf16*)(a.ws + WS_Z); const float* lb = (const float*)(a.ws + WS_LB) + L * 2 * W_;
    float* QS = (float*)(a.ws + WS_HQS); float* F = (float*)(a.ws + WS_HF);
    for (size_t i = (size_t)bid * NTHR + tid; i < SEG; i += (size_t)nb * NTHR) { const int ch = (int)(i & (W_ - 1));
        QS[i] = siluf_(bf2f(z[0 * SEG + i]));
        const float l0 = lb[ch], l1 = lb[W_ + ch];
        F[i] = l0 + (1.0f - l0) * sigmoidf_(bf2f(z[1 * SEG + i])); F[SEG + i] = l1 + (1.0f - l1) * sigmoidf_(bf2f(z[2 * SEG + i])); }
}
__device__ __forceinline__ void ph_hgrn_rec(const Args& a, LAS unsigned char* lds, int bid, int tid) {
    if (bid >= 16) return;
    const int dir = bid >> 3, head = bid & 7, kq = tid >> 7, v = tid & 127;
    const bf16* zi = (const bf16*)(a.ws + WS_Z) + 3 * SEG; const float* QS = (const float*)(a.ws + WS_HQS); const float* F = (const float*)(a.ws + WS_HF) + (size_t)dir * SEG;
    float* HO = (float*)(a.ws + WS_HO) + (size_t)dir * SEG;
    LAS float* part = (LAS float*)lds;
    float st[32];
#pragma unroll
    for (int j = 0; j < 32; ++j) st[j] = 0.f;
    for (int n0 = 0; n0 < S_; n0 += 8) {
#pragma unroll 1
        for (int s = 0; s < 8; ++s) { const int n = n0 + s, t = dir ? S_ - 1 - n : n;
            const float iv = bf2f(zi[(size_t)t * W_ + head * HD + v]);
            const f32x4* fp = (const f32x4*)(F + (size_t)t * W_ + head * HD + kq * 32); const f32x4* qp = (const f32x4*)(QS + (size_t)t * W_ + head * HD + kq * 32);
            float o = 0.f;
#pragma unroll
            for (int j = 0; j < 8; ++j) { const f32x4 f = fp[j], q = qp[j];
                st[4 * j + 0] = f.x * st[4 * j + 0] + (1.0f - f.x) * iv; o += q.x * st[4 * j + 0];
                st[4 * j + 1] = f.y * st[4 * j + 1] + (1.0f - f.y) * iv; o += q.y * st[4 * j + 1];
                st[4 * j + 2] = f.z * st[4 * j + 2] + (1.0f - f.z) * iv; o += q.z * st[4 * j + 2];
                st[4 * j + 3] = f.w * st[4 * j + 3] + (1.0f - f.w) * iv; o += q.w * st[4 * j + 3]; }
            part[(kq * 8 + s) * 128 + v] = o; }
        __syncthreads();
#pragma unroll
        for (int h = 0; h < 2; ++h) { const int s = (tid >> 7) + 4 * h; const int n = n0 + s, t = dir ? S_ - 1 - n : n;
            HO[(size_t)t * W_ + head * HD + v] = (part[(0 * 8 + s) * 128 + v] + part[(1 * 8 + s) * 128 + v]) + (part[(2 * 8 + s) * 128 + v] + part[(3 * 8 + s) * 128 + v]); }
        __syncthreads();
    }
}
__device__ __forceinline__ void ph_hgrn_fin(const Args& a, int L, int bid, int nb, int wave, int lane) {
    const float* HO = (const float*)(a.ws + WS_HO); const bf16* zg = (const bf16*)(a.ws + WS_Z) + 4 * SEG; bf16* br = (bf16*)(a.ws + WS_BR);
    for (int it = bid * NWAVES + wave; it < S_ * NHEAD; it += nb * NWAVES) { const int t = it >> 3, h = it & 7; const size_t o0 = (size_t)t * W_ + h * HD + 2 * lane;
        const float o_a = HO[o0] + HO[SEG + o0], o_b = HO[o0 + 1] + HO[SEG + o0 + 1];
        const float r = rsqrtf(wave_sum(o_a * o_a + o_b * o_b) * (1.0f / HD) + RMS_EPS);
        const unsigned gw = *(const unsigned*)(zg + o0); const float* on = a.hgrn_onorm + L * W_ + h * HD + 2 * lane;
        *(unsigned*)(br + o0) = pk2(o_a * r * on[0] * siluf_(bflo(gw)), o_b * r * on[1] * siluf_(bfhi(gw))); }
}
__device__ __forceinline__ void ph_lru_xc(const Args& a, int L, int bid, int nb, int tid) {
    const bf16* zx = (const bf16*)(a.ws + WS_Z) + 5 * SEG; float* XC = (float*)(a.ws + WS_N2);
    const float* cw = a.lru_conv_w + (size_t)L * 2 * 4 * W_; const float* cbp = a.lru_conv_b + (size_t)L * 2 * W_;
    for (size_t i = (size_t)bid * NTHR + tid; i < SEG; i += (size_t)nb * NTHR) { const int ch = (int)(i & (W_ - 1)), t = (int)(i >> 10);
        float f = cbp[ch], b = cbp[W_ + ch];
#pragma unroll
        for (int j = 0; j < 4; ++j) { const int tf = t - 3 + j, tb = t + 3 - j;
            if (tf >= 0) f += cw[(0 * 4 + j) * W_ + ch] * bf2f(zx[(size_t)tf * W_ + ch]);
            if (tb < S_) b += cw[(1 * 4 + j) * W_ + ch] * bf2f(zx[(size_t)tb * W_ + ch]); }
        XC[i] = f; XC[SEG + i] = b; }
}
__device__ __forceinline__ void ph_lru_gates(const Args& a, int L, int bid, int nb, int tid) {
    const float* XC = (const float*)(a.ws + WS_N2); float* A = (float*)(a.ws + WS_N2 + 128 * MiB); float* U = (float*)(a.ws + WS_N2 + 256 * MiB);
    for (size_t i = (size_t)bid * NTHR + tid; i < 2 * SEG; i += (size_t)nb * NTHR) { const int dir = (int)(i / SEG); const size_t r = i - (size_t)dir * SEG; const int t = (int)(r >> 10), ch = (int)(r & (W_ - 1)), hh = ch >> 7, jj = ch & 127;
        const float* xr = XC + (size_t)dir * SEG + (size_t)t * W_ + hh * 128;
        const float* wa = a.lru_wa + (((size_t)L * 2 + dir) * 8 + hh) * 128 * 128 + jj; const float* wx = a.lru_wx + (((size_t)L * 2 + dir) * 8 + hh) * 128 * 128 + jj;
        float ra = a.lru_ba[(L * 2 + dir) * W_ + ch], rx = a.lru_bx[(L * 2 + dir) * W_ + ch];
#pragma unroll 8
        for (int k = 0; k < 128; ++k) { const float xv = xr[k]; ra += xv * wa[k * 128]; rx += xv * wx[k * 128]; }
        const float rg = sigmoidf_(ra), ig = sigmoidf_(rx);
        const float lam = a.lru_lambda[(L * 2 + dir) * W_ + ch]; const float sp = log1pf(expf(-lam));
        const float la = -8.0f * rg * sp;
        A[i] = expf(la); U[i] = sqrtf(-expm1f(2.0f * la)) * (ig * xr[jj]); }
}
__device__ __forceinline__ void ph_lru_scan(const Args& a, int bid, int tid) {
    const int id = bid * NTHR + tid; if (id >= 2 * W_) return;
    const int dir = id >> 10, ch = id & (W_ - 1);
    const float* A = (const float*)(a.ws + WS_N2 + 128 * MiB) + (size_t)dir * SEG + ch; float* U = (float*)(a.ws + WS_N2 + 256 * MiB) + (size_t)dir * SEG + ch;
    float h = 0.f;
    for (int n0 = 0; n0 < S_; n0 += 8) { float av[8], uv[8];
#pragma unroll
        for (int s = 0; s < 8; ++s) { const int n = n0 + s, t = dir ? S_ - 1 - n : n; av[s] = A[(size_t)t * W_]; uv[s] = U[(size_t)t * W_]; }
#pragma unroll
        for (int s = 0; s < 8; ++s) { const int n = n0 + s, t = dir ? S_ - 1 - n : n; h = av[s] * h + uv[s]; U[(size_t)t * W_] = h; } }
}
__device__ __forceinline__ void ph_lru_fin(const Args& a, int bid, int nb, int tid) {
    const float* U = (const float*)(a.ws + WS_N2 + 256 * MiB); const bf16* zg = (const bf16*)(a.ws + WS_Z) + 6 * SEG; bf16* br = (bf16*)(a.ws + WS_BR) + SEG;
    for (size_t i = (size_t)bid * NTHR + tid; i < SEG; i += (size_t)nb * NTHR) br[i] = (bf16)f2bf((U[i] + U[SEG + i]) * gelu_tanh(bf2f(zg[i])));
}
__device__ __forceinline__ void ph_pool_d(const Args& a, int bid, int nb, int tid) {
    const bf16* zp = (const bf16*)(a.ws + WS_Z) + 7 * SEG; float* PD = (float*)(a.ws + WS_PD);
    for (size_t i = (size_t)bid * NTHR + tid; i < SEG; i += (size_t)nb * NTHR) { const int ch = (int)(i & (W_ - 1)), t = (int)(i >> 10), w2 = 1 << (ch >> 8);
        const int lo = max(t - w2, 0), hi = min(t + w2, S_); float s = 0.f;
        for (int tt = lo; tt < hi; ++tt) s += bf2f(zp[(size_t)tt * W_ + ch]);
        PD[i] = s / (float)(hi - lo) - bf2f(zp[i]); }
}
__device__ __forceinline__ void ph_pool_mm(const Args& a, int L, int bid, int nb, int tid) {
    const float* PD = (const float*)(a.ws + WS_PD); bf16* br = (bf16*)(a.ws + WS_BR) + 2 * SEG;
    for (size_t i = (size_t)bid * NTHR + tid; i < SEG; i += (size_t)nb * NTHR) { const int ch = (int)(i & (W_ - 1)), t = (int)(i >> 10), gi = ch >> 8, jj = ch & 255;
        const float* dr = PD + (size_t)t * W_ + gi * 256; const float* pw = a.pool_w + ((size_t)L * 4 + gi) * 256 * 256 + jj; float s = 0.f;
#pragma unroll 8
        for (int k = 0; k < 256; ++k) s += dr[k] * pw[k * 256];
        br[i] = (bf16)f2bf(s * a.pool_scale[L * W_ + ch]); }
}
__device__ __forceinline__ void ph_attn_prep(unsigned char* ws, int bid, int nb, int tid) {
    bf16* zq = (bf16*)(ws + WS_Z) + 8 * SEG; bf16* zk = zq + SEG; const float2* rot = (const float2*)(ws + WS_ROT);
#pragma unroll 4
    for (int i = bid * NTHR + tid; i < S_ * NHEAD * 8; i += nb * NTHR) { const int d8 = (i & 7) * 8, h = (i >> 3) & 7, t = i >> 6;
        const size_t o = (size_t)t * W_ + h * HD + d8;
        const v4u q1 = *(const v4u*)(zq + o), q2 = *(const v4u*)(zq + o + 64), k1 = *(const v4u*)(zk + o), k2 = *(const v4u*)(zk + o + 64);
        const f32x4* rp = (const f32x4*)(rot + t * 64 + d8); const f32x4 r0 = rp[0], r1 = rp[1], r2 = rp[2], r3 = rp[3];
        const float cs[8] = {r0[0], r0[2], r1[0], r1[2], r2[0], r2[2], r3[0], r3[2]}, sn[8] = {r0[1], r0[3], r1[1], r1[3], r2[1], r2[3], r3[1], r3[3]};
        const unsigned qa[4] = {q1.x, q1.y, q1.z, q1.w}, qb[4] = {q2.x, q2.y, q2.z, q2.w}, ka[4] = {k1.x, k1.y, k1.z, k1.w}, kb[4] = {k2.x, k2.y, k2.z, k2.w};
        unsigned oq1[4], oq2[4], ok1[4], ok2[4]; const float sc = 0.08838834764831845f;
#pragma unroll
        for (int j = 0; j < 4; ++j) { const float c0 = cs[2 * j], s0 = sn[2 * j], c1 = cs[2 * j + 1], s1 = sn[2 * j + 1];
            const float a0 = bflo(qa[j]), a1 = bfhi(qa[j]), b0 = bflo(qb[j]), b1 = bfhi(qb[j]);
            oq1[j] = cvtpk((a0 * c0 - b0 * s0) * sc, (a1 * c1 - b1 * s1) * sc); oq2[j] = cvtpk((b0 * c0 + a0 * s0) * sc, (b1 * c1 + a1 * s1) * sc);
            const float e0 = bflo(ka[j]), e1 = bfhi(ka[j]), f0 = bflo(kb[j]), f1 = bfhi(kb[j]);
            ok1[j] = cvtpk(e0 * c0 - f0 * s0, e1 * c1 - f1 * s1); ok2[j] = cvtpk(f0 * c0 + e0 * s0, f1 * c1 + e1 * s1); }
        *(v4u*)(zq + o) = (v4u){oq1[0], oq1[1], oq1[2], oq1[3]}; *(v4u*)(zq + o + 64) = (v4u){oq2[0], oq2[1], oq2[2], oq2[3]};
        *(v4u*)(zk + o) = (v4u){ok1[0], ok1[1], ok1[2], ok1[3]}; *(v4u*)(zk + o + 64) = (v4u){ok2[0], ok2[1], ok2[2], ok2[3]}; }
}
__device__ __forceinline__ void ph_attn_naive(const Args& a, LAS unsigned char* lds, int bid, int nb, int wave, int lane) {
    const bf16* zq = (const bf16*)(a.ws + WS_Z) + 8 * SEG; const bf16* zk = zq + SEG; const bf16* zv = zk + SEG; bf16* br = (bf16*)(a.ws + WS_BR) + 3 * SEG;
    LAS float* qs = (LAS float*)(lds + wave * 4096); LAS float* ps = qs + 128;
    for (int it = bid * NWAVES + wave; it < S_ * NHEAD; it += nb * NWAVES) { const int t = it >> 3, h = it & 7;
        { const unsigned qw = *(const unsigned*)(zq + (size_t)t * W_ + h * HD + 2 * lane); qs[2 * lane] = bflo(qw); qs[2 * lane + 1] = bfhi(qw); }
        LDS_WAIT(); asm volatile("" ::: "memory");
        float sv[7]; float mx = -1e30f;
#pragma unroll
        for (int i = 0; i < 7; ++i) { const int e = lane + 64 * i; float s = -1e30f;
            if (e < 387) { const int g = e / 129, o = e - g * 129 - 64, dil = (g == 0) ? 1 : (g == 1 ? 4 : 16), p = t + dil * o;
                if (p >= 0 && p < S_) { const v4u* kr = (const v4u*)(zk + (size_t)p * W_ + h * HD); float d = 0.f;
#pragma unroll 4
                    for (int c = 0; c < 16; ++c) { const v4u kw = kr[c]; const LAS float* qq = qs + 8 * c;
                        d += qq[0] * bflo(kw.x) + qq[1] * bfhi(kw.x) + qq[2] * bflo(kw.y) + qq[3] * bfhi(kw.y) + qq[4] * bflo(kw.z) + qq[5] * bfhi(kw.z) + qq[6] * bflo(kw.w) + qq[7] * bfhi(kw.w); }
                    s = d; } }
            sv[i] = s; mx = fmaxf(mx, s); }
        mx = wave_max(mx); float l = 0.f;
#pragma unroll
        for (int i = 0; i < 7; ++i) { const float p = (sv[i] > -1e29f) ? __expf(sv[i] - mx) : 0.f; l += p; ps[lane + 64 * i] = p; }
        l = wave_sum(l);
        LDS_WAIT(); asm volatile("" ::: "memory");
        float o0 = 0.f, o1 = 0.f;
        for (int e = 0; e < 387; ++e) { const float p = ps[e]; if (p != 0.f) { const int g = e / 129, o = e - g * 129 - 64, dil = (g == 0) ? 1 : (g == 1 ? 4 : 16), pp = t + dil * o;
                const unsigned vw = *(const unsigned*)(zv + (size_t)pp * W_ + h * HD + 2 * lane); o0 += p * bflo(vw); o1 += p * bfhi(vw); } }
        const float il = 1.0f / l;
        *(unsigned*)(br + (size_t)t * W_ + h * HD + 2 * lane) = pk2(o0 * il, o1 * il);
        LDS_WAIT(); asm volatile("" ::: "memory");
    }
}

typedef short bf16x8 __attribute__((ext_vector_type(8)));
__device__ __forceinline__ bf16* op_ptr(unsigned char* ws, int g) { return g < 2 ? (bf16*)(ws + WS_OP01) + (size_t)g * SEG : (bf16*)(ws + WS_OP2); }
typedef short s16x4 __attribute__((ext_vector_type(4)));
__device__ __forceinline__ bf16x8 tr_frag(const LAS bf16* T, int pitch, int r0, int c0, int lane) {
    const LAS bf16* p = T + (r0 + 8 * (lane >> 4) + ((lane & 15) >> 2)) * pitch + c0 + 4 * (lane & 3);
    const s16x4 x = __builtin_amdgcn_ds_read_tr16_b64_v4i16((LAS s16x4*)p), y = __builtin_amdgcn_ds_read_tr16_b64_v4i16((LAS s16x4*)(p + 4 * pitch));
    return __builtin_shufflevector(x, y, 0, 1, 2, 3, 4, 5, 6, 7);
}
__device__ __forceinline__ bf16x8 tr_frag_rs(const LAS bf16* T, int pitch, int r0, int rs, int c0, int lane) {
    const LAS bf16* p = T + (r0 + rs * (8 * (lane >> 4) + ((lane & 15) >> 2))) * pitch + c0 + 4 * (lane & 3);
    const s16x4 x = __builtin_amdgcn_ds_read_tr16_b64_v4i16((LAS s16x4*)p), y = __builtin_amdgcn_ds_read_tr16_b64_v4i16((LAS s16x4*)(p + 4 * rs * pitch));
    return __builtin_shufflevector(x, y, 0, 1, 2, 3, 4, 5, 6, 7);
}
__device__ __forceinline__ size_t vt_off(int g, int h, int d, int rr, int Lg, int l) { return ((size_t)g * NHEAD + h) * ((size_t)S_ * HD) + (size_t)rr * Lg * HD + (size_t)(l >> 5) * (32 * HD) + d * 32 + (l & 31); }
__device__ __forceinline__ void ph_attn_vt(unsigned char* ws, LAS unsigned char* lds, int bid, int nb, int tid, int wave, int lane) {
    const bf16* zv = (const bf16*)(ws + WS_Z) + 10 * SEG; bf16* VT = (bf16*)(ws + WS_VT);
    LAS bf16* T = (LAS bf16*)lds; const int n = lane & 15, G = lane >> 4;
    for (int unit = bid; unit < NHEAD * (S_ / 256); unit += nb) { const int h = unit & 7, t0 = (unit >> 3) * 256;
#pragma unroll
        for (int ps = 0; ps < 8; ++ps) { const int i = (tid >> 4) + 32 * ps, c = tid & 15;
            *(LAS v4u*)(T + i * 136 + 8 * c) = *(const v4u*)(zv + (size_t)(t0 + i) * W_ + h * HD + 8 * c); }
        __syncthreads();
#pragma unroll
        for (int g = 0; g < 3; ++g) { const int dsh = 2 * g, dil = 1 << dsh, Lg = S_ >> dsh;
#pragma unroll
            for (int q = 0; q < 8; ++q) {
                const int runs = 8 >> dsh;
                if (g < 2) { const int rr = q / runs, run = q % runs;
                    const bf16x8 v = tr_frag_rs(T, 136, rr + 32 * run * dil, dil, 16 * wave, lane);
                    *(v4u*)(VT + vt_off(g, h, 16 * wave + n, rr, Lg, (t0 >> dsh) + 32 * run + 8 * G)) = __builtin_bit_cast(v4u, v); }
                else {
                    const int rr = 2 * q + (G >> 1);
                    const LAS bf16* p = T + (rr + 16 * (8 * (G & 1) + ((lane & 15) >> 2))) * 136 + 16 * wave + 4 * (lane & 3);
                    const s16x4 x = __builtin_amdgcn_ds_read_tr16_b64_v4i16((LAS s16x4*)p), y = __builtin_amdgcn_ds_read_tr16_b64_v4i16((LAS s16x4*)(p + 4 * 16 * 136));
                    const bf16x8 v = __builtin_shufflevector(x, y, 0, 1, 2, 3, 4, 5, 6, 7);
                    *(v4u*)(VT + vt_off(g, h, 16 * wave + n, rr, Lg, (t0 >> dsh) + 8 * (G & 1))) = __builtin_bit_cast(v4u, v); } } }
        __syncthreads();
    }
}
__device__ __forceinline__ void ph_attn_main(unsigned char* ws, int bid, int nb, int wave, int lane) {
    const bf16* QR = (const bf16*)(ws + WS_Z) + 8 * SEG; const bf16* KR = QR + SEG; const bf16* VT = (const bf16*)(ws + WS_VT); float2* ML = (float2*)(ws + WS_ML);
    const int n = lane & 15, G = lane >> 4;
    const int vb = (nb & 7) == 0 ? (bid & 7) * (nb >> 3) + (bid >> 3) : bid;
    for (int unit = vb * NWAVES + wave; unit < 3 * 4096; unit += nb * NWAVES) {
        const int g = unit >> 12, u = unit & 4095, dsh = 2 * g, Lg = S_ >> dsh, nqb = Lg >> 5, h = u >> 9, rr = (u & 511) / nqb, qb = (u & 511) - rr * nqb;
        bf16x8 bq[2][4];
#pragma unroll
        for (int qk = 0; qk < 2; ++qk) { const unsigned qofs = (unsigned)((((32 * qb + 16 * qk + n) << dsh) + rr) * (W_ * 2) + h * (HD * 2) + 16 * G);
#pragma unroll
            for (int kk = 0; kk < 4; ++kk) bq[qk][kk] = *(const bf16x8*)((const char*)QR + qofs + 64 * kk); }
        f32x4 acc[8][2]; float mrun[2] = {-1e30f, -1e30f}, lsum[2] = {0.f, 0.f};
#pragma unroll
        for (int db = 0; db < 8; ++db) { acc[db][0] = (f32x4){0.f, 0.f, 0.f, 0.f}; acc[db][1] = (f32x4){0.f, 0.f, 0.f, 0.f}; }
        const bf16* vtb = VT + vt_off(g, h, n, rr, Lg, 8 * G);
#define ATT_LDK(dst, kbase_) do { _Pragma("unroll") for (int b = 0; b < 2; ++b) { int lk = (kbase_) + 8 * (n >> 2) + 4 * b + (n & 3); lk = lk < 0 ? 0 : (lk >= Lg ? Lg - 1 : lk); \
            const unsigned kofs_ = (unsigned)(((lk << dsh) + rr) * (W_ * 2) + h * (HD * 2) + 16 * G); _Pragma("unroll") for (int kk = 0; kk < 4; ++kk) dst[b][kk] = *(const bf16x8*)((const char*)KR + kofs_ + 64 * kk); } } while (0)
        bf16x8 ak[2][2][4];
        const int koff = (5 - qb % 5) % 5;
#define ATT_SIDX(i_) (((i_) + koff) >= 5 ? (i_) + koff - 5 : (i_) + koff)
        ATT_LDK(ak[0], 32 * qb - 64 + 32 * ATT_SIDX(0));
#pragma unroll
        for (int step = 0; step < 5; ++step) { const int kbase = 32 * qb - 64 + 32 * ATT_SIDX(step), cb = step & 1;
            int kblk = kbase >> 5; kblk = kblk < 0 ? 0 : (kblk > (Lg >> 5) - 1 ? (Lg >> 5) - 1 : kblk);
            bf16x8 av[8]; const bf16* vstep = vtb + (size_t)kblk * (32 * HD);
#pragma unroll
            for (int db = 0; db < 8; ++db) av[db] = *(const bf16x8*)(vstep + db * 512);
#if ATT_EXP == 1
            if (step < 4) { _Pragma("unroll") for (int b_ = 0; b_ < 2; ++b_) _Pragma("unroll") for (int k_ = 0; k_ < 4; ++k_) ak[cb ^ 1][b_][k_] = ak[cb][b_][k_]; }
#else
            if (step < 4) ATT_LDK(ak[cb ^ 1], 32 * qb - 64 + 32 * ATT_SIDX(step + 1));
#endif
            f32x4 st[2][2];
#pragma unroll
            for (int b = 0; b < 2; ++b)
#pragma unroll
                for (int qk = 0; qk < 2; ++qk) { f32x4 s = (f32x4){0.f, 0.f, 0.f, 0.f};
#pragma unroll
                    for (int kk = 0; kk < 4; ++kk) s = __builtin_amdgcn_mfma_f32_16x16x32_bf16(ak[cb][b][kk], bq[qk][kk], s, 0, 0, 0);
                    st[qk][b] = s; }
            bf16x8 pb[2];
#pragma unroll
            for (int qk = 0; qk < 2; ++qk) { const int lq = 32 * qb + 16 * qk + n; float sv[8]; float mx = mrun[qk];
#pragma unroll
                for (int j = 0; j < 8; ++j) { const int lk = kbase + 8 * G + j; const int df = lk - lq; const bool valid = (lk >= 0) && (lk < Lg) && (df <= 64) && (df >= -64);
                    sv[j] = valid ? st[qk][j >> 2][j & 3] : -1e30f; mx = fmaxf(mx, sv[j]); }
                mx = fmaxf(mx, mk_bperm(lane ^ 16, mx)); mx = fmaxf(mx, mk_bperm(lane ^ 32, mx));
                const float alpha = __expf(mrun[qk] - mx); mrun[qk] = mx; float ps = 0.f; float p[8];
#pragma unroll
                for (int j = 0; j < 8; ++j) { p[j] = sv[j] > -1e29f ? __expf(sv[j] - mx) : 0.f; ps += p[j]; }
                lsum[qk] = lsum[qk] * alpha + ps;
                v4u pw; pw.x = cvtpk(p[0], p[1]); pw.y = cvtpk(p[2], p[3]); pw.z = cvtpk(p[4], p[5]); pw.w = cvtpk(p[6], p[7]); pb[qk] = __builtin_bit_cast(bf16x8, pw);
#pragma unroll
                for (int db = 0; db < 8; ++db) acc[db][qk] = acc[db][qk] * alpha; }
#pragma unroll
            for (int db = 0; db < 8; ++db) {
                acc[db][0] = __builtin_amdgcn_mfma_f32_16x16x32_bf16(av[db], pb[0], acc[db][0], 0, 0, 0); acc[db][1] = __builtin_amdgcn_mfma_f32_16x16x32_bf16(av[db], pb[1], acc[db][1], 0, 0, 0); }
        }
#undef ATT_LDK
#undef ATT_SIDX
        bf16* OP = op_ptr(ws, g);
#pragma unroll
        for (int qk = 0; qk < 2; ++qk) { float l = lsum[qk]; l += mk_bperm(lane ^ 16, l); l += mk_bperm(lane ^ 32, l); const float il = 1.0f / l;
            const size_t tq = ((size_t)(32 * qb + 16 * qk + n) << dsh) + rr;
#pragma unroll
            for (int db = 0; db < 8; ++db) { const f32x4 o = acc[db][qk] * il; v2u w; w.x = cvtpk(o[0], o[1]); w.y = cvtpk(o[2], o[3]); *(v2u*)(OP + tq * W_ + h * HD + 16 * db + 4 * G) = w; }
            if (G == 0) ML[((size_t)g * S_ + tq) * NHEAD + h] = make_float2(mrun[qk], l); }
    }
}
__device__ __forceinline__ void ph_attn_comb(unsigned char* ws, int bid, int nb, int tid) {
    const float2* ML = (const float2*)(ws + WS_ML); bf16* br = (bf16*)(ws + WS_BR) + 3 * SEG;
    const bf16* O0 = op_ptr(ws, 0); const bf16* O1 = op_ptr(ws, 1); const bf16* O2 = op_ptr(ws, 2);
#pragma unroll 8
    for (size_t i = (size_t)bid * NTHR + tid; i < SEG / 8; i += (size_t)nb * NTHR) { const size_t e = i * 8; const int t = (int)(e >> 10), h = (int)((e >> 7) & 7);
        const float2 a0 = ML[((size_t)0 * S_ + t) * NHEAD + h], a1 = ML[((size_t)1 * S_ + t) * NHEAD + h], a2 = ML[((size_t)2 * S_ + t) * NHEAD + h];
        const float M = fmaxf(a0.x, fmaxf(a1.x, a2.x)); float w0 = __expf(a0.x - M) * a0.y, w1 = __expf(a1.x - M) * a1.y, w2 = __expf(a2.x - M) * a2.y; const float iw = 1.0f / (w0 + w1 + w2); w0 *= iw; w1 *= iw; w2 *= iw;
        const v4u x0 = *(const v4u*)(O0 + e), x1 = *(const v4u*)(O1 + e), x2 = *(const v4u*)(O2 + e); v4u o;
        o.x = pk2(w0 * bflo(x0.x) + w1 * bflo(x1.x) + w2 * bflo(x2.x), w0 * bfhi(x0.x) + w1 * bfhi(x1.x) + w2 * bfhi(x2.x));
        o.y = pk2(w0 * bflo(x0.y) + w1 * bflo(x1.y) + w2 * bflo(x2.y), w0 * bfhi(x0.y) + w1 * bfhi(x1.y) + w2 * bfhi(x2.y));
        o.z = pk2(w0 * bflo(x0.z) + w1 * bflo(x1.z) + w2 * bflo(x2.z), w0 * bfhi(x0.z) + w1 * bfhi(x1.z) + w2 * bfhi(x2.z));
        o.w = pk2(w0 * bflo(x0.w) + w1 * bflo(x1.w) + w2 * bflo(x2.w), w0 * bfhi(x0.w) + w1 * bfhi(x1.w) + w2 * bfhi(x2.w));
        *(v4u*)(br + e) = o; }
}

__device__ __forceinline__ void unpack16(const v4u w0, const v4u w1, float (&o)[16]) { const unsigned ww[8] = {w0.x, w0.y, w0.z, w0.w, w1.x, w1.y, w1.z, w1.w};
#pragma unroll
    for (int i = 0; i < 8; ++i) { o[2 * i] = bflo(ww[i]); o[2 * i + 1] = bfhi(ww[i]); } }
__device__ __forceinline__ void pack16_store(LAS bf16* dst, const float (&v)[16]) { v4u o0, o1; o0.x = cvtpk(v[0], v[1]); o0.y = cvtpk(v[2], v[3]); o0.z = cvtpk(v[4], v[5]); o0.w = cvtpk(v[6], v[7]);
    o1.x = cvtpk(v[8], v[9]); o1.y = cvtpk(v[10], v[11]); o1.z = cvtpk(v[12], v[13]); o1.w = cvtpk(v[14], v[15]); *(LAS v4u*)dst = o0; *(LAS v4u*)(dst + 8) = o1; }
__device__ __forceinline__ void pack8_store(LAS bf16* dst, const float* v) { v4u o; o.x = cvtpk(v[0], v[1]); o.y = cvtpk(v[2], v[3]); o.z = cvtpk(v[4], v[5]); o.w = cvtpk(v[6], v[7]); *(LAS v4u*)dst = o; }
__device__ __forceinline__ void hg_gate_scan(const v4u za, const v4u zb, const LAS float* lb8, int lane, float (&lf)[16], float (&kk)[16]) {
    float zv[16]; unpack16(za, zb, zv);
    const f32x4 l0 = *(const LAS f32x4*)lb8, l1 = *(const LAS f32x4*)(lb8 + 4); const float lb[8] = {l0[0], l0[1], l0[2], l0[3], l1[0], l1[1], l1[2], l1[3]};
#pragma unroll
    for (int e = 0; e < 16; ++e) { const float l = lb[e & 7]; const float f = l + (1.0f - l) * __builtin_amdgcn_rcpf(1.0f + __expf(-zv[e])); kk[e] = 1.0f - f; lf[e] = __logf(f); }
#pragma unroll
    for (int i = 0; i < 8; ++i) { lf[8 + i] += lf[i]; float t = lf[8 + i];
        float v = mk_bperm((lane - 16) & 63, t); t += (lane >= 16) ? v : 0.f; v = mk_bperm((lane - 32) & 63, t); t += (lane >= 32) ? v : 0.f;
        const float ex = t - lf[8 + i]; lf[i] += ex; lf[8 + i] = t; }
}
__device__ __forceinline__ void ph_hgrn_h1(unsigned char* ws, LAS unsigned char* lds, int L, int bid, int nb, int tid, int wave, int lane) {
    const bf16* z = (const bf16*)(ws + WS_Z); const float* lbp = (const float*)(ws + WS_LB) + L * 2 * W_;
    bf16* HST = (bf16*)(ws + WS_HST); float* HDEC = (float*)(ws + WS_HDEC);
    LAS float* WT = (LAS float*)lds; LAS bf16* KD = (LAS bf16*)(lds + 4096); LAS bf16* IS = (LAS bf16*)(lds + 21504); LAS float* LB = (LAS float*)(lds + 38912);
    const int jp = tid >> 4, ja = 2 * jp, k0 = (tid & 15) * 8, n = lane & 15, G = lane >> 4;
    if (bid >= 256 * NHEAD) return;
    const bool fixed_head = (nb & 7) == 0;
    if (fixed_head && tid < 256) LB[tid] = lbp[(tid >> 7) * W_ + (bid & 7) * HD + (tid & 127)];
    v4u pf[4];
#define H1_FETCH(item_, dir_) do { const int c_ = (item_) >> 3, h_ = (item_) & 7; const size_t oa_ = (size_t)(c_ * 64 + ((dir_) ? 63 - ja : ja)) * W_ + h_ * HD + k0, ob_ = (size_t)(c_ * 64 + ((dir_) ? 62 - ja : ja + 1)) * W_ + h_ * HD + k0; \
        pf[0] = *(const v4u*)(z + (size_t)(1 + (dir_)) * SEG + oa_); pf[1] = *(const v4u*)(z + (size_t)(1 + (dir_)) * SEG + ob_); pf[2] = *(const v4u*)(z + (size_t)3 * SEG + oa_); pf[3] = *(const v4u*)(z + (size_t)3 * SEG + ob_); } while (0)
    H1_FETCH(bid, 0);
    for (int item = bid; item < 256 * NHEAD; item += nb) { const int c = item >> 3, h = item & 7;
        if (!fixed_head) { __syncthreads(); if (tid < 256) LB[tid] = lbp[(tid >> 7) * W_ + h * HD + (tid & 127)]; __syncthreads(); }
#pragma unroll 1
        for (int dir = 0; dir < 2; ++dir) {
            const v4u f0 = pf[0], f1 = pf[1], i0 = pf[2], i1 = pf[3];
            if (dir == 0) H1_FETCH(item, 1); else if (item + nb < 256 * NHEAD) H1_FETCH(item + nb, 0);
            if (dir == 0 && item == bid) __syncthreads();
            float lf[16], kk[16]; hg_gate_scan(f0, f1, LB + dir * 128 + k0, lane, lf, kk);
            if (G == 3) { *(LAS f32x4*)(WT + wave * 128 + k0) = (f32x4){lf[8], lf[9], lf[10], lf[11]}; *(LAS f32x4*)(WT + wave * 128 + k0 + 4) = (f32x4){lf[12], lf[13], lf[14], lf[15]}; }
            __syncthreads();
            *(LAS v4u*)(IS + ja * 136 + k0) = i0; *(LAS v4u*)(IS + (ja + 1) * 136 + k0) = i1;
            { float pre[8], tot[8];
#pragma unroll
              for (int i = 0; i < 8; ++i) { pre[i] = 0.f; tot[i] = 0.f; }
#pragma unroll
              for (int w = 0; w < 8; ++w)
#pragma unroll
                  for (int q = 0; q < 2; ++q) { const f32x4 t4 = *(const LAS f32x4*)(WT + w * 128 + k0 + 4 * q);
#pragma unroll
                      for (int e = 0; e < 4; ++e) { tot[4 * q + e] += t4[e]; if (w < wave) pre[4 * q + e] += t4[e]; } }
              float kd[16];
#pragma unroll
              for (int e = 0; e < 16; ++e) kd[e] = kk[e] * __expf(tot[e & 7] - (lf[e] + pre[e & 7]));
              pack8_store(KD + ja * 136 + k0, kd); pack8_store(KD + (ja + 1) * 136 + k0, kd + 8);
              if (jp == 0) { float* hd = HDEC + (((size_t)dir * 256 + c) * 8 + h) * 128 + k0;
                  *(f32x4*)hd = (f32x4){__expf(tot[0]), __expf(tot[1]), __expf(tot[2]), __expf(tot[3])}; *(f32x4*)(hd + 4) = (f32x4){__expf(tot[4]), __expf(tot[5]), __expf(tot[6]), __expf(tot[7])}; } }
            __syncthreads();
            if (HG_EXP != 2) { const bf16x8 a0 = tr_frag(KD, 136, 0, 16 * wave, lane), a1 = tr_frag(KD, 136, 32, 16 * wave, lane);
              bf16* dst = HST + ((((size_t)dir * 256 + c) * 8 + h) * 128) * 128 + (wave >> 1) * 4096 + 16 * (wave & 1) + 4 * G;
#pragma unroll
              for (int vb = 0; vb < 8; ++vb) { const bf16x8 b0 = tr_frag(IS, 136, 0, 16 * vb, lane), b1 = tr_frag(IS, 136, 32, 16 * vb, lane);
                  f32x4 u = (f32x4){0.f, 0.f, 0.f, 0.f}; u = __builtin_amdgcn_mfma_f32_16x16x32_bf16(a0, b0, u, 0, 0, 0); u = __builtin_amdgcn_mfma_f32_16x16x32_bf16(a1, b1, u, 0, 0, 0);
                  v2u w; w.x = cvtpk(u[0], u[1]); w.y = cvtpk(u[2], u[3]); *(v2u*)(dst + (16 * vb + n) * 32) = w; } }
        }
    }
    __syncthreads();
#undef H1_FETCH
}
__device__ __forceinline__ void ph_hgrn_h2(unsigned char* ws, int bid, int nb, int tid) {
    unsigned* HST = (unsigned*)(ws + WS_HST); const float2* HDEC = (const float2*)(ws + WS_HDEC);
    for (int g = bid * NTHR + tid; g < 131072; g += nb * NTHR) { const int kp = g & 63, v = (g >> 6) & 127, h = (g >> 13) & 7, dir = g >> 16;
        const int kq = (((v >> 5) & 3) << 4) | (kp & 15);
        unsigned* base = HST + ((size_t)dir * 256 * 8 + h) * 8192 + v * 64 + kp; const float2* dec = HDEC + ((size_t)dir * 256 * 8 + h) * 64 + kq;
        float s0 = 0.f, s1 = 0.f;
        for (int cc = 0; cc < 256; cc += 8) { unsigned u[8]; float2 d[8];
#pragma unroll
            for (int j = 0; j < 8; ++j) { const int c = dir ? 255 - (cc + j) : cc + j; u[j] = base[(size_t)c * 65536]; d[j] = dec[(size_t)c * 512]; }
#pragma unroll
            for (int j = 0; j < 8; ++j) { const int c = dir ? 255 - (cc + j) : cc + j; s0 = d[j].x * s0 + bflo(u[j]); s1 = d[j].y * s1 + bfhi(u[j]); base[(size_t)c * 65536] = pk2(s0, s1); } }
    }
}
__device__ __forceinline__ void ph_hgrn_h3(unsigned char* ws, LAS unsigned char* lds, const float* onorm, int L, int bid, int nb, int tid, int wave, int lane) {
    const bf16* z = (const bf16*)(ws + WS_Z); const float* lbp = (const float*)(ws + WS_LB) + L * 2 * W_; const bf16* HST = (const bf16*)(ws + WS_HST); bf16* br = (bf16*)(ws + WS_BR);
    LAS float* WT = (LAS float*)lds; LAS bf16* QB = (LAS bf16*)(lds + 4096); LAS bf16* QT = (LAS bf16*)(lds + 21504); LAS bf16* KT = (LAS bf16*)(lds + 38912); LAS bf16* IS = (LAS bf16*)(lds + 82432);
    LAS float* RED = (LAS float*)(lds + 99840); LAS float* LB = (LAS float*)(lds + 101888);
    const int jp = tid >> 4, ja = 2 * jp, k0 = (tid & 15) * 8, n = lane & 15, G = lane >> 4, si = wave >> 1;
    if (bid >= 256 * NHEAD) return;
    const bool fixed_head = (nb & 7) == 0;
    if (fixed_head && tid < 256) LB[tid] = lbp[(tid >> 7) * W_ + (bid & 7) * HD + (tid & 127)];
    v4u pf[6];
#define H3_FETCH(item_, dir_) do { const int c_ = (item_) >> 3, h_ = (item_) & 7; const size_t oa_ = (size_t)(c_ * 64 + ((dir_) ? 63 - ja : ja)) * W_ + h_ * HD + k0, ob_ = (size_t)(c_ * 64 + ((dir_) ? 62 - ja : ja + 1)) * W_ + h_ * HD + k0; \
        pf[0] = *(const v4u*)(z + (size_t)(1 + (dir_)) * SEG + oa_); pf[1] = *(const v4u*)(z + (size_t)(1 + (dir_)) * SEG + ob_); pf[2] = *(const v4u*)(z + oa_); pf[3] = *(const v4u*)(z + ob_); \
        pf[4] = *(const v4u*)(z + (size_t)3 * SEG + oa_); pf[5] = *(const v4u*)(z + (size_t)3 * SEG + ob_); } while (0)
    H3_FETCH(bid, 0);
    for (int item = bid; item < 256 * NHEAD; item += nb) { const int c = item >> 3, h = item & 7, t0 = c * 64;
        if (!fixed_head) { __syncthreads(); if (tid < 256) LB[tid] = lbp[(tid >> 7) * W_ + h * HD + (tid & 127)]; __syncthreads(); }
        v2u gpre[4];
#pragma unroll
        for (int x = 0; x < 4; ++x) gpre[x] = *(const v2u*)(z + (size_t)4 * SEG + (size_t)(t0 + 16 * x + n) * W_ + h * HD + 16 * wave + 4 * G);
        f32x4 acc[4];
#pragma unroll
        for (int x = 0; x < 4; ++x) acc[x] = (f32x4){0.f, 0.f, 0.f, 0.f};
#pragma unroll 1
        for (int dir = 0; dir < 2; ++dir) {
            const v4u f0 = pf[0], f1 = pf[1], q0 = pf[2], q1 = pf[3], i0 = pf[4], i1 = pf[5];
            if (dir == 0) H3_FETCH(item, 1); else if (item + nb < 256 * NHEAD) H3_FETCH(item + nb, 0);
            const int cs = dir ? c + 1 : c - 1; const bool has_state = (cs >= 0 && cs < 256);
            bf16x8 as[4];
            if (has_state) { const bf16* sp = HST + (((size_t)dir * 256 + cs) * 8 + h) * 16384 + (16 * wave + n) * 32 + 8 * G;
#pragma unroll
                for (int ks = 0; ks < 4; ++ks) as[ks] = *(const bf16x8*)(sp + 4096 * ks); }
            if (dir == 0 && item == bid) __syncthreads();
            float lf[16], kk[16]; hg_gate_scan(f0, f1, LB + dir * 128 + k0, lane, lf, kk);
            if (G == 3) { *(LAS f32x4*)(WT + wave * 128 + k0) = (f32x4){lf[8], lf[9], lf[10], lf[11]}; *(LAS f32x4*)(WT + wave * 128 + k0 + 4) = (f32x4){lf[12], lf[13], lf[14], lf[15]}; }
            __syncthreads();
            *(LAS v4u*)(IS + ja * 136 + k0) = i0; *(LAS v4u*)(IS + (ja + 1) * 136 + k0) = i1;
            { float qs[16]; unpack16(q0, q1, qs);
#pragma unroll
              for (int e = 0; e < 16; ++e) qs[e] = qs[e] * __builtin_amdgcn_rcpf(1.0f + __expf(-qs[e]));
#pragma unroll
              for (int w = 0; w < 7; ++w) { if (w < wave) {
#pragma unroll
                  for (int q = 0; q < 2; ++q) { const f32x4 t4 = *(const LAS f32x4*)(WT + w * 128 + k0 + 4 * q);
#pragma unroll
                      for (int e = 0; e < 4; ++e) { lf[4 * q + e] += t4[e]; lf[8 + 4 * q + e] += t4[e]; } } } }
              float tmp[16];
#pragma unroll
              for (int e = 0; e < 16; ++e) tmp[e] = qs[e] * __expf(lf[e]);
              pack8_store(QB + ja * 136 + k0, tmp); pack8_store(QB + (ja + 1) * 136 + k0, tmp + 8);
              float ref[8];
#pragma unroll
              for (int i = 0; i < 8; ++i) ref[i] = 0.f;
#pragma unroll
              for (int it = 0; it < 4; ++it) {
                  if (it > 0) {
#pragma unroll
                      for (int w = 2 * it - 2; w < 2 * it; ++w)
#pragma unroll
                          for (int q = 0; q < 2; ++q) { const f32x4 t4 = *(const LAS f32x4*)(WT + w * 128 + k0 + 4 * q); ref[4 * q] += t4[0]; ref[4 * q + 1] += t4[1]; ref[4 * q + 2] += t4[2]; ref[4 * q + 3] += t4[3]; } }
                  if (si == it) {
#pragma unroll
                      for (int e = 0; e < 16; ++e) tmp[e] = qs[e] * __expf(lf[e] - ref[e & 7]);
                      pack8_store(QT + ja * 136 + k0, tmp); pack8_store(QT + (ja + 1) * 136 + k0, tmp + 8); }
                  if (si <= it) {
#pragma unroll
                      for (int e = 0; e < 16; ++e) tmp[e] = kk[e] * __expf(fminf(ref[e & 7] - lf[e], 80.f));
                      pack8_store(KT + (8 * it * (it + 1) + ja) * 136 + k0, tmp); pack8_store(KT + (8 * it * (it + 1) + ja + 1) * 136 + k0, tmp + 8); } } }
            __syncthreads();
            if (has_state) {
#pragma unroll
                for (int x = 0; x < 4; ++x) { const int jt = dir ? 63 - 16 * x - n : 16 * x + n;
#pragma unroll
                    for (int ks = 0; ks < 4; ++ks) { const bf16x8 b = *(const LAS bf16x8*)(QB + jt * 136 + 32 * ks + 8 * G); acc[x] = __builtin_amdgcn_mfma_f32_16x16x32_bf16(as[ks], b, acc[x], 0, 0, 0); } } }
#pragma unroll
            for (int x = 0; x < 4; ++x) { const int jt = dir ? 63 - 16 * x - n : 16 * x + n; const int it = dir ? 3 - x : x; const int kb = 8 * it * (it + 1);
                bf16x8 bqt[4];
#pragma unroll
                for (int ks = 0; ks < 4; ++ks) bqt[ks] = *(const LAS bf16x8*)(QT + jt * 136 + 32 * ks + 8 * G);
#pragma unroll
                for (int p = 0; p < 2; ++p) { if (p <= (it >> 1)) {
                    float pv[8];
#pragma unroll
                    for (int b = 0; b < 2; ++b) { const int js = 32 * p + 8 * (n >> 2) + 4 * b + (n & 3); f32x4 sc = (f32x4){0.f, 0.f, 0.f, 0.f};
#pragma unroll
                        for (int ks = 0; ks < 4; ++ks) { const bf16x8 ak = *(const LAS bf16x8*)(KT + (kb + js) * 136 + 32 * ks + 8 * G); sc = __builtin_amdgcn_mfma_f32_16x16x32_bf16(ak, bqt[ks], sc, 0, 0, 0); }
#pragma unroll
                        for (int r = 0; r < 4; ++r) { const int jsr = 32 * p + 8 * G + 4 * b + r; pv[4 * b + r] = (jsr <= jt) ? sc[r] : 0.f; } }
                    v4u pw; pw.x = cvtpk(pv[0], pv[1]); pw.y = cvtpk(pv[2], pv[3]); pw.z = cvtpk(pv[4], pv[5]); pw.w = cvtpk(pv[6], pv[7]);
                    const bf16x8 av = tr_frag(IS, 136, 32 * p, 16 * wave, lane);
                    acc[x] = __builtin_amdgcn_mfma_f32_16x16x32_bf16(av, __builtin_bit_cast(bf16x8, pw), acc[x], 0, 0, 0); } } }
        }
#pragma unroll
        for (int x = 0; x < 4; ++x) { float ss = acc[x][0] * acc[x][0] + acc[x][1] * acc[x][1] + acc[x][2] * acc[x][2] + acc[x][3] * acc[x][3]; ss += mk_bperm(lane ^ 16, ss); ss += mk_bperm(lane ^ 32, ss); if (G == 0) RED[wave * 64 + 16 * x + n] = ss; }
        __syncthreads();
        { const int ch = h * HD + 16 * wave + 4 * G; const f32x4 on = *(const f32x4*)(onorm + ch);
#pragma unroll
          for (int x = 0; x < 4; ++x) { const int tl = 16 * x + n; float tot = 0.f;
#pragma unroll
            for (int w = 0; w < 8; ++w) tot += RED[w * 64 + tl];
            const float rs = rsqrtf(tot * (1.0f / HD) + RMS_EPS); const size_t o = (size_t)(t0 + tl) * W_ + ch; const v2u gw = gpre[x];
            v2u w; w.x = cvtpk(acc[x][0] * rs * on[0] * siluf_(bflo(gw.x)), acc[x][1] * rs * on[1] * siluf_(bfhi(gw.x))); w.y = cvtpk(acc[x][2] * rs * on[2] * siluf_(bflo(gw.y)), acc[x][3] * rs * on[3] * siluf_(bfhi(gw.y)));
            *(v2u*)(br + o) = w; } }
    }
    __syncthreads();
#undef H3_FETCH
}
template <int D> __device__ __forceinline__ float dpp_shr(float v, float old) { return __builtin_bit_cast(float, __builtin_amdgcn_update_dpp(__builtin_bit_cast(int, old), __builtin_bit_cast(int, v), 0x110 | D, 0xf, 0xf, false)); }
template <int D> __device__ __forceinline__ float dpp_shl(float v, float old) { return __builtin_bit_cast(float, __builtin_amdgcn_update_dpp(__builtin_bit_cast(int, old), __builtin_bit_cast(int, v), 0x100 | D, 0xf, 0xf, false)); }
template <bool BWD, int D> __device__ __forceinline__ void scan_step(float& av, float& uv) { const float al = BWD ? dpp_shl<D>(av, 1.0f) : dpp_shr<D>(av, 1.0f), ul = BWD ? dpp_shl<D>(uv, 0.0f) : dpp_shr<D>(uv, 0.0f); uv = av * ul + uv; av = al * av; }
template <bool FINAL>
__device__ __forceinline__ void ph_lru(const Args& a, unsigned char* ws, LAS unsigned char* lds, int L, int bid, int nb, int tid, int wave, int lane) {
    const bf16* zx = (const bf16*)(ws + WS_Z) + 5 * SEG; const bf16* zg = (const bf16*)(ws + WS_Z) + 6 * SEG; bf16* br = (bf16*)(ws + WS_BR) + SEG;
    const bf16* LW = (const bf16*)(ws + WS_LRUW); float2* LSUM = (float2*)(ws + WS_LSUM); const float* LCIN = (const float*)(ws + WS_LCIN);
    LAS bf16* XT = (LAS bf16*)lds; LAS bf16* XCB = (LAS bf16*)(lds + 19040); LAS float* CW = (LAS float*)(lds + 36448);
    const int tr = tid >> 3, c0 = (tid & 7) * 16, n = lane & 15, G = lane >> 4;
    if (bid >= 256 * NHEAD) return;
    const bool fixed_head = (nb & 7) == 0;
#define LRU_LOAD_PARAMS(hh_) do { for (int q = tid; q < 2 * 8 * 128; q += NTHR) { const int dir_ = q >> 10, j_ = (q >> 7) & 7, c_ = q & 127, ch_ = (hh_) * HD + c_, pi_ = (L * 2 + dir_) * W_ + ch_; float v_; \
            if (j_ < 4) v_ = a.lru_conv_w[((size_t)(L * 2 + dir_) * 4 + j_) * W_ + ch_]; else if (j_ == 4) v_ = a.lru_conv_b[pi_]; else if (j_ == 5) v_ = a.lru_ba[pi_]; else if (j_ == 6) v_ = a.lru_bx[pi_]; else v_ = log1pf(__expf(-a.lru_lambda[pi_])); \
            CW[q] = v_; } } while (0)
    if (fixed_head) LRU_LOAD_PARAMS(bid & 7);
    v4u xpre[3];
#define LRU_FETCH_X(item_) do { const int tile_ = (item_) >> 3, hh_ = (item_) & 7, t0_ = tile_ * 64; \
        _Pragma("unroll") for (int p = 0; p < 3; ++p) { const int q = tid + p * NTHR, row = q >> 4, c = q & 15, t = t0_ - 3 + row; xpre[p] = (v4u){0u, 0u, 0u, 0u}; \
            if (q < 70 * 16 && t >= 0 && t < S_) xpre[p] = *(const v4u*)(zx + (size_t)t * W_ + hh_ * HD + 8 * c); } } while (0)
    LRU_FETCH_X(bid);
    for (int item = bid; item < 256 * NHEAD; item += nb) { const int tile = item >> 3, hh = item & 7, t0 = tile * 64;
        if (!fixed_head) { __syncthreads(); LRU_LOAD_PARAMS(hh); }
#pragma unroll
        for (int p = 0; p < 3; ++p) { const int q = tid + p * NTHR, row = q >> 4, c = q & 15; if (q < 70 * 16) *(LAS v4u*)(XT + row * 136 + 8 * c) = xpre[p]; }
        if (item + nb < 256 * NHEAD) LRU_FETCH_X(item + nb);
        const int chl = hh * HD + 16 * wave + 4 * G;
        v2u gpre[4]; f32x4 cin[2];
        if (FINAL) {
#pragma unroll
            for (int tb = 0; tb < 4; ++tb) gpre[tb] = *(const v2u*)(zg + (size_t)(t0 + 16 * tb + n) * W_ + chl);
            cin[0] = *(const f32x4*)(LCIN + (size_t)(tile * 2 + 0) * W_ + chl); cin[1] = *(const f32x4*)(LCIN + (size_t)(tile * 2 + 1) * W_ + chl); }
        __syncthreads();
        f32x4 yacc[4];
#pragma unroll
        for (int tb = 0; tb < 4; ++tb) yacc[tb] = (f32x4){0.f, 0.f, 0.f, 0.f};
#pragma unroll 1
        for (int dir = 0; dir < 2; ++dir) {
            const bf16* wap = LW + ((size_t)((L * 2 + dir) * 8 + hh)) * 16384 + (16 * wave + n) * 128 + 8 * G; const bf16* wxp = wap + (size_t)64 * 16384;
            bf16x8 wA[4], wX[4];
#pragma unroll
            for (int ks = 0; ks < 4; ++ks) { wA[ks] = *(const bf16x8*)(wap + 32 * ks); wX[ks] = *(const bf16x8*)(wxp + 32 * ks); }
            { float xc[16]; const LAS float* cwl = CW + dir * 1024 + c0;
#pragma unroll
              for (int q = 0; q < 4; ++q) { const f32x4 b4 = *(const LAS f32x4*)(cwl + 4 * 128 + 4 * q); xc[4 * q] = b4[0]; xc[4 * q + 1] = b4[1]; xc[4 * q + 2] = b4[2]; xc[4 * q + 3] = b4[3]; }
#pragma unroll
              for (int j = 0; j < 4; ++j) { const int row = dir ? tr + 6 - j : tr + j;
                  const v4u w0 = *(const LAS v4u*)(XT + row * 136 + c0), w1 = *(const LAS v4u*)(XT + row * 136 + c0 + 8); const unsigned ww[8] = {w0.x, w0.y, w0.z, w0.w, w1.x, w1.y, w1.z, w1.w};
#pragma unroll
                  for (int q = 0; q < 4; ++q) { const f32x4 w4 = *(const LAS f32x4*)(cwl + j * 128 + 4 * q);
#pragma unroll
                      for (int e = 0; e < 4; ++e) { const int i = 4 * q + e; xc[i] += w4[e] * ((i & 1) ? bfhi(ww[i >> 1]) : bflo(ww[i >> 1])); } } }
              v4u o0, o1; o0.x = cvtpk(xc[0], xc[1]); o0.y = cvtpk(xc[2], xc[3]); o0.z = cvtpk(xc[4], xc[5]); o0.w = cvtpk(xc[6], xc[7]); o1.x = cvtpk(xc[8], xc[9]); o1.y = cvtpk(xc[10], xc[11]); o1.z = cvtpk(xc[12], xc[13]); o1.w = cvtpk(xc[14], xc[15]);
              *(LAS v4u*)(XCB + tr * 136 + c0) = o0; *(LAS v4u*)(XCB + tr * 136 + c0 + 8) = o1; }
            __syncthreads();
            { f32x4 ar[4], ai[4];
#pragma unroll
              for (int tb = 0; tb < 4; ++tb) { ar[tb] = (f32x4){0.f, 0.f, 0.f, 0.f}; ai[tb] = (f32x4){0.f, 0.f, 0.f, 0.f}; }
#pragma unroll
              for (int ks = 0; ks < 4; ++ks)
#pragma unroll
                  for (int tb = 0; tb < 4; ++tb) { const bf16x8 xf = *(const LAS bf16x8*)(XCB + (16 * tb + n) * 136 + 32 * ks + 8 * G);
                      ar[tb] = __builtin_amdgcn_mfma_f32_16x16x32_bf16(wA[ks], xf, ar[tb], 0, 0, 0); ai[tb] = __builtin_amdgcn_mfma_f32_16x16x32_bf16(wX[ks], xf, ai[tb], 0, 0, 0); }
              const LAS float* pl = CW + dir * 1024 + 16 * wave + 4 * G; const f32x4 ba = *(const LAS f32x4*)(pl + 5 * 128), bx = *(const LAS f32x4*)(pl + 6 * 128), sp = *(const LAS f32x4*)(pl + 7 * 128);
#pragma unroll
              for (int tb = 0; tb < 4; ++tb) { const v2u xw = *(const LAS v2u*)(XCB + (16 * tb + n) * 136 + 16 * wave + 4 * G); const float xv[4] = {bflo(xw.x), bfhi(xw.x), bflo(xw.y), bfhi(xw.y)};
#pragma unroll
                  for (int r = 0; r < 4; ++r) { const float rg = __builtin_amdgcn_rcpf(1.0f + __expf(-(ar[tb][r] + ba[r]))), ig = __builtin_amdgcn_rcpf(1.0f + __expf(-(ai[tb][r] + bx[r]))); const float la = -8.0f * rg * sp[r];
                      const float av = __expf(la); ar[tb][r] = av; ai[tb][r] = sqrtf(fmaxf(1.0f - av * av, 0.0f)) * (ig * xv[r]); } }
#pragma unroll
              for (int tb = 0; tb < 4; ++tb)
#pragma unroll
                  for (int r = 0; r < 4; ++r) { float av = ar[tb][r], uv = ai[tb][r];
                      if (dir == 0) { scan_step<false, 1>(av, uv); scan_step<false, 2>(av, uv); scan_step<false, 4>(av, uv); scan_step<false, 8>(av, uv); }
                      else { scan_step<true, 1>(av, uv); scan_step<true, 2>(av, uv); scan_step<true, 4>(av, uv); scan_step<true, 8>(av, uv); }
                      ar[tb][r] = av; ai[tb][r] = uv; }
              const int lastlane = (lane & 48) | (dir ? 0 : 15);
              f32x4 hc, pc = (f32x4){1.f, 1.f, 1.f, 1.f};
              if (FINAL) hc = dir ? cin[1] : cin[0]; else hc = (f32x4){0.f, 0.f, 0.f, 0.f};
#pragma unroll
              for (int s = 0; s < 4; ++s) { const int tb = dir ? 3 - s : s;
                  { f32x4 at;
#pragma unroll
                  for (int r = 0; r < 4; ++r) { const float h = ar[tb][r] * hc[r] + ai[tb][r]; yacc[tb][r] += h; hc[r] = mk_bperm(lastlane, h);
                      if (!FINAL) { at[r] = ar[tb][r] * pc[r]; pc[r] = mk_bperm(lastlane, at[r]); } }
                  if (!FINAL) { v2u w; w.x = cvtpk(at[0], at[1]); w.y = cvtpk(at[2], at[3]); *(v2u*)((bf16*)(ws + (dir ? WS_LAB : WS_LAF)) + (size_t)(t0 + 16 * tb + n) * W_ + chl) = w; } } }
              if (!FINAL && n == 0) {
#pragma unroll
                  for (int r = 0; r < 4; ++r) LSUM[(size_t)(tile * 2 + dir) * W_ + chl + r] = make_float2(pc[r], hc[r]); } }
            __syncthreads();
        }
        if (!FINAL) {
#pragma unroll
            for (int tb = 0; tb < 4; ++tb) { v2u w; w.x = cvtpk(yacc[tb][0], yacc[tb][1]); w.y = cvtpk(yacc[tb][2], yacc[tb][3]); *(v2u*)((bf16*)(ws + WS_LSU) + (size_t)(t0 + 16 * tb + n) * W_ + chl) = w; } }
        if (FINAL) {
#pragma unroll
            for (int tb = 0; tb < 4; ++tb) { const size_t o = (size_t)(t0 + 16 * tb + n) * W_ + chl; const v2u gw = gpre[tb];
                v2u w; w.x = cvtpk(yacc[tb][0] * gelu_tanh(bflo(gw.x)), yacc[tb][1] * gelu_tanh(bfhi(gw.x))); w.y = cvtpk(yacc[tb][2] * gelu_tanh(bflo(gw.y)), yacc[tb][3] * gelu_tanh(bfhi(gw.y)));
                *(v2u*)(br + o) = w; } }
    }
    __syncthreads();
}

__device__ __forceinline__ void ph_lru_out(unsigned char* ws, int bid, int nb, int tid) {
    const bf16* SU = (const bf16*)(ws + WS_LSU); const bf16* AF = (const bf16*)(ws + WS_LAF); const bf16* AB = (const bf16*)(ws + WS_LAB); const float* LCIN = (const float*)(ws + WS_LCIN);
    const bf16* zg = (const bf16*)(ws + WS_Z) + 6 * SEG; bf16* br = (bf16*)(ws + WS_BR) + SEG;
#pragma unroll 8
    for (size_t i = (size_t)bid * NTHR + tid; i < SEG / 8; i += (size_t)nb * NTHR) { const size_t e = i * 8; const int t = (int)(e >> 10), ch = (int)(e & (W_ - 1)), tile = t >> 6;
        const v4u su = __builtin_nontemporal_load((const v4u*)(SU + e)), af = __builtin_nontemporal_load((const v4u*)(AF + e)), ab = __builtin_nontemporal_load((const v4u*)(AB + e)), gw = __builtin_nontemporal_load((const v4u*)(zg + e));
        const f32x4 hf0 = *(const f32x4*)(LCIN + (size_t)(tile * 2) * W_ + ch), hf1 = *(const f32x4*)(LCIN + (size_t)(tile * 2) * W_ + ch + 4), hb0 = *(const f32x4*)(LCIN + (size_t)(tile * 2 + 1) * W_ + ch), hb1 = *(const f32x4*)(LCIN + (size_t)(tile * 2 + 1) * W_ + ch + 4);
        float s[8], f[8], b[8], g[8]; unpack8(su, s); unpack8(af, f); unpack8(ab, b); unpack8(gw, g);
        const float hf[8] = {hf0[0], hf0[1], hf0[2], hf0[3], hf1[0], hf1[1], hf1[2], hf1[3]}, hb[8] = {hb0[0], hb0[1], hb0[2], hb0[3], hb1[0], hb1[1], hb1[2], hb1[3]};
        float y[8];
#pragma unroll
        for (int j = 0; j < 8; ++j) y[j] = (s[j] + f[j] * hf[j] + b[j] * hb[j]) * gelu_tanh(g[j]);
        v4u o; o.x = cvtpk(y[0], y[1]); o.y = cvtpk(y[2], y[3]); o.z = cvtpk(y[4], y[5]); o.w = cvtpk(y[6], y[7]);
        *(v4u*)(br + e) = o; }
}
__device__ __forceinline__ void ph_lru_carry(unsigned char* ws, LAS unsigned char* lds, int bid, int tid, int wave, int lane) {
    if (bid >= 32) return;
    const int chain = bid * 64 + lane, dir = chain >> 10, ch = chain & (W_ - 1), seg = wave; const float2* LSUM = (const float2*)(ws + WS_LSUM); float* LCIN = (float*)(ws + WS_LCIN);
    LAS f32x2_t* SEGS = (LAS f32x2_t*)lds;
    float2 sv[32];
#pragma unroll
    for (int i = 0; i < 32; ++i) { const int kp = 32 * seg + i, k = dir ? 255 - kp : kp; sv[i] = LSUM[(size_t)(k * 2 + dir) * W_ + ch]; }
    float p = 1.f, h = 0.f;
#pragma unroll
    for (int i = 0; i < 32; ++i) { h = sv[i].x * h + sv[i].y; p *= sv[i].x; }
    SEGS[seg * 64 + lane] = (f32x2_t){p, h};
    __syncthreads();
    float c = 0.f;
#pragma unroll
    for (int s = 0; s < 7; ++s) { if (s < seg) { const f32x2_t q = SEGS[s * 64 + lane]; c = q[0] * c + q[1]; } }
#pragma unroll
    for (int i = 0; i < 32; ++i) { const int kp = 32 * seg + i, k = dir ? 255 - kp : kp; LCIN[(size_t)(k * 2 + dir) * W_ + ch] = c; c = sv[i].x * c + sv[i].y; }
    __syncthreads();
}
__device__ __forceinline__ void ph_pool(const Args& a, unsigned char* ws, LAS unsigned char* lds, int L, int bid, int nb, int tid, int wave, int lane) {
    const bf16* zp = (const bf16*)(ws + WS_Z) + 7 * SEG; bf16* br = (bf16*)(ws + WS_BR) + 2 * SEG; const bf16* PW = (const bf16*)(ws + WS_POOLW);
    LAS bf16* XP = (LAS bf16*)lds; LAS bf16* DT = (LAS bf16*)(lds + 42240);
    const int tr = tid >> 3, c0 = (tid & 7) * 32, n = lane & 15, G = lane >> 4;
    for (int item = bid; item < 256 * 4; item += nb) { const int tile = item >> 2, gi = item & 3, t0 = tile * 64, w2 = 1 << gi;
        for (int q = tid; q < 80 * 32; q += NTHR) { const int row = q >> 5, c = q & 31, t = t0 - 8 + row; v4u v = (v4u){0u, 0u, 0u, 0u};
            if (t >= 0 && t < S_) v = *(const v4u*)(zp + (size_t)t * W_ + gi * 256 + 8 * c);
            *(LAS v4u*)(XP + row * 264 + 8 * c) = v; }
        __syncthreads();
        { const int t = t0 + tr, lo = max(t - w2, 0), hi = min(t + w2, S_); const float ic = 1.0f / (float)(hi - lo); float sm[32];
#pragma unroll
          for (int i = 0; i < 32; ++i) sm[i] = 0.f;
          for (int tt = lo; tt < hi; ++tt) { const LAS bf16* xr = XP + (tt - t0 + 8) * 264 + c0;
#pragma unroll
              for (int q = 0; q < 4; ++q) { const v4u w = *(const LAS v4u*)(xr + 8 * q);
                  sm[8 * q + 0] += bflo(w.x); sm[8 * q + 1] += bfhi(w.x); sm[8 * q + 2] += bflo(w.y); sm[8 * q + 3] += bfhi(w.y); sm[8 * q + 4] += bflo(w.z); sm[8 * q + 5] += bfhi(w.z); sm[8 * q + 6] += bflo(w.w); sm[8 * q + 7] += bfhi(w.w); } }
          const LAS bf16* xs = XP + (tr + 8) * 264 + c0;
#pragma unroll
          for (int q = 0; q < 4; ++q) { const v4u w = *(const LAS v4u*)(xs + 8 * q); v4u o;
              o.x = cvtpk(sm[8 * q + 0] * ic - bflo(w.x), sm[8 * q + 1] * ic - bfhi(w.x)); o.y = cvtpk(sm[8 * q + 2] * ic - bflo(w.y), sm[8 * q + 3] * ic - bfhi(w.y));
              o.z = cvtpk(sm[8 * q + 4] * ic - bflo(w.z), sm[8 * q + 5] * ic - bfhi(w.z)); o.w = cvtpk(sm[8 * q + 6] * ic - bflo(w.w), sm[8 * q + 7] * ic - bfhi(w.w));
              *(LAS v4u*)(DT + tr * 264 + c0 + 8 * q) = o; } }
        __syncthreads();
        { f32x4 acc[2][4];
#pragma unroll
          for (int x = 0; x < 2; ++x)
#pragma unroll
              for (int y = 0; y < 4; ++y) acc[x][y] = (f32x4){0.f, 0.f, 0.f, 0.f};
          const bf16* wp = PW + ((size_t)(L * 4 + gi) * 256 + 32 * wave + n) * 256 + 8 * G;
#pragma unroll
          for (int ks = 0; ks < 8; ++ks) { const bf16x8 a0 = *(const bf16x8*)(wp + 32 * ks), a1 = *(const bf16x8*)(wp + 16 * 256 + 32 * ks);
#pragma unroll
              for (int y = 0; y < 4; ++y) { const bf16x8 bf = *(const LAS bf16x8*)(DT + (16 * y + n) * 264 + 32 * ks + 8 * G);
                  acc[0][y] = __builtin_amdgcn_mfma_f32_16x16x32_bf16(a0, bf, acc[0][y], 0, 0, 0); acc[1][y] = __builtin_amdgcn_mfma_f32_16x16x32_bf16(a1, bf, acc[1][y], 0, 0, 0); } }
#pragma unroll
          for (int x = 0; x < 2; ++x) { const int ch = gi * 256 + 32 * wave + 16 * x + 4 * G; const f32x4 sc = *(const f32x4*)(a.pool_scale + L * W_ + ch);
#pragma unroll
              for (int y = 0; y < 4; ++y) { const f32x4 o = acc[x][y] * sc; v2u w; w.x = cvtpk(o[0], o[1]); w.y = cvtpk(o[2], o[3]); *(v2u*)(br + (size_t)(t0 + 16 * y + n) * W_ + ch) = w; } } }
        __syncthreads();
    }
}
__device__ __forceinline__ void ph_merge(const Args& a, int bid, int nb, int tid) {
    const bf16* zg = (const bf16*)(a.ws + WS_ZG); const bf16* P = (const bf16*)(a.ws + WS_P); bf16* mg = (bf16*)(a.ws + WS_MERGED);
    for (size_t i = (size_t)bid * NTHR + tid; i < (size_t)S_ * (D_ / 8); i += (size_t)nb * NTHR) { const int t = (int)(i >> 8), c8 = (int)(i & 255) * 8; float acc[8];
#pragma unroll
        for (int j = 0; j < 8; ++j) acc[j] = 0.f;
#pragma unroll
        for (int g = 0; g < 4; ++g) { const v4u gw = *(const v4u*)(zg + (size_t)t * 4 * D_ + g * D_ + c8), pw = *(const v4u*)(P + (size_t)g * S_ * D_ + (size_t)t * D_ + c8);
            acc[0] += sigmoidf_(bflo(gw.x)) * bflo(pw.x); acc[1] += sigmoidf_(bfhi(gw.x)) * bfhi(pw.x); acc[2] += sigmoidf_(bflo(gw.y)) * bflo(pw.y); acc[3] += sigmoidf_(bfhi(gw.y)) * bfhi(pw.y);
            acc[4] += sigmoidf_(bflo(gw.z)) * bflo(pw.z); acc[5] += sigmoidf_(bfhi(gw.z)) * bfhi(pw.z); acc[6] += sigmoidf_(bflo(gw.w)) * bflo(pw.w); acc[7] += sigmoidf_(bfhi(gw.w)) * bfhi(pw.w); }
        v4u o; o.x = pk2(acc[0], acc[1]); o.y = pk2(acc[2], acc[3]); o.z = pk2(acc[4], acc[5]); o.w = pk2(acc[6], acc[7]);
        *(v4u*)(mg + (size_t)t * D_ + c8) = o; }
}
__device__ __forceinline__ void ph_convact(const Args& a, unsigned char* ws, int L, int bid, int nb, int tid) {
    const bf16* u = (const bf16*)(ws + WS_Z); bf16* act = (bf16*)(ws + WS_P);
    const float* cw = a.ffn_conv_w + (size_t)L * 3 * FF2; const float* cbp = a.ffn_conv_b + (size_t)L * FF2;
    constexpr int G8 = FF / 8, ROWS = 87;
    for (int g = bid * NTHR + tid; g < G8 * 190; g += nb * NTHR) { const int cg = g % G8, strip = g / G8, c8 = cg * 8, r0 = strip * ROWS, r1 = min(r0 + ROWS, S_);
        float wg[3][8], wv[3][8], bg[8], bv[8];
#pragma unroll
        for (int k = 0; k < 3; ++k) { const f32x4 x0 = *(const f32x4*)(cw + k * FF2 + c8), x1 = *(const f32x4*)(cw + k * FF2 + c8 + 4), y0 = *(const f32x4*)(cw + k * FF2 + FF + c8), y1 = *(const f32x4*)(cw + k * FF2 + FF + c8 + 4);
#pragma unroll
            for (int j = 0; j < 4; ++j) { wg[k][j] = x0[j]; wg[k][4 + j] = x1[j]; wv[k][j] = y0[j]; wv[k][4 + j] = y1[j]; } }
        { const f32x4 x0 = *(const f32x4*)(cbp + c8), x1 = *(const f32x4*)(cbp + c8 + 4), y0 = *(const f32x4*)(cbp + FF + c8), y1 = *(const f32x4*)(cbp + FF + c8 + 4);
#pragma unroll
          for (int j = 0; j < 4; ++j) { bg[j] = x0[j]; bg[4 + j] = x1[j]; bv[j] = y0[j]; bv[4 + j] = y1[j]; } }
        const v4u zero = (v4u){0u, 0u, 0u, 0u};
        const bf16* up = u + c8;
#define LDROW(t, G, V) do { if ((t) >= 0 && (t) < S_) { G = *(const v4u*)(up + (size_t)(t) * FF2); V = *(const v4u*)(up + (size_t)(t) * FF2 + FF); } else { G = zero; V = zero; } } while (0)
        v4u gp, vp, gc, vc, gn, vn, g2, v2, g3, v3;
        LDROW(r0 - 1, gp, vp); LDROW(r0, gc, vc); LDROW(r0 + 1, gn, vn); LDROW(r0 + 2, g2, v2); LDROW(r0 + 3, g3, v3);
        for (int t = r0; t < r1; ++t) {
            v4u g4, v4; LDROW(t + 4, g4, v4);
            float gpf[8], gcf[8], gnf[8], vpf[8], vcf[8], vnf[8]; unpack8(gp, gpf); unpack8(gc, gcf); unpack8(gn, gnf); unpack8(vp, vpf); unpack8(vc, vcf); unpack8(vn, vnf);
            float o[8];
#pragma unroll
            for (int j = 0; j < 8; ++j) { const float gt = bg[j] + wg[0][j] * gpf[j] + wg[1][j] * gcf[j] + wg[2][j] * gnf[j], vl = bv[j] + wv[0][j] * vpf[j] + wv[1][j] * vcf[j] + wv[2][j] * vnf[j];
                o[j] = gt * __builtin_amdgcn_rcpf(1.0f + __expf(-gt)) * vl; }
            v4u ow; ow.x = cvtpk(o[0], o[1]); ow.y = cvtpk(o[2], o[3]); ow.z = cvtpk(o[4], o[5]); ow.w = cvtpk(o[6], o[7]);
            *(v4u*)(act + (size_t)t * FF + c8) = ow;
            gp = gc; vp = vc; gc = gn; vc = vn; gn = g2; vn = v2; g2 = g3; v2 = v3; g3 = g4; v3 = v4; }
#undef LDROW
    }
}


__device__ __forceinline__ void ph_convfix(const Args& a, unsigned char* ws, int L, int bid, int nb, int tid) {
    const bf16* RAW = (const bf16*)(ws + WS_RAW); bf16* act = (bf16*)(ws + WS_P);
    const float* cw = a.ffn_conv_w + (size_t)L * 3 * FF2; const float* cbp = a.ffn_conv_b + (size_t)L * FF2;
    for (int i = bid * NTHR + tid; i < 65 * 2 * FF; i += nb * NTHR) { const int c = i % FF, rb = i / FF, b = rb >> 1, r = 256 * b - 1 + (rb & 1);
        if (r < 0 || r >= S_) continue;
        const int pn = c >> 7, cc = c & 127; float ug = cbp[c], uv = cbp[FF + c];
#pragma unroll
        for (int k = 0; k < 3; ++k) { const int t = r + k - 1; if (t < 0 || t >= S_) continue; const int tl = t & 255, ri = tl < 2 ? tl : tl - 252;
            const bf16* rp = RAW + (((size_t)(t >> 8) * 4 + ri) * 43 + pn) * 256 + cc; ug += cw[k * FF2 + c] * bf2f(rp[0]); uv += cw[k * FF2 + FF + c] * bf2f(rp[128]); }
        act[(size_t)r * FF + c] = (bf16)f2bf(siluf_(ug) * uv); }
}
constexpr int NPH = 11;
constexpr int NPHASES = 2 + DEPTH * NPH;
__global__ void __launch_bounds__(NTHR, 2) mk_fwd(Args a) {
    extern __shared__ __attribute__((aligned(16))) unsigned char lds_raw[];
    LAS unsigned char* lds = (LAS unsigned char*)lds_raw;
    const int wave_s = __builtin_amdgcn_readfirstlane((int)threadIdx.x >> 6);
    const int lane = mk_lane_id(), wave = wave_s, tid = wave_s * 64 + lane;
    const int bid = blockIdx.x, nb = gridDim.x;
    unsigned char* ws = a.ws;
    volatile LAS unsigned* MISC = (volatile LAS unsigned*)(lds + MISC_OFF);
    for (int u = tid; u < (LDS_BYTES - MISC_OFF) / 4; u += NTHR) ((LAS unsigned*)(lds + MISC_OFF))[u] = 0u;
    __syncthreads();
    XcdBarrier bar; bar.w0 = 0u; bar.bar = (unsigned*)(ws + WS_CTL) + CW_BAR; bar.x = 0; bar.st = nullptr;
    if (!MK_MULTI_LAUNCH) bar = xcd_barrier_post((unsigned*)(ws + WS_CTL) + CW_BAR, MISC + 8);
    bar.w0 = (wave_s == 0) ? 1u : 0u;
    const int lo = a.ph_lo, hi = a.ph_hi;
#define PH_LOCALS() size_t wsoff_ = 0; asm volatile("" : "+s"(wsoff_)); unsigned char* ws = a.ws + wsoff_;     \
    int tid = wave_s * 64 + mk_lane_id(); asm volatile("" : "+v"(tid)); const int lane = tid & 63, wave = __builtin_amdgcn_readfirstlane(tid >> 6); int bid = blockIdx.x, nb = gridDim.x; asm volatile("" : "+s"(bid), "+s"(nb)); (void)ws; (void)lane; (void)wave; (void)tid
#define IN(k) (lo <= (k) && (k) < hi)
#define SEAM(k) do { if (IN((k) + 1)) xcd_barrier(bar); } while (0)

    if (IN(0)) { PH_LOCALS(); ph_prologue(a, lds, bid, nb, tid, wave, lane); SEAM(0); }
    if (IN(1)) { PH_LOCALS(); ph_resnorm<false>(a, lds, bid, nb, tid, wave, lane, a.x, nullptr, nullptr, (bf16*)(ws + WS_H), 0, 0, 0, 0, 0, 1, 0); SEAM(1); }

    for (int L = 0; L < DEPTH; ++L) {
        const int pb = 2 + L * NPH;
        if (IN(pb + 0)) { PH_LOCALS();
            pg8::Gemm g{(const bf16*)(ws + WS_H), (const bf16*)(ws + WS_WIN) + (size_t)L * NIN * D_, S_, NIN, D_}; pg8::StaticOrder so; so.init(S_, NIN, nb, bid);
            pg8::EpiZ8 E{(bf16*)(ws + WS_Z), W_, 4, 44, SEG, (bf16*)(ws + WS_ZG), 4 * D_};
            pg8::gemm_phase<pg8::EpiZ8, pg8::StaticOrder, true, true>(lds, g, so, E, wave);
            SEAM(pb + 0);
        }
        if (IN(pb + 1)) { PH_LOCALS(); ph_pool(a, ws, lds, L, bid, nb, tid, wave, lane); ph_lru<false>(a, ws, lds, L, bid, nb, tid, wave, lane); ph_hgrn_h1(ws, lds, L, bid, nb, tid, wave, lane);
            ph_attn_prep(ws, bid, nb, tid); ph_attn_vt(ws, lds, bid, nb, tid, wave, lane); SEAM(pb + 1); }
        if (IN(pb + 2)) { PH_LOCALS(); ph_attn_main(ws, bid, nb, wave, lane); ph_lru_carry(ws, lds, bid, tid, wave, lane); ph_hgrn_h2(ws, bid, nb, tid); SEAM(pb + 2); }
        if (IN(pb + 3)) { PH_LOCALS(); ph_hgrn_h3(ws, lds, a.hgrn_onorm + L * W_, L, bid, nb, tid, wave, lane); ph_lru_out(ws, bid, nb, tid); ph_attn_comb(ws, bid, nb, tid); SEAM(pb + 3); }
        if (IN(pb + 4)) { PH_LOCALS();
            pg8::Gemm g{(const bf16*)(ws + WS_BR), (const bf16*)(ws + WS_WBR) + (size_t)L * 4 * D_ * W_, 4 * S_, 4 * D_, W_}; pg8::GateOrder so; so.so.init(S_, D_, nb, bid);
            pg8::EpiGate E{(const unsigned char*)(ws + WS_ZG), (bf16*)(ws + WS_MERGED)};
            pg8::gemm_phase<pg8::EpiGate, pg8::GateOrder, true, true>(lds, g, so, E, wave);
            SEAM(pb + 4);
        }
        if (IN(pb + 5)) { PH_LOCALS();
            pg8::Gemm g{(const bf16*)(ws + WS_MERGED), (const bf16*)(ws + WS_WOUT) + (size_t)L * D_ * D_, S_, D_, D_}; pg8::StaticOrder so; so.init(S_, D_, nb, bid);
            pg8::EpiBf16R E{(bf16*)(ws + WS_Y), D_, 8, 8, 0, nullptr, 0};
            pg8::gemm_phase<pg8::EpiBf16R, pg8::StaticOrder, true, true>(lds, g, so, E, wave);
            SEAM(pb + 5);
        }
        if (IN(pb + 6)) { PH_LOCALS(); ph_resnorm<true>(a, lds, bid, nb, tid, wave, lane, a.x, a.out, (const bf16*)(ws + WS_Y), (bf16*)(ws + WS_H), L, 2, 1, L, 2, 4, 3, L == 0 ? nullptr : (const bf16*)(ws + WS_XR), (bf16*)(ws + WS_XR)); SEAM(pb + 6); }
        if (IN(pb + 7)) { PH_LOCALS();
            pg8::Gemm g{(const bf16*)(ws + WS_H), (const bf16*)(ws + WS_WUP) + (size_t)L * FF2 * D_, S_, FF2, D_}; pg8::StaticOrder so; so.init(S_, FF2, nb, bid);
            pg8::EpiConvAct E{(bf16*)(ws + WS_P), (bf16*)(ws + WS_RAW), (const float*)(ws + WS_CWT) + (size_t)L * 43 * 8 * 128, (LAS float*)(lds + RING_BYTES)};
            pg8::gemm_phase<pg8::EpiConvAct, pg8::StaticOrder, true, true>(lds, g, so, E, wave);
            SEAM(pb + 7);
        }
        if (IN(pb + 8)) { PH_LOCALS(); ph_convfix(a, ws, L, bid, nb, tid); SEAM(pb + 8); }
        if (IN(pb + 9)) { PH_LOCALS();
            pg8::Gemm g{(const bf16*)(ws + WS_P), (const bf16*)(ws + WS_WDN) + (size_t)L * D_ * FF, S_, D_, FF}; pg8::StaticOrder so; so.init(S_, D_, nb, bid);
            pg8::EpiBf16R E{(bf16*)(ws + WS_Y), D_, 8, 8, 0, nullptr, 0};
            pg8::gemm_phase<pg8::EpiBf16R, pg8::StaticOrder, true, true>(lds, g, so, E, wave);
            SEAM(pb + 9);
        }
        if (IN(pb + 10)) { PH_LOCALS(); ph_resnorm<true>(a, lds, bid, nb, tid, wave, lane, a.x, a.out, (const bf16*)(ws + WS_Y), L + 1 < DEPTH ? (bf16*)(ws + WS_H) : nullptr, L, 5, 3, L + 1 < DEPTH ? L + 1 : L, 0, 1, 0, (const bf16*)(ws + WS_XR), L + 1 < DEPTH ? (bf16*)(ws + WS_XR) : nullptr); SEAM(pb + 10); }
    }
#undef IN
#undef SEAM
}

extern "C" void kernel_launch(void* const* d_in, const int* in_sizes, int n_in, void* d_out, int out_size, void* d_ws, size_t ws_size, hipStream_t stream) {
    static int grid = 0;
    if (grid == 0) {
        if (n_in != 24 || in_sizes[0] != S_ * D_ || out_size != S_ * D_ || ws_size < WS_END) { fprintf(stderr, "kernel_launch: unexpected shapes (n_in %d, in0 %d, out %d, ws %zu < %zu); nothing launched\n", n_in, n_in > 0 ? in_sizes[0] : -1, out_size, ws_size, (size_t)WS_END); grid = -1; return; }
        int dev = 0, cus = 0, per_cu = 0;
        if (hipGetDevice(&dev) != hipSuccess || hipDeviceGetAttribute(&cus, hipDeviceAttributeMultiprocessorCount, dev) != hipSuccess) { grid = -1; return; }
        if (hipFuncSetAttribute((const void*)mk_fwd, hipFuncAttributeMaxDynamicSharedMemorySize, LDS_BYTES) != hipSuccess) { fprintf(stderr, "kernel_launch: hipFuncSetAttribute failed\n"); grid = -1; return; }
        if (hipOccupancyMaxActiveBlocksPerMultiprocessor(&per_cu, (const void*)mk_fwd, NTHR, LDS_BYTES) != hipSuccess || per_cu < 1) fprintf(stderr, "kernel_launch: occupancy query reports %d\n", per_cu);
        (void)hipGetLastError();
        grid = cus;
    }
    if (grid < 0) return;
    if (hipMemsetAsync((char*)d_ws + WS_CTL, 0, CTL_ZERO_BYTES, stream) != hipSuccess) return;
    Args a{};
    a.x = (const float*)d_in[0]; a.c = (const float*)d_in[1]; a.pos = (const int*)d_in[2]; a.ada_w = (const float*)d_in[3]; a.ada_b = (const float*)d_in[4]; a.norm_g = (const float*)d_in[5];
    a.w_in = (const float*)d_in[6]; a.hgrn_lb = (const float*)d_in[7]; a.hgrn_onorm = (const float*)d_in[8]; a.lru_conv_w = (const float*)d_in[9]; a.lru_conv_b = (const float*)d_in[10];
    a.lru_wa = (const float*)d_in[11]; a.lru_ba = (const float*)d_in[12]; a.lru_wx = (const float*)d_in[13]; a.lru_bx = (const float*)d_in[14]; a.lru_lambda = (const float*)d_in[15];
    a.pool_w = (const float*)d_in[16]; a.pool_scale = (const float*)d_in[17]; a.w_branch = (const float*)d_in[18]; a.w_out = (const float*)d_in[19]; a.ffn_up = (const float*)d_in[20];
    a.ffn_conv_w = (const float*)d_in[21]; a.ffn_conv_b = (const float*)d_in[22]; a.ffn_down = (const float*)d_in[23];
    a.out = (float*)d_out; a.ws = (unsigned char*)d_ws;
#if MK_MULTI_LAUNCH
    for (int p = 0; p < NPHASES; ++p) { a.ph_lo = p; a.ph_hi = p + 1; hipLaunchKernelGGL(mk_fwd, dim3(grid), dim3(NTHR), LDS_BYTES, stream, a); }
#else
    a.ph_lo = 0; a.ph_hi = NPHASES; hipLaunchKernelGGL(mk_fwd, dim3(grid), dim3(NTHR), LDS_BYTES, stream, a);
#endif
}
```

```cpp
#include <hip/hip_runtime.h>
#include <cstdio>
#include <cstdint>
#ifndef MK_MULTI_LAUNCH
#define MK_MULTI_LAUNCH 0
#endif
#ifndef GATE_EXP
#define GATE_EXP 0
#endif
__device__ __forceinline__ int mk_lane_id() { int l; asm volatile("v_mbcnt_lo_u32_b32 %0, -1, 0\n\tv_mbcnt_hi_u32_b32 %0, -1, %0" : "=v"(l)); return l; }
#define GAS __attribute__((address_space(1)))
#define LAS __attribute__((address_space(3)))
namespace pg8 {
#define PG8_LAS __attribute__((address_space(3)))
typedef unsigned short bf16_t;
typedef short bf16x8 __attribute__((ext_vector_type(8)));
typedef float f32x4 __attribute__((ext_vector_type(4)));
typedef unsigned u32x4 __attribute__((ext_vector_type(4)));
constexpr int BM = 256, BK = 64, HALF = 128, HTB = HALF * BK * 2  , STAGE_BYTES = 8 * HTB, NXCD = 8, WGM = 8;

__host__ __device__ __forceinline__ int lds_byte(int r, int c) { const int st = (r >> 4) * 2 + (c >> 5), rr = r & 15, cc = c & 31, ob = rr * 64 + cc * 2; return st * 1024 + (ob ^ (((ob >> 9) & 1) << 5)); }
__host__ __device__ __forceinline__ void stage_rc(int b, int& R, int& C) { const int st = b / 1024, sb = b % 1024, swz = sb ^ (((sb >> 9) & 1) << 5); R = (st >> 1) * 16 + swz / 64; C = (st & 1) * 32 + (swz % 64) / 2; }
__host__ __device__ __forceinline__ int perm32(int rho) { const int n = rho >> 4, i = rho & 15; return 8 * (i >> 2) + 4 * n + (i & 3); }

struct Unit { int pm, pn; };
struct Gemm { const bf16_t* A; const bf16_t* Bt; int M, N, K; };

struct StaticOrder {
    int nM, nN, nwg, G, c;
    __host__ __device__ void init(int M, int N, int G_, int c_) { nM = M / BM; nN = N / BM; nwg = nM * nN; G = G_; c = c_; }
    __host__ __device__ bool next(int i, Unit& u) const {
        const long L = (long)i * G + c; if (L >= nwg) return false;
        int wgid = (int)L; { const int q = nwg / NXCD, r = nwg % NXCD, xcd = wgid % NXCD, off = wgid / NXCD; wgid = (xcd < r ? xcd * (q + 1) : r * (q + 1) + (xcd - r) * q) + off; }
        const int nig = WGM * nN, gid = wgid / nig, fm = gid * WGM, gsz = (nM - fm) < WGM ? (nM - fm) : WGM;
        u.pm = fm + ((wgid % nig) % gsz); u.pn = (wgid % nig) / gsz; return true;
    }
    __device__ __forceinline__ void a_ready(const Unit&) const {}
    __device__ __forceinline__ void done(const Unit&) const {}
};

typedef __bf16 bf16x2_t __attribute__((ext_vector_type(2)));
typedef float f32x2_t __attribute__((ext_vector_type(2)));
__device__ __forceinline__ unsigned cvt_pk_bf16(float lo, float hi) { const f32x2_t v = {lo, hi}; return __builtin_bit_cast(unsigned, __builtin_convertvector(v, bf16x2_t)); }

struct EpiBf16R {
    static constexpr bool PERM = true, AFTER_DRAIN = false, INPLACE = false;
    bf16_t* O; int ldc_seg; int tiles_per_seg; int nseg_tiles; size_t seg_stride; bf16_t* O2; int ldc2;
    __device__ __forceinline__ void operator()(const f32x4 (&acc)[2][2][4][2], const Unit& u, int wr, int wc, int fr, int fq) const {
        const int row0 = u.pm * BM + wr * 64 + fr; bf16_t* base; int ldc, colt;
        if (u.pn < nseg_tiles) { const int sg = u.pn / tiles_per_seg; base = O + (size_t)sg * seg_stride; ldc = ldc_seg; colt = (u.pn - sg * tiles_per_seg) * BM; }
        else { base = O2; ldc = ldc2; colt = (u.pn - nseg_tiles) * BM; }
        const int col0 = colt + wc * 32 + 8 * fq;
#pragma unroll
        for (int ai = 0; ai < 2; ++ai)
#pragma unroll
            for (int m = 0; m < 4; ++m) { bf16_t* rowp = base + (size_t)(row0 + ai * HALF + m * 16) * ldc + col0;
#pragma unroll
                for (int bj = 0; bj < 2; ++bj) { const f32x4 v0 = acc[ai][bj][m][0], v1 = acc[ai][bj][m][1];
                    u32x4 w; w.x = cvt_pk_bf16(v0[0], v0[1]); w.y = cvt_pk_bf16(v0[2], v0[3]); w.z = cvt_pk_bf16(v1[0], v1[1]); w.w = cvt_pk_bf16(v1[2], v1[3]);
                    *(u32x4*)(rowp + bj * HALF) = w; } }
    }
};
struct EpiZ8 {
    static constexpr bool PERM = true, AFTER_DRAIN = false, INPLACE = false;
    bf16_t* O; int ldc_seg; int tiles_per_seg; int nseg_tiles; size_t seg_stride; bf16_t* O2; int ldc2;
    __device__ __forceinline__ void operator()(const f32x4 (&acc)[2][2][4][2], const Unit& u, int wr, int wc, int fr, int fq) const {
        const int row0 = u.pm * BM + wr * 64 + fr; bf16_t* base; int ldc, colt;
        if (u.pn < nseg_tiles) { const int sg = u.pn / tiles_per_seg; base = O + (size_t)sg * seg_stride; ldc = ldc_seg; colt = (u.pn - sg * tiles_per_seg) * BM; }
        else { base = O2; ldc = ldc2; colt = (u.pn - nseg_tiles) * BM; }
        const int col0 = colt + wc * 32 + 8 * fq;
        if (u.pn >= nseg_tiles) {
            unsigned char* gb = (unsigned char*)O2;
#pragma unroll
            for (int ai = 0; ai < 2; ++ai)
#pragma unroll
                for (int m = 0; m < 4; ++m) { unsigned char* rowp = gb + (size_t)(u.pm * 32 + (u.pn - nseg_tiles)) * 65536 + (unsigned)(((wr * 4 + wc) * 64 + fq * 16 + fr) * 8);
#pragma unroll
                    for (int bj = 0; bj < 2; ++bj) { unsigned w2[2];
#pragma unroll
                        for (int hh = 0; hh < 2; ++hh) { const f32x4 v = acc[ai][bj][m][hh]; unsigned q = 0;
#pragma unroll
                            for (int j = 0; j < 4; ++j) q |= (unsigned)max((int)(255.0f * __builtin_amdgcn_rcpf(1.0f + __expf(-v[j])) + 0.5f), 1) << (8 * j);
                            w2[hh] = q; }
                        typedef unsigned u32x2 __attribute__((ext_vector_type(2))); u32x2 w; w.x = w2[0]; w.y = w2[1];
                        *(u32x2*)(rowp + ((ai * 4 + m) * 2 + bj) * 4096) = w; } }
            return; }
#pragma unroll
        for (int ai = 0; ai < 2; ++ai)
#pragma unroll
            for (int m = 0; m < 4; ++m) { bf16_t* rowp = base + (size_t)(row0 + ai * HALF + m * 16) * ldc + col0;
#pragma unroll
                for (int bj = 0; bj < 2; ++bj) { const f32x4 v0 = acc[ai][bj][m][0], v1 = acc[ai][bj][m][1];
                    u32x4 w; w.x = cvt_pk_bf16(v0[0], v0[1]); w.y = cvt_pk_bf16(v0[2], v0[3]); w.z = cvt_pk_bf16(v1[0], v1[1]); w.w = cvt_pk_bf16(v1[2], v1[3]);
                    *(u32x4*)(rowp + bj * HALF) = w; } }
    }
};

struct RotOrder { StaticOrder so;
    __device__ __forceinline__ bool next(int i, Unit& u) const { if (!so.next(i, u)) return false; u.pn = (u.pn < 32) ? u.pn + 44 : u.pn - 32; return true; }
    __device__ __forceinline__ void a_ready(const Unit&) const {}
    __device__ __forceinline__ void done(const Unit&) const {}
};
struct GateOrder { StaticOrder so;
    __device__ __forceinline__ bool next(int i, Unit& u) const { Unit t; if (!so.next(i >> 2, t)) return false; const int g = i & 3; u.pm = g * 64 + t.pm; u.pn = g * 8 + t.pn; return true; }
    __device__ __forceinline__ void a_ready(const Unit&) const {}
    __device__ __forceinline__ void done(const Unit&) const {}
};
struct EpiGate {
    static constexpr bool PERM = true, AFTER_DRAIN = false, INPLACE = true;
    const unsigned char* ZG; bf16_t* MG;
    static __device__ __forceinline__ bool keep(const Unit& u) { return (u.pn >> 3) < 3; }
    __device__ __forceinline__ void operator()(f32x4 (&acc)[2][2][4][2], const Unit& u, int wr, int wc, int fr, int fq) const {
        typedef unsigned u32x2 __attribute__((ext_vector_type(2)));
        const int g = u.pn >> 3, pn0 = u.pn & 7, pm0 = u.pm - g * 64;
        const unsigned tix = (unsigned)((wr * 4 + wc) * 64 + fq * 16 + fr);
        const unsigned char* gtile = ZG + (size_t)(pm0 * 32 + g * 8 + pn0) * 65536 + tix * 8;
        if (g < 3) {
#pragma unroll
            for (int ai = 0; ai < 2; ++ai) { u32x2 gw[4][2], gn[4][2];
#pragma unroll
                for (int m = 0; m < 4; ++m)
#pragma unroll
                    for (int bj = 0; bj < 2; ++bj) { gw[m][bj] = *(const u32x2*)(gtile + ((ai * 4 + m) * 2 + bj) * 4096); gn[m][bj] = *(const u32x2*)(gtile + 8 * 65536 + ((ai * 4 + m) * 2 + bj) * 4096); }
#pragma unroll
                for (int m = 0; m < 4; ++m)
#pragma unroll
                    for (int bj = 0; bj < 2; ++bj)
#pragma unroll
                        for (int j = 0; j < 4; ++j) { const unsigned gword = (j < 2) ? gw[m][bj].x : gw[m][bj].y, nword = (j < 2) ? gn[m][bj].x : gn[m][bj].y; const int sh = 16 * (j & 1);
                            const float r0 = (float)((gword >> sh) & 0xffu) * __builtin_amdgcn_rcpf((float)((nword >> sh) & 0xffu)), r1 = (float)((gword >> (sh + 8)) & 0xffu) * __builtin_amdgcn_rcpf((float)((nword >> (sh + 8)) & 0xffu));
                            if (j < 2) { acc[ai][bj][m][0][2 * j] *= r0; acc[ai][bj][m][0][2 * j + 1] *= r1; } else { acc[ai][bj][m][1][2 * j - 4] *= r0; acc[ai][bj][m][1][2 * j - 3] *= r1; } } }
        } else {
            const int row0 = pm0 * BM + wr * 64 + fr, col0 = pn0 * BM + wc * 32 + 8 * fq;
#pragma unroll
            for (int ai = 0; ai < 2; ++ai) { u32x2 gw[4][2];
#pragma unroll
                for (int m = 0; m < 4; ++m)
#pragma unroll
                    for (int bj = 0; bj < 2; ++bj) gw[m][bj] = *(const u32x2*)(gtile + ((ai * 4 + m) * 2 + bj) * 4096);
#pragma unroll
                for (int m = 0; m < 4; ++m)
#pragma unroll
                    for (int bj = 0; bj < 2; ++bj) { const size_t row = (size_t)(row0 + ai * HALF + m * 16); const int col = col0 + bj * HALF; float v[8];
#pragma unroll
                        for (int j = 0; j < 4; ++j) { const unsigned gword = (j < 2) ? gw[m][bj].x : gw[m][bj].y; const int sh = 16 * (j & 1);
                            const float g0 = (float)((gword >> sh) & 0xffu) * (1.0f / 255.0f), g1 = (float)((gword >> (sh + 8)) & 0xffu) * (1.0f / 255.0f);
                            const float a0 = (j < 2) ? acc[ai][bj][m][0][2 * j] : acc[ai][bj][m][1][2 * j - 4], a1 = (j < 2) ? acc[ai][bj][m][0][2 * j + 1] : acc[ai][bj][m][1][2 * j - 3];
                            v[2 * j] = a0 * g0; v[2 * j + 1] = a1 * g1; }
                        u32x4 w; w.x = cvt_pk_bf16(v[0], v[1]); w.y = cvt_pk_bf16(v[2], v[3]); w.z = cvt_pk_bf16(v[4], v[5]); w.w = cvt_pk_bf16(v[6], v[7]);
                        *(u32x4*)(MG + row * 2048 + col) = w; } }
        }
    }
};

template <int ROT> __device__ __forceinline__ float dpp_ror(float v) { return __builtin_bit_cast(float, __builtin_amdgcn_update_dpp(0, __builtin_bit_cast(int, v), 0x120 | ROT, 0xf, 0xf, false)); }
struct EpiConvAct {
    static constexpr bool PERM = true, AFTER_DRAIN = false, INPLACE = false;
    bf16_t* ACT; bf16_t* RAW; const float* cwt; PG8_LAS float* XA;
    __device__ __forceinline__ void operator()(const f32x4 (&acc)[2][2][4][2], const Unit& u, int wr, int wc, int fr, int fq) const {
        const int FFc = 5504;
        PG8_LAS float* CW = XA + 2048;
        { const int t8 = ((wr * 4 + wc) * 64 + fq * 16 + fr) * 2; typedef float f32x2l __attribute__((ext_vector_type(2)));
          const f32x2l v = *(const f32x2l*)(cwt + (unsigned)(u.pn * 1024 + t8)); *(PG8_LAS f32x2l*)(CW + t8) = v; }
#pragma unroll
        for (int ai = 0; ai < 2; ++ai) { PG8_LAS float* xs = XA + (((ai * 2 + wr) * 4 + wc) * 2) * 64 + fq * 8;
            if (fr == 0) {
#pragma unroll
                for (int bj = 0; bj < 2; ++bj) { *(PG8_LAS f32x4*)(xs + bj * 32) = acc[ai][bj][0][0]; *(PG8_LAS f32x4*)(xs + bj * 32 + 4) = acc[ai][bj][0][1]; } }
            if (fr == 15) {
#pragma unroll
                for (int bj = 0; bj < 2; ++bj) { *(PG8_LAS f32x4*)(xs + 64 + bj * 32) = acc[ai][bj][3][0]; *(PG8_LAS f32x4*)(xs + 64 + bj * 32 + 4) = acc[ai][bj][3][1]; } } }
        asm volatile("s_waitcnt lgkmcnt(0)" ::: "memory"); __builtin_amdgcn_s_barrier(); asm volatile("" ::: "memory");
        int fqw = fq; asm volatile("" : "+v"(fqw));
        const int chan0 = u.pn * 128 + wc * 32 + fq * 8;
#pragma unroll
        for (int ai = 0; ai < 2; ++ai) {
            const bool has_top = (ai == 1) || (wr == 1), has_bot = (ai == 0) || (wr == 0);
            const int ts = (wr == 1) ? ((ai * 2 + 0) * 4 + wc) * 2 + 1 : (((ai - 1) * 2 + 1) * 4 + wc) * 2 + 1;
            const int bs = (wr == 0) ? ((ai * 2 + 1) * 4 + wc) * 2 + 0 : (((ai + 1) * 2 + 0) * 4 + wc) * 2 + 0;
#pragma unroll
            for (int nn = 0; nn < 2; ++nn) {
                float actv[4][4];
#pragma unroll
                for (int bj = 0; bj < 2; ++bj) {
                    __builtin_amdgcn_sched_barrier(0);
                    const PG8_LAS float* wp = CW + (bj * 512 + wc * 32 + fqw * 8 + 4 * nn);
                    const f32x4 bb = *(const PG8_LAS f32x4*)wp, w0 = *(const PG8_LAS f32x4*)(wp + 128), w1 = *(const PG8_LAS f32x4*)(wp + 256), w2 = *(const PG8_LAS f32x4*)(wp + 384);
                    f32x4 ht = (f32x4){0.f, 0.f, 0.f, 0.f}, hb = ht;
                    if (has_top) ht = *(const PG8_LAS f32x4*)(XA + ts * 64 + bj * 32 + fq * 8 + 4 * nn);
                    if (has_bot) hb = *(const PG8_LAS f32x4*)(XA + bs * 64 + bj * 32 + fq * 8 + 4 * nn);
#pragma unroll
                    for (int e = 0; e < 4; ++e) {
                        float r1[4], r15[4];
#pragma unroll
                        for (int m = 0; m < 4; ++m) { r1[m] = dpp_ror<1>(acc[ai][bj][m][nn][e]); r15[m] = dpp_ror<15>(acc[ai][bj][m][nn][e]); }
#pragma unroll
                        for (int m = 0; m < 4; ++m) {
                            const float pv = (fr != 0) ? r1[m] : (m > 0 ? r1[m > 0 ? m - 1 : 0] : ht[e]), nx = (fr != 15) ? r15[m] : (m < 3 ? r15[m < 3 ? m + 1 : 3] : hb[e]);
                            const float uc = bb[e] + w0[e] * pv + w1[e] * acc[ai][bj][m][nn][e] + w2[e] * nx;
                            if (bj == 0) actv[m][e] = uc * __builtin_amdgcn_rcpf(1.0f + __expf(-uc)); else actv[m][e] *= uc; } } }
#pragma unroll
                for (int m = 0; m < 4; ++m) { const unsigned aoff = (unsigned)(u.pm * BM + ai * HALF + wr * 64 + m * 16 + fr) * (unsigned)FFc + (unsigned)(chan0 + 4 * nn);
                    typedef unsigned u32x2 __attribute__((ext_vector_type(2))); u32x2 w; w.x = cvt_pk_bf16(actv[m][0], actv[m][1]); w.y = cvt_pk_bf16(actv[m][2], actv[m][3]);
                    *(u32x2*)(ACT + aoff) = w; } } }
        { int frl = fr, fql = fq; asm volatile("" : "+v"(frl), "+v"(fql));
          if (wr == 0 && frl < 2) { bf16_t* rp = RAW + (unsigned)(((u.pm * 4 + frl) * 43 + u.pn) * 256 + wc * 32 + fql * 8);
#pragma unroll
              for (int bj = 0; bj < 2; ++bj) { const f32x4 v0 = acc[0][bj][0][0], v1 = acc[0][bj][0][1]; u32x4 w; w.x = cvt_pk_bf16(v0[0], v0[1]); w.y = cvt_pk_bf16(v0[2], v0[3]); w.z = cvt_pk_bf16(v1[0], v1[1]); w.w = cvt_pk_bf16(v1[2], v1[3]); *(u32x4*)(rp + bj * 128) = w; } }
          if (wr == 1 && frl >= 14) { bf16_t* rp = RAW + (unsigned)(((u.pm * 4 + frl - 12) * 43 + u.pn) * 256 + wc * 32 + fql * 8);
#pragma unroll
              for (int bj = 0; bj < 2; ++bj) { const f32x4 v0 = acc[1][bj][3][0], v1 = acc[1][bj][3][1]; u32x4 w; w.x = cvt_pk_bf16(v0[0], v0[1]); w.y = cvt_pk_bf16(v0[2], v0[3]); w.z = cvt_pk_bf16(v1[0], v1[1]); w.w = cvt_pk_bf16(v1[2], v1[3]); *(u32x4*)(rp + bj * 128) = w; } } }
    }
};
struct EpiF32 {
    static constexpr bool PERM = false, AFTER_DRAIN = false, INPLACE = false;
    float* C; int ldc; const float* bias;
    __device__ __forceinline__ void operator()(const f32x4 (&acc)[2][2][4][2], const Unit& u, int wr, int wc, int fr, int fq) const {
        const int row0 = u.pm * BM + wr * 64 + fr, col0 = u.pn * BM + wc * 32 + 4 * fq;
        f32x4 bv[2][2];
#pragma unroll
        for (int bj = 0; bj < 2; ++bj)
#pragma unroll
            for (int n = 0; n < 2; ++n) bv[bj][n] = bias ? *(const f32x4*)(bias + col0 + bj * HALF + n * 16) : (f32x4){0.f, 0.f, 0.f, 0.f};
#pragma unroll
        for (int ai = 0; ai < 2; ++ai)
#pragma unroll
            for (int m = 0; m < 4; ++m) { float* rowp = C + (size_t)(row0 + ai * HALF + m * 16) * ldc + col0;
#pragma unroll
                for (int bj = 0; bj < 2; ++bj)
#pragma unroll
                    for (int n = 0; n < 2; ++n) *(f32x4*)(rowp + bj * HALF + n * 16) = acc[ai][bj][m][n] + bv[bj][n]; }
    }
};
template <class Epi, class Sched, bool ALIGN_EPI = false, bool SP2 = false>
__device__ __forceinline__ void gemm_phase(PG8_LAS unsigned char* lds, const Gemm g, const Sched& S, const Epi& E, const int wave_in) {
    int tid = wave_in * 64 + mk_lane_id(); asm volatile("" : "+v"(tid));
    const int wid = __builtin_amdgcn_readfirstlane(tid >> 6), lane = tid & 63, wr = wid >> 2, wc = wid & 3, fr = lane & 15, fq = lane >> 4;
    const int K = g.K, nt = K / BK;
    unsigned voffA[2], voffB[2];
#pragma unroll
    for (int i = 0; i < 2; ++i) { int R, C; stage_rc(tid * 16 + i * 8192, R, C); const int Rb = Epi::PERM ? ((R & ~31) + perm32(R & 31)) : R;
        voffA[i] = (unsigned)(R * K + C) * 2u; voffB[i] = (unsigned)(Rb * K + C) * 2u; }
    const size_t kstep = (size_t)(BK * 2);
    const size_t hstep = (size_t)HALF * K * 2;
    const size_t tstep = 2 * hstep;
    const unsigned ldsw = (unsigned)wid * 1024u;
    const int aoff = lds_byte(wr * 64 + fr, fq * 8), boff = lds_byte(wc * 32 + fr, fq * 8);
#define PG8_SA(b, h) (((b) * 2 + (h)) * HTB)
#define PG8_SB(b, h) ((4 + (b) * 2 + (h)) * HTB)
#define PG8_STAGE(bufoff, gbase, voff) do { _Pragma("unroll") for (int _i = 0; _i < 2; ++_i) \
        __builtin_amdgcn_global_load_lds((const unsigned*)((const char*)(gbase) + (voff)[_i]), (PG8_LAS unsigned*)(lds + (bufoff) + ldsw + _i * 8192), 16, 0, 0); } while (0)
#define PG8_LDA(dst, b, h) do { _Pragma("unroll") for (int m = 0; m < 4; ++m) _Pragma("unroll") for (int k = 0; k < 2; ++k) dst[m][k] = *(const PG8_LAS bf16x8*)(lds + PG8_SA(b, h) + aoff + m * 2048 + k * 1024); } while (0)
#define PG8_LDB(dst, b, h) do { _Pragma("unroll") for (int n = 0; n < 2; ++n) _Pragma("unroll") for (int k = 0; k < 2; ++k) dst[n][k] = *(const PG8_LAS bf16x8*)(lds + PG8_SB(b, h) + boff + n * 2048 + k * 1024); } while (0)
#define PG8_MMA(ai, bj, At, Bt) do { __builtin_amdgcn_s_setprio(1); _Pragma("unroll") for (int m = 0; m < 4; ++m) _Pragma("unroll") for (int n = 0; n < 2; ++n) _Pragma("unroll") for (int k = 0; k < 2; ++k) \
        acc[ai][bj][m][n] = __builtin_amdgcn_mfma_f32_16x16x32_bf16(Bt[n][k], At[m][k], acc[ai][bj][m][n], 0, 0, 0); __builtin_amdgcn_s_setprio(0); } while (0)
#define PG8_WAIT_V(n) asm volatile("s_waitcnt vmcnt(" #n ")" ::: "memory")
#define PG8_WAIT_L(n) asm volatile("s_waitcnt lgkmcnt(" #n ")" ::: "memory")
#define PG8_BAR __builtin_amdgcn_s_barrier()
#define PG8_SCHED __builtin_amdgcn_sched_barrier(0)
    Unit cur, nxt; int ui = 0;
    if (!S.next(0, cur)) return;
    f32x4 acc[2][2][4][2];
#pragma unroll
    for (int a = 0; a < 2; ++a)
#pragma unroll
        for (int b = 0; b < 2; ++b)
#pragma unroll
            for (int m = 0; m < 4; ++m)
#pragma unroll
                for (int n = 0; n < 2; ++n) acc[a][b][m][n] = (f32x4){0.f, 0.f, 0.f, 0.f};
    bf16x8 At[4][2], B0[2][2], B1[2][2];
    const char* cA = (const char*)g.A + (size_t)cur.pm * tstep; const char* cB = (const char*)g.Bt + (size_t)cur.pn * tstep;
    S.a_ready(cur);
    if constexpr (SP2) {
        PG8_STAGE(PG8_SB(0, 0), cB, voffB); PG8_STAGE(PG8_SB(0, 1), cB + hstep, voffB); PG8_STAGE(PG8_SA(0, 0), cA, voffA); PG8_STAGE(PG8_SA(0, 1), cA + hstep, voffA);
        if (wr == 1) PG8_BAR;
        PG8_WAIT_V(2); PG8_BAR;
        PG8_STAGE(PG8_SB(1, 0), cB + kstep, voffB); PG8_STAGE(PG8_SA(1, 0), cA + kstep, voffA); PG8_STAGE(PG8_SB(1, 1), cB + hstep + kstep, voffB);
        PG8_WAIT_V(6); PG8_BAR;
    } else {
        PG8_STAGE(PG8_SB(0, 0), cB, voffB); PG8_STAGE(PG8_SA(0, 0), cA, voffA); PG8_STAGE(PG8_SB(0, 1), cB + hstep, voffB); PG8_STAGE(PG8_SA(0, 1), cA + hstep, voffA);
        if (wr == 1) PG8_BAR;
        PG8_WAIT_V(4); PG8_BAR;
        PG8_STAGE(PG8_SB(1, 0), cB + kstep, voffB); PG8_STAGE(PG8_SA(1, 0), cA + kstep, voffA); PG8_STAGE(PG8_SB(1, 1), cB + hstep + kstep, voffB);
        PG8_WAIT_V(6); PG8_BAR;
    }
    for (;;) {
        const bool has_next = S.next(ui + 1, nxt);
        const char* nA = has_next ? (const char*)g.A + (size_t)nxt.pm * tstep : cA; const char* nB = has_next ? (const char*)g.Bt + (size_t)nxt.pn * tstep : cB;
        for (int t = 0; t < nt; t += 2) {
            const bool last = (t == nt - 2);
            const char* a1 = cA + (size_t)(t + 1) * kstep;
            const char* a2 = last ? nA : cA + (size_t)(t + 2) * kstep; const char* b2 = last ? nB : cB + (size_t)(t + 2) * kstep;
            const char* a3 = a2 + kstep; const char* b3 = b2 + kstep;
            if (last && has_next) S.a_ready(nxt);
            if constexpr (SP2) {
            PG8_LDB(B0, 0, 0); PG8_LDB(B1, 0, 1); PG8_SCHED; PG8_LDA(At, 0, 0); PG8_STAGE(PG8_SA(1, 1), a1 + hstep, voffA);
            PG8_WAIT_V(8); PG8_WAIT_L(0); PG8_BAR; PG8_MMA(0, 0, At, B0); PG8_MMA(0, 1, At, B1); PG8_BAR; PG8_SCHED;
            PG8_LDA(At, 0, 1); PG8_STAGE(PG8_SB(0, 0), b2, voffB); PG8_STAGE(PG8_SB(0, 1), b2 + hstep, voffB); PG8_STAGE(PG8_SA(0, 0), a2, voffA);
            PG8_WAIT_V(8); PG8_WAIT_L(0); PG8_BAR; PG8_MMA(1, 0, At, B0); PG8_MMA(1, 1, At, B1); PG8_BAR; PG8_SCHED;
            PG8_LDB(B0, 1, 0); PG8_LDB(B1, 1, 1); PG8_SCHED; PG8_LDA(At, 1, 0); PG8_STAGE(PG8_SA(0, 1), a2 + hstep, voffA);
            PG8_WAIT_V(8); PG8_WAIT_L(0); PG8_BAR; PG8_MMA(0, 0, At, B0); PG8_MMA(0, 1, At, B1); PG8_BAR; PG8_SCHED;
            PG8_LDA(At, 1, 1); PG8_STAGE(PG8_SB(1, 0), b3, voffB); PG8_STAGE(PG8_SB(1, 1), b3 + hstep, voffB); PG8_STAGE(PG8_SA(1, 0), a3, voffA);
            PG8_WAIT_V(8); PG8_WAIT_L(0); PG8_BAR; PG8_MMA(1, 0, At, B0); PG8_MMA(1, 1, At, B1); PG8_BAR; PG8_SCHED;
            } else {
            PG8_LDB(B0, 0, 0); PG8_SCHED; PG8_LDA(At, 0, 0); PG8_STAGE(PG8_SA(1, 1), a1 + hstep, voffA);
            PG8_WAIT_L(8); PG8_BAR; PG8_WAIT_L(0); PG8_MMA(0, 0, At, B0); PG8_BAR; PG8_SCHED;
            PG8_LDB(B1, 0, 1); PG8_STAGE(PG8_SB(0, 0), b2, voffB);
            PG8_BAR; PG8_WAIT_L(0); PG8_MMA(0, 1, At, B1); PG8_BAR;
            PG8_LDA(At, 0, 1); PG8_STAGE(PG8_SA(0, 0), a2, voffA);
            PG8_BAR; PG8_WAIT_L(0); PG8_MMA(1, 0, At, B0); PG8_BAR; PG8_SCHED;
            PG8_STAGE(PG8_SB(0, 1), b2 + hstep, voffB);
            PG8_WAIT_V(6); PG8_BAR; PG8_MMA(1, 1, At, B1); PG8_BAR;
            PG8_LDB(B0, 1, 0); PG8_SCHED; PG8_LDA(At, 1, 0); PG8_STAGE(PG8_SA(0, 1), a2 + hstep, voffA);
            PG8_WAIT_L(8); PG8_BAR; PG8_WAIT_L(0); PG8_MMA(0, 0, At, B0); PG8_BAR; PG8_SCHED;
            PG8_LDB(B1, 1, 1); PG8_STAGE(PG8_SB(1, 0), b3, voffB);
            PG8_BAR; PG8_WAIT_L(0); PG8_MMA(0, 1, At, B1); PG8_BAR;
            PG8_LDA(At, 1, 1); PG8_STAGE(PG8_SA(1, 0), a3, voffA);
            PG8_BAR; PG8_WAIT_L(0); PG8_MMA(1, 0, At, B0); PG8_BAR; PG8_SCHED;
            PG8_STAGE(PG8_SB(1, 1), b3 + hstep, voffB);
            PG8_WAIT_V(6); PG8_BAR; PG8_MMA(1, 1, At, B1); PG8_BAR;
            }
        }
        if constexpr (ALIGN_EPI) { if (wr == 0) PG8_BAR; }
        if constexpr (!Epi::AFTER_DRAIN) { E(acc, cur, wr, wc, fr, fq); S.done(cur); }
        if (!has_next) break;
        bool keep = false; if constexpr (Epi::INPLACE) keep = Epi::keep(cur);
        if (!keep) {
#pragma unroll
        for (int a = 0; a < 2; ++a)
#pragma unroll
            for (int b = 0; b < 2; ++b)
#pragma unroll
                for (int m = 0; m < 4; ++m)
#pragma unroll
                    for (int n = 0; n < 2; ++n) acc[a][b][m][n] = (f32x4){0.f, 0.f, 0.f, 0.f};
        }
        cur = nxt; cA = nA; cB = nB; ++ui;
        if constexpr (ALIGN_EPI) { if (wr == 1) PG8_BAR; }
    }
    PG8_WAIT_V(0);
    if constexpr (!ALIGN_EPI) { if (wr == 0) PG8_BAR; }
    PG8_BAR;
    if constexpr (Epi::AFTER_DRAIN) { E.fused(acc, cur, wr, wc, fr, fq, lds, wid, lane); S.done(cur); }
#undef PG8_SA
#undef PG8_SB
#undef PG8_STAGE
#undef PG8_LDA
#undef PG8_LDB
#undef PG8_MMA
#undef PG8_WAIT_V
#undef PG8_WAIT_L
#undef PG8_BAR
#undef PG8_SCHED
}
}

#define XB_TMO      128
#define XB_XCNT(j)  (256  + 64 * (j))
#define XB_XSUB(j)  (1280 + 64 * (j))
#define XB_XGEN(j)  (2304 + 64 * (j))
#define XB_TOP      3328
#define XB_TOPGEN   3392
#define XCD_BAR_WORDS 3456
#define XB_SPIN_CAP (1u << 18)

__device__ __forceinline__ unsigned xb_ld(unsigned* p)              { return __hip_atomic_load(p, __ATOMIC_RELAXED, __HIP_MEMORY_SCOPE_AGENT); }
__device__ __forceinline__ unsigned xb_add(unsigned* p, unsigned v) { return __hip_atomic_fetch_add(p, v, __ATOMIC_RELAXED, __HIP_MEMORY_SCOPE_AGENT); }
__device__ __forceinline__ unsigned xb_xcc_id() { return (unsigned)__builtin_amdgcn_s_getreg((3 << 11) | 20) & 0xFu; }
#define XB_SPIN(cond, bar) do { unsigned _sp = 0; while (cond) { __builtin_amdgcn_s_sleep(1); \
    if ((++_sp & 255u) == 0u) { if (xb_ld(&(bar)[XB_TMO])) break; if (_sp > XB_SPIN_CAP) { atomicAdd(&(bar)[XB_TMO], 1u); break; } } } } while (0)

struct XcdBarrier {
    unsigned w0;
    unsigned* bar; unsigned x;
    volatile LAS unsigned* st;
};

__device__ __forceinline__ XcdBarrier xcd_barrier_post(unsigned* bar, volatile LAS unsigned* st) {
    XcdBarrier b; b.w0 = 0u; b.bar = bar; b.x = xb_xcc_id(); b.st = st;
    if (threadIdx.x == 0) (void)xb_add(&bar[XB_XCNT(b.x)], 1u);
    return b;
}
__device__ __forceinline__ void xcd_barrier_complete(unsigned* bar, unsigned x, unsigned& nloc, unsigned& nx) {
    const unsigned G = gridDim.x * gridDim.y * gridDim.z;
    unsigned sum, cnt, mine, sp = 0u;
    for (;;) {
        sum = 0u; cnt = 0u; mine = 0u;
#pragma unroll
        for (unsigned j = 0; j < 16; ++j) { const unsigned c = xb_ld(&bar[XB_XCNT(j)]); sum += c; cnt += (c > 0u) ? 1u : 0u; mine = (j == x) ? c : mine; }
        if (sum == G) break;
        __builtin_amdgcn_s_sleep(1);
        if ((++sp & 255u) == 0u) { if (xb_ld(&bar[XB_TMO])) break; if (sp > XB_SPIN_CAP) { atomicAdd(&bar[XB_TMO], 1u); break; } }
    }
    nloc = mine > 0u ? mine : 1u; nx = cnt > 0u ? cnt : 1u;
}

__device__ __forceinline__ void xcd_barrier(const XcdBarrier& b) {
    asm volatile("s_waitcnt vmcnt(0)" ::: "memory");
    __syncthreads();
    if (b.w0 != 0u && (unsigned)mk_lane_id() == 0u) {
        unsigned* bar = b.bar;
        __builtin_amdgcn_s_waitcnt(0);
        unsigned nloc = b.st[0], nx = b.st[1];
        if (nloc == 0u) { xcd_barrier_complete(bar, b.x, nloc, nx); b.st[0] = nloc; b.st[1] = nx; }
        const unsigned old = xb_add(&bar[XB_XSUB(b.x)], 1u);
        const unsigned gen = old / nloc;
        if (old + 1u == (gen + 1u) * nloc) {
            __builtin_amdgcn_fence(__ATOMIC_RELEASE, "agent");
            asm volatile("s_waitcnt vmcnt(0)" ::: "memory");
            const unsigned og = xb_add(&bar[XB_TOP], 1u);
            const unsigned tg = og / nx;
            if (og + 1u == (tg + 1u) * nx) xb_add(&bar[XB_TOPGEN], 1u);
            else XB_SPIN(xb_ld(&bar[XB_TOPGEN]) == tg, bar);
            __builtin_amdgcn_fence(__ATOMIC_ACQUIRE, "agent");
            xb_add(&bar[XB_XGEN(b.x)], 1u);
            asm volatile("s_waitcnt vmcnt(0)" ::: "memory");
        } else {
            XB_SPIN(xb_ld(&bar[XB_XGEN(b.x)]) == gen, bar);
            __builtin_amdgcn_fence(__ATOMIC_ACQUIRE, "agent");
            asm volatile("s_waitcnt vmcnt(0)" ::: "memory");
        }
    }
    __syncthreads();
}

#ifndef ATT_EXP
#define ATT_EXP 0
#endif
#ifndef HG_EXP
#define HG_EXP 0
#endif
constexpr int S_ = 16384, D_ = 2048, W_ = 1024, NIN = 19456, FF = 5504, FF2 = 11008, DEPTH = 4, NHEAD = 8, HD = 128;
constexpr float RMS_EPS = 1e-6f;
constexpr int NWAVES = 8, NTHR = 512;
constexpr size_t MiB = 1u << 20;
constexpr size_t WS_CTL = 0, CTL_ZERO_BYTES = 1 * MiB;
constexpr size_t WS_MOD = 1 * MiB;
constexpr size_t WS_LB = WS_MOD + 256 * 1024;
constexpr size_t WS_ROT = 2 * MiB;
constexpr size_t WS_WIN = 10 * MiB;
constexpr size_t WS_WBR = WS_WIN + 304 * MiB;
constexpr size_t WS_WOUT = WS_WBR + 64 * MiB;
constexpr size_t WS_WUP = WS_WOUT + 32 * MiB;
constexpr size_t WS_WDN = WS_WUP + 172 * MiB;
constexpr size_t WS_H = WS_WDN + 86 * MiB;
constexpr size_t WS_Z = WS_H + 64 * MiB;
constexpr size_t WS_ZG = WS_Z + 352 * MiB;
constexpr size_t WS_BR = WS_Z + 608 * MiB;
constexpr size_t WS_P = WS_BR + 128 * MiB;
constexpr size_t WS_MERGED = WS_P + 256 * MiB;
constexpr size_t WS_Y = WS_MERGED + 64 * MiB;
constexpr size_t WS_N2 = WS_Y + 128 * MiB;
constexpr size_t WS_VT = WS_N2 + 384 * MiB;
constexpr size_t WS_LRUW = WS_VT + 96 * MiB;
constexpr size_t WS_POOLW = WS_LRUW + 4 * MiB;
constexpr size_t WS_RAW = WS_POOLW + 2 * MiB;
constexpr size_t WS_CWT = WS_RAW + 6 * MiB;
constexpr size_t WS_END = WS_CWT + 1 * MiB;
constexpr size_t WS_LSUM = WS_N2;
constexpr size_t WS_LCIN = WS_N2 + 4 * MiB;
constexpr size_t WS_LSU = WS_N2 + 8 * MiB;
constexpr size_t WS_LAF = WS_N2 + 40 * MiB;
constexpr size_t WS_LAB = WS_N2 + 72 * MiB;
constexpr size_t WS_XR = WS_N2 + 128 * MiB;
constexpr size_t WS_OP01 = WS_H;
constexpr size_t WS_OP2 = WS_Y + 64 * MiB;
constexpr size_t WS_ML = WS_Y + 96 * MiB;
constexpr size_t SEG = (size_t)S_ * W_;
constexpr size_t WS_HQS = WS_P;
constexpr size_t WS_HF = WS_P + 64 * MiB;
constexpr size_t WS_HO = WS_P + 192 * MiB;
constexpr size_t WS_PD = WS_P + 320 * MiB;
constexpr size_t WS_HST = WS_P;
constexpr size_t WS_HDEC = WS_P + 128 * MiB;
constexpr int CW_BAR = 4096;
constexpr int RING_BYTES = 131072, MISC_OFF = 143360, LDS_BYTES = 147456;

typedef unsigned short bf16;
typedef unsigned v4u __attribute__((ext_vector_type(4)));
typedef unsigned v2u __attribute__((ext_vector_type(2)));
typedef float f32x4 __attribute__((ext_vector_type(4)));
#define LDS_WAIT() asm volatile("s_waitcnt lgkmcnt(0)" ::: "memory")
__device__ __forceinline__ unsigned f2bf(float f) { unsigned u = __builtin_bit_cast(unsigned, f); return (u + 0x7fffu + ((u >> 16) & 1u)) >> 16; }
__device__ __forceinline__ unsigned pk2(float lo, float hi) { return f2bf(lo) | (f2bf(hi) << 16); }
typedef __bf16 bf16x2_t __attribute__((ext_vector_type(2)));
typedef float f32x2_t __attribute__((ext_vector_type(2)));
__device__ __forceinline__ unsigned cvtpk(float lo, float hi) { const f32x2_t v = {lo, hi}; return __builtin_bit_cast(unsigned, __builtin_convertvector(v, bf16x2_t)); }
__device__ __forceinline__ float bf2f(unsigned b) { return __builtin_bit_cast(float, b << 16); }
__device__ __forceinline__ float bflo(unsigned w) { return __builtin_bit_cast(float, w << 16); }
__device__ __forceinline__ float bfhi(unsigned w) { return __builtin_bit_cast(float, w & 0xffff0000u); }
__device__ __forceinline__ void unpack8(const v4u w, float (&o)[8]) { o[0] = bflo(w.x); o[1] = bfhi(w.x); o[2] = bflo(w.y); o[3] = bfhi(w.y); o[4] = bflo(w.z); o[5] = bfhi(w.z); o[6] = bflo(w.w); o[7] = bfhi(w.w); }
__device__ __forceinline__ float sigmoidf_(float x) { return __builtin_amdgcn_rcpf(1.0f + __expf(-x)); }
__device__ __forceinline__ float siluf_(float x) { return x * __builtin_amdgcn_rcpf(1.0f + __expf(-x)); }
__device__ __forceinline__ float gelu_tanh(float x) { const float u = 0.7978845608028654f * (x + 0.044715f * x * x * x); const float e = __expf(-2.0f * u); return x * __builtin_amdgcn_rcpf(1.0f + e); }
__device__ __forceinline__ float mk_bperm(int srclane, float v) { return __builtin_bit_cast(float, __builtin_amdgcn_ds_bpermute(srclane << 2, __builtin_bit_cast(int, v))); }
__device__ __forceinline__ float wave_sum(float v) { const int l = mk_lane_id();
#pragma unroll
    for (int o = 1; o < 64; o <<= 1) v += mk_bperm(l ^ o, v);
    return v;
}
__device__ __forceinline__ float wave_max(float v) { const int l = mk_lane_id();
#pragma unroll
    for (int o = 1; o < 64; o <<= 1) v = fmaxf(v, mk_bperm(l ^ o, v));
    return v;
}

struct Args {
    const float *x, *c; const int* pos; const float *ada_w, *ada_b, *norm_g, *w_in, *hgrn_lb, *hgrn_onorm, *lru_conv_w, *lru_conv_b, *lru_wa, *lru_ba, *lru_wx, *lru_bx, *lru_lambda,
        *pool_w, *pool_scale, *w_branch, *w_out, *ffn_up, *ffn_conv_w, *ffn_conv_b, *ffn_down;
    float* out; unsigned char* ws; int ph_lo, ph_hi;
};

struct TJob { const float* W; bf16* WT; int K, N, item, up; };
__device__ __forceinline__ void tr_load(const TJob& j, f32x4 (&v)[16], int lane) { const int nblk = j.N / 64, kb = j.item / nblk, nb = j.item % nblk, k0 = 64 * kb, n0 = 64 * nb;
#pragma unroll
    for (int i = 0; i < 16; ++i) v[i] = *(const f32x4*)(j.W + (size_t)(k0 + 4 * i + (lane >> 4)) * j.N + n0 + 4 * (lane & 15)); }
__device__ __forceinline__ void tr_to_lds(const f32x4 (&v)[16], LAS float* scr, int lane) {
#pragma unroll
    for (int i = 0; i < 16; ++i) { LAS float* s = scr + (4 * i + (lane >> 4)) * 65 + 4 * (lane & 15); s[0] = v[i][0]; s[1] = v[i][1]; s[2] = v[i][2]; s[3] = v[i][3]; }
    LDS_WAIT(); asm volatile("" ::: "memory"); }
__device__ __forceinline__ void tr_store(const TJob& j, LAS float* scr, int lane) { const int nblk = j.N / 64, kb = j.item / nblk, nb = j.item % nblk, k0 = 64 * kb, n0 = 64 * nb;
    int d0 = n0; if (j.up) { const int isv = n0 >= FF ? 1 : 0, c = n0 - isv * FF; d0 = 256 * (c >> 7) + 128 * isv + (c & 127); }
    const int c = lane & 7;
#pragma unroll
    for (int jj = 0; jj < 8; ++jj) { const int n = (lane >> 3) + 8 * jj; const LAS float* s = scr + (8 * c) * 65 + n;
        v4u o; o.x = cvtpk(s[0 * 65], s[1 * 65]); o.y = cvtpk(s[2 * 65], s[3 * 65]); o.z = cvtpk(s[4 * 65], s[5 * 65]); o.w = cvtpk(s[6 * 65], s[7 * 65]);
        *(GAS v4u*)(j.WT + (size_t)(d0 + n) * j.K + k0 + 8 * c) = o; }
    LDS_WAIT(); asm volatile("" ::: "memory"); }
__device__ __forceinline__ TJob tr_job(const Args& a, unsigned char* ws, int it) {
    constexpr int I_IN = (D_ / 64) * (NIN / 64), I_BR1 = (W_ / 64) * (D_ / 64), I_BR = 4 * I_BR1, I_OUT = (D_ / 64) * (D_ / 64), I_UP = (D_ / 64) * (FF2 / 64), I_DN = (FF / 64) * (D_ / 64);
    constexpr int I_LAYER = I_IN + I_BR + I_OUT + I_UP + I_DN, I_BIG = DEPTH * I_LAYER;
    TJob j; j.up = 0;
    if (it < I_BIG) { const int L = it / I_LAYER; int r = it - L * I_LAYER;
        if (r < I_IN) { j.W = a.w_in + (size_t)L * D_ * NIN; j.K = D_; j.N = NIN; j.WT = (bf16*)(ws + WS_WIN) + (size_t)L * NIN * D_; j.item = r; return j; } r -= I_IN;
        if (r < I_BR) { const int g = r / I_BR1; j.W = a.w_branch + ((size_t)L * 4 + g) * W_ * D_; j.K = W_; j.N = D_; j.WT = (bf16*)(ws + WS_WBR) + ((size_t)L * 4 + g) * D_ * W_; j.item = r - g * I_BR1; return j; } r -= I_BR;
        if (r < I_OUT) { j.W = a.w_out + (size_t)L * D_ * D_; j.K = D_; j.N = D_; j.WT = (bf16*)(ws + WS_WOUT) + (size_t)L * D_ * D_; j.item = r; return j; } r -= I_OUT;
        if (r < I_UP) { j.W = a.ffn_up + (size_t)L * D_ * FF2; j.K = D_; j.N = FF2; j.WT = (bf16*)(ws + WS_WUP) + (size_t)L * FF2 * D_; j.item = r; j.up = 1; return j; } r -= I_UP;
        j.W = a.ffn_down + (size_t)L * FF * D_; j.K = FF; j.N = D_; j.WT = (bf16*)(ws + WS_WDN) + (size_t)L * D_ * FF; j.item = r; return j; }
    const int s = it - I_BIG;
    if (s < 512) { const int blk = s >> 2, sel = blk >> 6, rest = blk & 63;
        j.W = (sel ? a.lru_wx : a.lru_wa) + (size_t)rest * 16384; j.K = 128; j.N = 128; j.WT = (bf16*)(ws + WS_LRUW) + (size_t)blk * 16384; j.item = s & 3; return j; }
    const int r = s - 512, blk = r >> 4; j.W = a.pool_w + (size_t)blk * 65536; j.K = 256; j.N = 256; j.WT = (bf16*)(ws + WS_POOLW) + (size_t)blk * 65536; j.item = r & 15; return j;
}
__device__ __forceinline__ void ph_prologue(const Args& a, LAS unsigned char* lds, int bid, int nb, int tid, int wave, int lane) {
    unsigned char* ws = a.ws;
    LAS float* scr = (LAS float*)(lds + wave * 16640);
    const int gw = bid * NWAVES + wave, NGW = nb * NWAVES;
    constexpr int N_ITEMS = DEPTH * ((D_ / 64) * (NIN / 64) + 4 * (W_ / 64) * (D_ / 64) + (D_ / 64) * (D_ / 64) + (D_ / 64) * (FF2 / 64) + (FF / 64) * (D_ / 64)) + 512 + 256;
    if (gw < N_ITEMS) { f32x4 v[16]; TJob cur = tr_job(a, ws, gw); tr_load(cur, v, lane);
        for (int it = gw; it < N_ITEMS; it += NGW) { tr_to_lds(v, scr, lane);
            const bool hn = it + NGW < N_ITEMS; TJob nx = cur; if (hn) { nx = tr_job(a, ws, it + NGW); tr_load(nx, v, lane); }
            tr_store(cur, scr, lane); cur = nx; } }
    __syncthreads();
    LAS float* red = (LAS float*)lds;
    float* mod = (float*)(ws + WS_MOD);
    for (int it = bid; it < DEPTH * 192; it += nb) {
        const int L = it / 192, j0 = (it % 192) * 64;
        const float* wp = a.ada_w + (size_t)L * D_ * 6 * D_ + (size_t)(wave * 256) * 6 * D_ + j0 + lane;
        float acc = 0.f;
        for (int k0 = 0; k0 < 256; k0 += 32) { float wv[32];
#pragma unroll
            for (int k = 0; k < 32; ++k) wv[k] = wp[(size_t)(k0 + k) * 6 * D_];
#pragma unroll
            for (int k = 0; k < 32; ++k) { const float cv = a.c[wave * 256 + k0 + k]; acc += siluf_(cv) * wv[k]; } }
        red[wave * 64 + lane] = acc;
        __syncthreads();
        if (wave == 0) { float s = a.ada_b[L * 6 * D_ + j0 + lane];
#pragma unroll
            for (int w = 0; w < 8; ++w) s += red[w * 64 + lane];
            mod[L * 6 * D_ + j0 + lane] = s; }
        __syncthreads();
    }
    { float* cwt = (float*)(ws + WS_CWT);
      for (int i = bid * NTHR + tid; i < DEPTH * 43 * 8 * 128; i += nb * NTHR) { const int c = i & 127, r = (i >> 7) & 7, pn = (i >> 10) % 43, L = (i >> 10) / 43, ch = (r >> 2) * FF + pn * 128 + c, k = r & 3;
          cwt[i] = k == 0 ? a.ffn_conv_b[(size_t)L * FF2 + ch] : a.ffn_conv_w[((size_t)L * 3 + (k - 1)) * FF2 + ch]; } }
    if (bid == 0) { float* lb = (float*)(ws + WS_LB);
        for (int i = tid; i < 2 * W_; i += NTHR) { float e[DEPTH], s = 0.f;
#pragma unroll
            for (int L = 0; L < DEPTH; ++L) e[L] = a.hgrn_lb[L * 2 * W_ + i];
            const float mx = fmaxf(fmaxf(e[0], e[1]), fmaxf(e[2], e[3]));
#pragma unroll
            for (int L = 0; L < DEPTH; ++L) { e[L] = expf(e[L] - mx); s += e[L]; }
            float cum = 0.f; lb[i] = 0.f;
#pragma unroll
            for (int L = 1; L < DEPTH; ++L) { cum += e[L] / s; lb[L * 2 * W_ + i] = cum; } } }
    { float2* rot = (float2*)(ws + WS_ROT);
      for (int i = bid * NTHR + tid; i < S_ * 64; i += nb * NTHR) { const int t = i >> 6, d = i & 63;
          const float inv = powf(10000.0f, -(float)d / 64.0f); const float ang = (float)a.pos[t] * inv; float sn, cs; sincosf(ang, &sn, &cs); rot[i] = make_float2(cs, sn); } }
}

template <bool HAS_Y>
__device__ __forceinline__ void ph_resnorm(const Args& a, LAS unsigned char* lds, int bid, int nb, int tid, int wave, int lane,
                                           const float* xsrc, float* xdst, const bf16* y, bf16* hdst, int L, int gsel, int ysel, int Lh, int hsel, int scsel, int shsel, const bf16* xsrcb = nullptr, bf16* xdstb = nullptr) {
    const float* mod = (const float*)(a.ws + WS_MOD);
    LAS float* cy = (LAS float*)lds; LAS float* ca = cy + D_; LAS float* cb = ca + D_;
    for (int c = tid; c < D_; c += NTHR) {
        if (HAS_Y) cy[c] = mod[L * 6 * D_ + gsel * D_ + c] * a.norm_g[(L * 4 + ysel) * D_ + c];
        if (hdst) { ca[c] = a.norm_g[(Lh * 4 + hsel) * D_ + c] * (1.0f + mod[Lh * 6 * D_ + scsel * D_ + c]); cb[c] = mod[Lh * 6 * D_ + shsel * D_ + c]; }
    }
    __syncthreads();
#pragma unroll 2
    for (int row = bid * NWAVES + wave; row < S_; row += nb * NWAVES) {
        f32x4 xv[8];
        if (xsrcb) { const v2u* xb = (const v2u*)(xsrcb + (size_t)row * D_) + lane;
#pragma unroll
            for (int j = 0; j < 8; ++j) { const v2u w = __builtin_nontemporal_load(&xb[64 * j]); xv[j] = (f32x4){bflo(w.x), bfhi(w.x), bflo(w.y), bfhi(w.y)}; } }
        else { const f32x4* xr = (const f32x4*)(xsrc + (size_t)row * D_) + lane;
#pragma unroll
            for (int j = 0; j < 8; ++j) xv[j] = __builtin_nontemporal_load(&xr[64 * j]); }
        if (HAS_Y) {
            const v2u* yr = (const v2u*)(y + (size_t)row * D_) + lane; f32x4 yv[8]; float ss = 0.f;
#pragma unroll
            for (int j = 0; j < 8; ++j) { const v2u yw = __builtin_nontemporal_load(&yr[64 * j]); yv[j] = (f32x4){bflo(yw.x), bfhi(yw.x), bflo(yw.y), bfhi(yw.y)}; ss += (yv[j].x * yv[j].x + yv[j].y * yv[j].y) + (yv[j].z * yv[j].z + yv[j].w * yv[j].w); }
            const float r = rsqrtf(wave_sum(ss) * (1.0f / D_) + RMS_EPS);
            if (xdstb) { v2u* xo = (v2u*)(xdstb + (size_t)row * D_) + lane;
#pragma unroll
                for (int j = 0; j < 8; ++j) { const f32x4 cv = *(const LAS f32x4*)(cy + 4 * (lane + 64 * j)); xv[j] = xv[j] + yv[j] * r * cv; v2u w; w.x = pk2(xv[j].x, xv[j].y); w.y = pk2(xv[j].z, xv[j].w); __builtin_nontemporal_store(w, &xo[64 * j]); } }
            else { f32x4* xo = (f32x4*)(xdst + (size_t)row * D_) + lane;
#pragma unroll
                for (int j = 0; j < 8; ++j) { const f32x4 cv = *(const LAS f32x4*)(cy + 4 * (lane + 64 * j)); xv[j] = xv[j] + yv[j] * r * cv; __builtin_nontemporal_store(xv[j], &xo[64 * j]); } }
        }
        if (hdst) {
            float ss = 0.f;
#pragma unroll
            for (int j = 0; j < 8; ++j) ss += (xv[j].x * xv[j].x + xv[j].y * xv[j].y) + (xv[j].z * xv[j].z + xv[j].w * xv[j].w);
            const float r = rsqrtf(wave_sum(ss) * (1.0f / D_) + RMS_EPS);
            v2u* ho = (v2u*)(hdst + (size_t)row * D_) + lane;
#pragma unroll
            for (int j = 0; j < 8; ++j) { const f32x4 av = *(const LAS f32x4*)(ca + 4 * (lane + 64 * j)), bv = *(const LAS f32x4*)(cb + 4 * (lane + 64 * j)); const f32x4 h = xv[j] * r * av + bv;
                v2u w; w.x = pk2(h.x, h.y); w.y = pk2(h.z, h.w); ho[64 * j] = w; }
        }
    }
    __syncthreads();
}

__device__ __forceinline__ void ph_hgrn_prep(const Args& a, int L, int bid, int nb, int tid) {
    const bf16* z = (const bf16*)(a.ws + WS_Z); const float* lb = (const float*)(a.ws + WS_LB) + L * 2 * W_;
    float* QS = (float*)(a.ws + WS_HQS); float* F = (float*)(a.ws + WS_HF);
    for (size_t i = (size_t)bid * NTHR + tid; i < SEG; i += (size_t)nb * NTHR) { const int ch = (int)(i & (W_ - 1));
        QS[i] = siluf_(bf2f(z[0 * SEG + i]));
        const float l0 = lb[ch], l1 = lb[W_ + ch];
        F[i] = l0 + (1.0f - l0) * sigmoidf_(bf2f(z[1 * SEG + i])); F[SEG + i] = l1 + (1.0f - l1) * sigmoidf_(bf2f(z[2 * SEG + i])); }
}
__device__ __forceinline__ void ph_hgrn_rec(const Args& a, LAS unsigned char* lds, int bid, int tid) {
    if (bid >= 16) return;
    const int dir = bid >> 3, head = bid & 7, kq = tid >> 7, v = tid & 127;
    const bf16* zi = (const bf16*)(a.ws + WS_Z) + 3 * SEG; const float* QS = (const float*)(a.ws + WS_HQS); const float* F = (const float*)(a.ws + WS_HF) + (size_t)dir * SEG;
    float* HO = (float*)(a.ws + WS_HO) + (size_t)dir * SEG;
    LAS float* part = (LAS float*)lds;
    float st[32];
#pragma unroll
    for (int j = 0; j < 32; ++j) st[j] = 0.f;
    for (int n0 = 0; n0 < S_; n0 += 8) {
#pragma unroll 1
        for (int s = 0; s < 8; ++s) { const int n = n0 + s, t = dir ? S_ - 1 - n : n;
            const float iv = bf2f(zi[(size_t)t * W_ + head * HD + v]);
            const f32x4* fp = (const f32x4*)(F + (size_t)t * W_ + head * HD + kq * 32); const f32x4* qp = (const f32x4*)(QS + (size_t)t * W_ + head * HD + kq * 32);
            float o = 0.f;
#pragma unroll
            for (int j = 0; j < 8; ++j) { const f32x4 f = fp[j], q = qp[j];
                st[4 * j + 0] = f.x * st[4 * j + 0] + (1.0f - f.x) * iv; o += q.x * st[4 * j + 0];
                st[4 * j + 1] = f.y * st[4 * j + 1] + (1.0f - f.y) * iv; o += q.y * st[4 * j + 1];
                st[4 * j + 2] = f.z * st[4 * j + 2] + (1.0f - f.z) * iv; o += q.z * st[4 * j + 2];
                st[4 * j + 3] = f.w * st[4 * j + 3] + (1.0f - f.w) * iv; o += q.w * st[4 * j + 3]; }
            part[(kq * 8 + s) * 128 + v] = o; }
        __syncthreads();
#pragma unroll
        for (int h = 0; h < 2; ++h) { const int s = (tid >> 7) + 4 * h; const int n = n0 + s, t = dir ? S_ - 1 - n : n;
            HO[(size_t)t * W_ + head * HD + v] = (part[(0 * 8 + s) * 128 + v] + part[(1 * 8 + s) * 128 + v]) + (part[(2 * 8 + s) * 128 + v] + part[(3 * 8 + s) * 128 + v]); }
        __syncthreads();
    }
}
__device__ __forceinline__ void ph_hgrn_fin(const Args& a, int L, int bid, int nb, int wave, int lane) {
    const float* HO = (const float*)(a.ws + WS_HO); const bf16* zg = (const bf16*)(a.ws + WS_Z) + 4 * SEG; bf16* br = (bf16*)(a.ws + WS_BR);
    for (int it = bid * NWAVES + wave; it < S_ * NHEAD; it += nb * NWAVES) { const int t = it >> 3, h = it & 7; const size_t o0 = (size_t)t * W_ + h * HD + 2 * lane;
        const float o_a = HO[o0] + HO[SEG + o0], o_b = HO[o0 + 1] + HO[SEG + o0 + 1];
        const float r = rsqrtf(wave_sum(o_a * o_a + o_b * o_b) * (1.0f / HD) + RMS_EPS);
        const unsigned gw = *(const unsigned*)(zg + o0); const float* on = a.hgrn_onorm + L * W_ + h * HD + 2 * lane;
        *(unsigned*)(br + o0) = pk2(o_a * r * on[0] * siluf_(bflo(gw)), o_b * r * on[1] * siluf_(bfhi(gw))); }
}
__device__ __forceinline__ void ph_lru_xc(const Args& a, int L, int bid, int nb, int tid) {
    const bf16* zx = (const bf16*)(a.ws + WS_Z) + 5 * SEG; float* XC = (float*)(a.ws + WS_N2);
    const float* cw = a.lru_conv_w + (size_t)L * 2 * 4 * W_; const float* cbp = a.lru_conv_b + (size_t)L * 2 * W_;
    for (size_t i = (size_t)bid * NTHR + tid; i < SEG; i += (size_t)nb * NTHR) { const int ch = (int)(i & (W_ - 1)), t = (int)(i >> 10);
        float f = cbp[ch], b = cbp[W_ + ch];
#pragma unroll
        for (int j = 0; j < 4; ++j) { const int tf = t - 3 + j, tb = t + 3 - j;
            if (tf >= 0) f += cw[(0 * 4 + j) * W_ + ch] * bf2f(zx[(size_t)tf * W_ + ch]);
            if (tb < S_) b += cw[(1 * 4 + j) * W_ + ch] * bf2f(zx[(size_t)tb * W_ + ch]); }
        XC[i] = f; XC[SEG + i] = b; }
}
__device__ __forceinline__ void ph_lru_gates(const Args& a, int L, int bid, int nb, int tid) {
    const float* XC = (const float*)(a.ws + WS_N2); float* A = (float*)(a.ws + WS_N2 + 128 * MiB); float* U = (float*)(a.ws + WS_N2 + 256 * MiB);
    for (size_t i = (size_t)bid * NTHR + tid; i < 2 * SEG; i += (size_t)nb * NTHR) { const int dir = (int)(i / SEG); const size_t r = i - (size_t)dir * SEG; const int t = (int)(r >> 10), ch = (int)(r & (W_ - 1)), hh = ch >> 7, jj = ch & 127;
        const float* xr = XC + (size_t)dir * SEG + (size_t)t * W_ + hh * 128;
        const float* wa = a.lru_wa + (((size_t)L * 2 + dir) * 8 + hh) * 128 * 128 + jj; const float* wx = a.lru_wx + (((size_t)L * 2 + dir) * 8 + hh) * 128 * 128 + jj;
        float ra = a.lru_ba[(L * 2 + dir) * W_ + ch], rx = a.lru_bx[(L * 2 + dir) * W_ + ch];
#pragma unroll 8
        for (int k = 0; k < 128; ++k) { const float xv = xr[k]; ra += xv * wa[k * 128]; rx += xv * wx[k * 128]; }
        const float rg = sigmoidf_(ra), ig = sigmoidf_(rx);
        const float lam = a.lru_lambda[(L * 2 + dir) * W_ + ch]; const float sp = log1pf(expf(-lam));
        const float la = -8.0f * rg * sp;
        A[i] = expf(la); U[i] = sqrtf(-expm1f(2.0f * la)) * (ig * xr[jj]); }
}
__device__ __forceinline__ void ph_lru_scan(const Args& a, int bid, int tid) {
    const int id = bid * NTHR + tid; if (id >= 2 * W_) return;
    const int dir = id >> 10, ch = id & (W_ - 1);
    const float* A = (const float*)(a.ws + WS_N2 + 128 * MiB) + (size_t)dir * SEG + ch; float* U = (float*)(a.ws + WS_N2 + 256 * MiB) + (size_t)dir * SEG + ch;
    float h = 0.f;
    for (int n0 = 0; n0 < S_; n0 += 8) { float av[8], uv[8];
#pragma unroll
        for (int s = 0; s < 8; ++s) { const int n = n0 + s, t = dir ? S_ - 1 - n : n; av[s] = A[(size_t)t * W_]; uv[s] = U[(size_t)t * W_]; }
#pragma unroll
        for (int s = 0; s < 8; ++s) { const int n = n0 + s, t = dir ? S_ - 1 - n : n; h = av[s] * h + uv[s]; U[(size_t)t * W_] = h; } }
}
__device__ __forceinline__ void ph_lru_fin(const Args& a, int bid, int nb, int tid) {
    const float* U = (const float*)(a.ws + WS_N2 + 256 * MiB); const bf16* zg = (const bf16*)(a.ws + WS_Z) + 6 * SEG; bf16* br = (bf16*)(a.ws + WS_BR) + SEG;
    for (size_t i = (size_t)bid * NTHR + tid; i < SEG; i += (size_t)nb * NTHR) br[i] = (bf16)f2bf((U[i] + U[SEG + i]) * gelu_tanh(bf2f(zg[i])));
}
__device__ __forceinline__ void ph_pool_d(const Args& a, int bid, int nb, int tid) {
    const bf16* zp = (const bf16*)(a.ws + WS_Z) + 7 * SEG; float* PD = (float*)(a.ws + WS_PD);
    for (size_t i = (size_t)bid * NTHR + tid; i < SEG; i += (size_t)nb * NTHR) { const int ch = (int)(i & (W_ - 1)), t = (int)(i >> 10), w2 = 1 << (ch >> 8);
        const int lo = max(t - w2, 0), hi = min(t + w2, S_); float s = 0.f;
        for (int tt = lo; tt < hi; ++tt) s += bf2f(zp[(size_t)tt * W_ + ch]);
        PD[i] = s / (float)(hi - lo) - bf2f(zp[i]); }
}
__device__ __forceinline__ void ph_pool_mm(const Args& a, int L, int bid, int nb, int tid) {
    const float* PD = (const float*)(a.ws + WS_PD); bf16* br = (bf16*)(a.ws + WS_BR) + 2 * SEG;
    for (size_t i = (size_t)bid * NTHR + tid; i < SEG; i += (size_t)nb * NTHR) { const int ch = (int)(i & (W_ - 1)), t = (int)(i >> 10), gi = ch >> 8, jj = ch & 255;
        const float* dr = PD + (size_t)t * W_ + gi * 256; const float* pw = a.pool_w + ((size_t)L * 4 + gi) * 256 * 256 + jj; float s = 0.f;
#pragma unroll 8
        for (int k = 0; k < 256; ++k) s += dr[k] * pw[k * 256];
        br[i] = (bf16)f2bf(s * a.pool_scale[L * W_ + ch]); }
}
__device__ __forceinline__ void ph_attn_prep(unsigned char* ws, int bid, int nb, int tid) {
    bf16* zq = (bf16*)(ws + WS_Z) + 8 * SEG; bf16* zk = zq + SEG; const float2* rot = (const float2*)(ws + WS_ROT);
#pragma unroll 4
    for (int i = bid * NTHR + tid; i < S_ * NHEAD * 8; i += nb * NTHR) { const int d8 = (i & 7) * 8, h = (i >> 3) & 7, t = i >> 6;
        const size_t o = (size_t)t * W_ + h * HD + d8;
        const v4u q1 = *(const v4u*)(zq + o), q2 = *(const v4u*)(zq + o + 64), k1 = *(const v4u*)(zk + o), k2 = *(const v4u*)(zk + o + 64);
        const f32x4* rp = (const f32x4*)(rot + t * 64 + d8); const f32x4 r0 = rp[0], r1 = rp[1], r2 = rp[2], r3 = rp[3];
        const float cs[8] = {r0[0], r0[2], r1[0], r1[2], r2[0], r2[2], r3[0], r3[2]}, sn[8] = {r0[1], r0[3], r1[1], r1[3], r2[1], r2[3], r3[1], r3[3]};
        const unsigned qa[4] = {q1.x, q1.y, q1.z, q1.w}, qb[4] = {q2.x, q2.y, q2.z, q2.w}, ka[4] = {k1.x, k1.y, k1.z, k1.w}, kb[4] = {k2.x, k2.y, k2.z, k2.w};
        unsigned oq1[4], oq2[4], ok1[4], ok2[4]; const float sc = 0.08838834764831845f;
#pragma unroll
        for (int j = 0; j < 4; ++j) { const float c0 = cs[2 * j], s0 = sn[2 * j], c1 = cs[2 * j + 1], s1 = sn[2 * j + 1];
            const float a0 = bflo(qa[j]), a1 = bfhi(qa[j]), b0 = bflo(qb[j]), b1 = bfhi(qb[j]);
            oq1[j] = cvtpk((a0 * c0 - b0 * s0) * sc, (a1 * c1 - b1 * s1) * sc); oq2[j] = cvtpk((b0 * c0 + a0 * s0) * sc, (b1 * c1 + a1 * s1) * sc);
            const float e0 = bflo(ka[j]), e1 = bfhi(ka[j]), f0 = bflo(kb[j]), f1 = bfhi(kb[j]);
            ok1[j] = cvtpk(e0 * c0 - f0 * s0, e1 * c1 - f1 * s1); ok2[j] = cvtpk(f0 * c0 + e0 * s0, f1 * c1 + e1 * s1); }
        *(v4u*)(zq + o) = (v4u){oq1[0], oq1[1], oq1[2], oq1[3]}; *(v4u*)(zq + o + 64) = (v4u){oq2[0], oq2[1], oq2[2], oq2[3]};
        *(v4u*)(zk + o) = (v4u){ok1[0], ok1[1], ok1[2], ok1[3]}; *(v4u*)(zk + o + 64) = (v4u){ok2[0], ok2[1], ok2[2], ok2[3]}; }
}
__device__ __forceinline__ void ph_attn_naive(const Args& a, LAS unsigned char* lds, int bid, int nb, int wave, int lane) {
    const bf16* zq = (const bf16*)(a.ws + WS_Z) + 8 * SEG; const bf16* zk = zq + SEG; const bf16* zv = zk + SEG; bf16* br = (bf16*)(a.ws + WS_BR) + 3 * SEG;
    LAS float* qs = (LAS float*)(lds + wave * 4096); LAS float* ps = qs + 128;
    for (int it = bid * NWAVES + wave; it < S_ * NHEAD; it += nb * NWAVES) { const int t = it >> 3, h = it & 7;
        { const unsigned qw = *(const unsigned*)(zq + (size_t)t * W_ + h * HD + 2 * lane); qs[2 * lane] = bflo(qw); qs[2 * lane + 1] = bfhi(qw); }
        LDS_WAIT(); asm volatile("" ::: "memory");
        float sv[7]; float mx = -1e30f;
#pragma unroll
        for (int i = 0; i < 7; ++i) { const int e = lane + 64 * i; float s = -1e30f;
            if (e < 387) { const int g = e / 129, o = e - g * 129 - 64, dil = (g == 0) ? 1 : (g == 1 ? 4 : 16), p = t + dil * o;
                if (p >= 0 && p < S_) { const v4u* kr = (const v4u*)(zk + (size_t)p * W_ + h * HD); float d = 0.f;
#pragma unroll 4
                    for (int c = 0; c < 16; ++c) { const v4u kw = kr[c]; const LAS float* qq = qs + 8 * c;
                        d += qq[0] * bflo(kw.x) + qq[1] * bfhi(kw.x) + qq[2] * bflo(kw.y) + qq[3] * bfhi(kw.y) + qq[4] * bflo(kw.z) + qq[5] * bfhi(kw.z) + qq[6] * bflo(kw.w) + qq[7] * bfhi(kw.w); }
                    s = d; } }
            sv[i] = s; mx = fmaxf(mx, s); }
        mx = wave_max(mx); float l = 0.f;
#pragma unroll
        for (int i = 0; i < 7; ++i) { const float p = (sv[i] > -1e29f) ? __expf(sv[i] - mx) : 0.f; l += p; ps[lane + 64 * i] = p; }
        l = wave_sum(l);
        LDS_WAIT(); asm volatile("" ::: "memory");
        float o0 = 0.f, o1 = 0.f;
        for (int e = 0; e < 387; ++e) { const float p = ps[e]; if (p != 0.f) { const int g = e / 129, o = e - g * 129 - 64, dil = (g == 0) ? 1 : (g == 1 ? 4 : 16), pp = t + dil * o;
                const unsigned vw = *(const unsigned*)(zv + (size_t)pp * W_ + h * HD + 2 * lane); o0 += p * bflo(vw); o1 += p * bfhi(vw); } }
        const float il = 1.0f / l;
        *(unsigned*)(br + (size_t)t * W_ + h * HD + 2 * lane) = pk2(o0 * il, o1 * il);
        LDS_WAIT(); asm volatile("" ::: "memory");
    }
}

typedef short bf16x8 __attribute__((ext_vector_type(8)));
__device__ __forceinline__ bf16* op_ptr(unsigned char* ws, int g) { return g < 2 ? (bf16*)(ws + WS_OP01) + (size_t)g * SEG : (bf16*)(ws + WS_OP2); }
typedef short s16x4 __attribute__((ext_vector_type(4)));
__device__ __forceinline__ bf16x8 tr_frag(const LAS bf16* T, int pitch, int r0, int c0, int lane) {
    const LAS bf16* p = T + (r0 + 8 * (lane >> 4) + ((lane & 15) >> 2)) * pitch + c0 + 4 * (lane & 3);
    const s16x4 x = __builtin_amdgcn_ds_read_tr16_b64_v4i16((LAS s16x4*)p), y = __builtin_amdgcn_ds_read_tr16_b64_v4i16((LAS s16x4*)(p + 4 * pitch));
    return __builtin_shufflevector(x, y, 0, 1, 2, 3, 4, 5, 6, 7);
}
__device__ __forceinline__ bf16x8 tr_frag_rs(const LAS bf16* T, int pitch, int r0, int rs, int c0, int lane) {
    const LAS bf16* p = T + (r0 + rs * (8 * (lane >> 4) + ((lane & 15) >> 2))) * pitch + c0 + 4 * (lane & 3);
    const s16x4 x = __builtin_amdgcn_ds_read_tr16_b64_v4i16((LAS s16x4*)p), y = __builtin_amdgcn_ds_read_tr16_b64_v4i16((LAS s16x4*)(p + 4 * rs * pitch));
    return __builtin_shufflevector(x, y, 0, 1, 2, 3, 4, 5, 6, 7);
}
__device__ __forceinline__ size_t vt_off(int g, int h, int d, int rr, int Lg, int l) { return ((size_t)g * NHEAD + h) * ((size_t)S_ * HD) + (size_t)rr * Lg * HD + (size_t)(l >> 5) * (32 * HD) + d * 32 + (l & 31); }
__device__ __forceinline__ void ph_attn_vt(unsigned char* ws, LAS unsigned char* lds, int bid, int nb, int tid, int wave, int lane) {
    const bf16* zv = (const bf16*)(ws + WS_Z) + 10 * SEG; bf16* VT = (bf16*)(ws + WS_VT);
    LAS bf16* T = (LAS bf16*)lds; const int n = lane & 15, G = lane >> 4;
    for (int unit = bid; unit < NHEAD * (S_ / 256); unit += nb) { const int h = unit & 7, t0 = (unit >> 3) * 256;
#pragma unroll
        for (int ps = 0; ps < 8; ++ps) { const int i = (tid >> 4) + 32 * ps, c = tid & 15;
            *(LAS v4u*)(T + i * 136 + 8 * c) = *(const v4u*)(zv + (size_t)(t0 + i) * W_ + h * HD + 8 * c); }
        __syncthreads();
#pragma unroll
        for (int g = 0; g < 3; ++g) { const int dsh = 2 * g, dil = 1 << dsh, Lg = S_ >> dsh;
#pragma unroll
            for (int q = 0; q < 8; ++q) {
                const int runs = 8 >> dsh;
                if (g < 2) { const int rr = q / runs, run = q % runs;
                    const bf16x8 v = tr_frag_rs(T, 136, rr + 32 * run * dil, dil, 16 * wave, lane);
                    *(v4u*)(VT + vt_off(g, h, 16 * wave + n, rr, Lg, (t0 >> dsh) + 32 * run + 8 * G)) = __builtin_bit_cast(v4u, v); }
                else {
                    const int rr = 2 * q + (G >> 1);
                    const LAS bf16* p = T + (rr + 16 * (8 * (G & 1) + ((lane & 15) >> 2))) * 136 + 16 * wave + 4 * (lane & 3);
                    const s16x4 x = __builtin_amdgcn_ds_read_tr16_b64_v4i16((LAS s16x4*)p), y = __builtin_amdgcn_ds_read_tr16_b64_v4i16((LAS s16x4*)(p + 4 * 16 * 136));
                    const bf16x8 v = __builtin_shufflevector(x, y, 0, 1, 2, 3, 4, 5, 6, 7);
                    *(v4u*)(VT + vt_off(g, h, 16 * wave + n, rr, Lg, (t0 >> dsh) + 8 * (G & 1))) = __builtin_bit_cast(v4u, v); } } }
        __syncthreads();
    }
}
__device__ __forceinline__ void ph_attn_main(unsigned char* ws, int bid, int nb, int wave, int lane) {
    const bf16* QR = (const bf16*)(ws + WS_Z) + 8 * SEG; const bf16* KR = QR + SEG; const bf16* VT = (const bf16*)(ws + WS_VT); float2* ML = (float2*)(ws + WS_ML);
    const int n = lane & 15, G = lane >> 4;
    const int vb = (nb & 7) == 0 ? (bid & 7) * (nb >> 3) + (bid >> 3) : bid;
    for (int unit = vb * NWAVES + wave; unit < 3 * 4096; unit += nb * NWAVES) {
        const int g = unit >> 12, u = unit & 4095, dsh = 2 * g, Lg = S_ >> dsh, nqb = Lg >> 5, h = u >> 9, rr = (u & 511) / nqb, qb = (u & 511) - rr * nqb;
        bf16x8 bq[2][4];
#pragma unroll
        for (int qk = 0; qk < 2; ++qk) { const unsigned qofs = (unsigned)((((32 * qb + 16 * qk + n) << dsh) + rr) * (W_ * 2) + h * (HD * 2) + 16 * G);
#pragma unroll
            for (int kk = 0; kk < 4; ++kk) bq[qk][kk] = *(const bf16x8*)((const char*)QR + qofs + 64 * kk); }
        f32x4 acc[8][2]; float mrun[2] = {-1e30f, -1e30f}, lsum[2] = {0.f, 0.f};
#pragma unroll
        for (int db = 0; db < 8; ++db) { acc[db][0] = (f32x4){0.f, 0.f, 0.f, 0.f}; acc[db][1] = (f32x4){0.f, 0.f, 0.f, 0.f}; }
        const bf16* vtb = VT + vt_off(g, h, n, rr, Lg, 8 * G);
#define ATT_LDK(dst, kbase_) do { _Pragma("unroll") for (int b = 0; b < 2; ++b) { int lk = (kbase_) + 8 * (n >> 2) + 4 * b + (n & 3); lk = lk < 0 ? 0 : (lk >= Lg ? Lg - 1 : lk); \
            const unsigned kofs_ = (unsigned)(((lk << dsh) + rr) * (W_ * 2) + h * (HD * 2) + 16 * G); _Pragma("unroll") for (int kk = 0; kk < 4; ++kk) dst[b][kk] = *(const bf16x8*)((const char*)KR + kofs_ + 64 * kk); } } while (0)
        bf16x8 ak[2][2][4];
        const int koff = (5 - qb % 5) % 5;
#define ATT_SIDX(i_) (((i_) + koff) >= 5 ? (i_) + koff - 5 : (i_) + koff)
        ATT_LDK(ak[0], 32 * qb - 64 + 32 * ATT_SIDX(0));
#pragma unroll
        for (int step = 0; step < 5; ++step) { const int kbase = 32 * qb - 64 + 32 * ATT_SIDX(step), cb = step & 1;
            int kblk = kbase >> 5; kblk = kblk < 0 ? 0 : (kblk > (Lg >> 5) - 1 ? (Lg >> 5) - 1 : kblk);
            bf16x8 av[8]; const bf16* vstep = vtb + (size_t)kblk * (32 * HD);
#pragma unroll
            for (int db = 0; db < 8; ++db) av[db] = *(const bf16x8*)(vstep + db * 512);
#if ATT_EXP == 1
            if (step < 4) { _Pragma("unroll") for (int b_ = 0; b_ < 2; ++b_) _Pragma("unroll") for (int k_ = 0; k_ < 4; ++k_) ak[cb ^ 1][b_][k_] = ak[cb][b_][k_]; }
#else
            if (step < 4) ATT_LDK(ak[cb ^ 1], 32 * qb - 64 + 32 * ATT_SIDX(step + 1));
#endif
            f32x4 st[2][2];
#pragma unroll
            for (int b = 0; b < 2; ++b)
#pragma unroll
                for (int qk = 0; qk < 2; ++qk) { f32x4 s = (f32x4){0.f, 0.f, 0.f, 0.f};
#pragma unroll
                    for (int kk = 0; kk < 4; ++kk) s = __builtin_amdgcn_mfma_f32_16x16x32_bf16(ak[cb][b][kk], bq[qk][kk], s, 0, 0, 0);
                    st[qk][b] = s; }
            bf16x8 pb[2];
#pragma unroll
            for (int qk = 0; qk < 2; ++qk) { const int lq = 32 * qb + 16 * qk + n; float sv[8]; float mx = mrun[qk];
#pragma unroll
                for (int j = 0; j < 8; ++j) { const int lk = kbase + 8 * G + j; const int df = lk - lq; const bool valid = (lk >= 0) && (lk < Lg) && (df <= 64) && (df >= -64);
                    sv[j] = valid ? st[qk][j >> 2][j & 3] : -1e30f; mx = fmaxf(mx, sv[j]); }
                mx = fmaxf(mx, mk_bperm(lane ^ 16, mx)); mx = fmaxf(mx, mk_bperm(lane ^ 32, mx));
                const float alpha = __expf(mrun[qk] - mx); mrun[qk] = mx; float ps = 0.f; float p[8];
#pragma unroll
                for (int j = 0; j < 8; ++j) { p[j] = sv[j] > -1e29f ? __expf(sv[j] - mx) : 0.f; ps += p[j]; }
                lsum[qk] = lsum[qk] * alpha + ps;
                v4u pw; pw.x = cvtpk(p[0], p[1]); pw.y = cvtpk(p[2], p[3]); pw.z = cvtpk(p[4], p[5]); pw.w = cvtpk(p[6], p[7]); pb[qk] = __builtin_bit_cast(bf16x8, pw);
#pragma unroll
                for (int db = 0; db < 8; ++db) acc[db][qk] = acc[db][qk] * alpha; }
#pragma unroll
            for (int db = 0; db < 8; ++db) {
                acc[db][0] = __builtin_amdgcn_mfma_f32_16x16x32_bf16(av[db], pb[0], acc[db][0], 0, 0, 0); acc[db][1] = __builtin_amdgcn_mfma_f32_16x16x32_bf16(av[db], pb[1], acc[db][1], 0, 0, 0); }
        }
#undef ATT_LDK
#undef ATT_SIDX
        bf16* OP = op_ptr(ws, g);
#pragma unroll
        for (int qk = 0; qk < 2; ++qk) { float l = lsum[qk]; l += mk_bperm(lane ^ 16, l); l += mk_bperm(lane ^ 32, l); const float il = 1.0f / l;
            const size_t tq = ((size_t)(32 * qb + 16 * qk + n) << dsh) + rr;
#pragma unroll
            for (int db = 0; db < 8; ++db) { const f32x4 o = acc[db][qk] * il; v2u w; w.x = cvtpk(o[0], o[1]); w.y = cvtpk(o[2], o[3]); *(v2u*)(OP + tq * W_ + h * HD + 16 * db + 4 * G) = w; }
            if (G == 0) ML[((size_t)g * S_ + tq) * NHEAD + h] = make_float2(mrun[qk], l); }
    }
}
__device__ __forceinline__ void ph_attn_comb(unsigned char* ws, int bid, int nb, int tid) {
    const float2* ML = (const float2*)(ws + WS_ML); bf16* br = (bf16*)(ws + WS_BR) + 3 * SEG;
    const bf16* O0 = op_ptr(ws, 0); const bf16* O1 = op_ptr(ws, 1); const bf16* O2 = op_ptr(ws, 2);
#pragma unroll 4
    for (size_t i = (size_t)bid * NTHR + tid; i < SEG / 8; i += (size_t)nb * NTHR) { const size_t e = i * 8; const int t = (int)(e >> 10), h = (int)((e >> 7) & 7);
        const float2 a0 = ML[((size_t)0 * S_ + t) * NHEAD + h], a1 = ML[((size_t)1 * S_ + t) * NHEAD + h], a2 = ML[((size_t)2 * S_ + t) * NHEAD + h];
        const float M = fmaxf(a0.x, fmaxf(a1.x, a2.x)); float w0 = __expf(a0.x - M) * a0.y, w1 = __expf(a1.x - M) * a1.y, w2 = __expf(a2.x - M) * a2.y; const float iw = 1.0f / (w0 + w1 + w2); w0 *= iw; w1 *= iw; w2 *= iw;
        const v4u x0 = *(const v4u*)(O0 + e), x1 = *(const v4u*)(O1 + e), x2 = *(const v4u*)(O2 + e); v4u o;
        o.x = pk2(w0 * bflo(x0.x) + w1 * bflo(x1.x) + w2 * bflo(x2.x), w0 * bfhi(x0.x) + w1 * bfhi(x1.x) + w2 * bfhi(x2.x));
        o.y = pk2(w0 * bflo(x0.y) + w1 * bflo(x1.y) + w2 * bflo(x2.y), w0 * bfhi(x0.y) + w1 * bfhi(x1.y) + w2 * bfhi(x2.y));
        o.z = pk2(w0 * bflo(x0.z) + w1 * bflo(x1.z) + w2 * bflo(x2.z), w0 * bfhi(x0.z) + w1 * bfhi(x1.z) + w2 * bfhi(x2.z));
        o.w = pk2(w0 * bflo(x0.w) + w1 * bflo(x1.w) + w2 * bflo(x2.w), w0 * bfhi(x0.w) + w1 * bfhi(x1.w) + w2 * bfhi(x2.w));
        *(v4u*)(br + e) = o; }
}

__device__ __forceinline__ void unpack16(const v4u w0, const v4u w1, float (&o)[16]) { const unsigned ww[8] = {w0.x, w0.y, w0.z, w0.w, w1.x, w1.y, w1.z, w1.w};
#pragma unroll
    for (int i = 0; i < 8; ++i) { o[2 * i] = bflo(ww[i]); o[2 * i + 1] = bfhi(ww[i]); } }
__device__ __forceinline__ void pack16_store(LAS bf16* dst, const float (&v)[16]) { v4u o0, o1; o0.x = cvtpk(v[0], v[1]); o0.y = cvtpk(v[2], v[3]); o0.z = cvtpk(v[4], v[5]); o0.w = cvtpk(v[6], v[7]);
    o1.x = cvtpk(v[8], v[9]); o1.y = cvtpk(v[10], v[11]); o1.z = cvtpk(v[12], v[13]); o1.w = cvtpk(v[14], v[15]); *(LAS v4u*)dst = o0; *(LAS v4u*)(dst + 8) = o1; }
__device__ __forceinline__ void pack8_store(LAS bf16* dst, const float* v) { v4u o; o.x = cvtpk(v[0], v[1]); o.y = cvtpk(v[2], v[3]); o.z = cvtpk(v[4], v[5]); o.w = cvtpk(v[6], v[7]); *(LAS v4u*)dst = o; }
__device__ __forceinline__ void hg_gate_scan(const v4u za, const v4u zb, const LAS float* lb8, int lane, float (&lf)[16], float (&kk)[16]) {
    float zv[16]; unpack16(za, zb, zv);
    const f32x4 l0 = *(const LAS f32x4*)lb8, l1 = *(const LAS f32x4*)(lb8 + 4); const float lb[8] = {l0[0], l0[1], l0[2], l0[3], l1[0], l1[1], l1[2], l1[3]};
#pragma unroll
    for (int e = 0; e < 16; ++e) { const float l = lb[e & 7]; const float f = l + (1.0f - l) * __builtin_amdgcn_rcpf(1.0f + __expf(-zv[e])); kk[e] = 1.0f - f; lf[e] = __logf(f); }
#pragma unroll
    for (int i = 0; i < 8; ++i) { lf[8 + i] += lf[i]; float t = lf[8 + i];
        float v = mk_bperm((lane - 16) & 63, t); t += (lane >= 16) ? v : 0.f; v = mk_bperm((lane - 32) & 63, t); t += (lane >= 32) ? v : 0.f;
        const float ex = t - lf[8 + i]; lf[i] += ex; lf[8 + i] = t; }
}
__device__ __forceinline__ void ph_hgrn_h1(unsigned char* ws, LAS unsigned char* lds, int L, int bid, int nb, int tid, int wave, int lane) {
    const bf16* z = (const bf16*)(ws + WS_Z); const float* lbp = (const float*)(ws + WS_LB) + L * 2 * W_;
    bf16* HST = (bf16*)(ws + WS_HST); float* HDEC = (float*)(ws + WS_HDEC);
    LAS float* WT = (LAS float*)lds; LAS bf16* KD = (LAS bf16*)(lds + 4096); LAS bf16* IS = (LAS bf16*)(lds + 21504); LAS float* LB = (LAS float*)(lds + 38912);
    const int jp = tid >> 4, ja = 2 * jp, k0 = (tid & 15) * 8, n = lane & 15, G = lane >> 4;
    if (bid >= 256 * NHEAD) return;
    const bool fixed_head = (nb & 7) == 0;
    if (fixed_head && tid < 256) LB[tid] = lbp[(tid >> 7) * W_ + (bid & 7) * HD + (tid & 127)];
    v4u pf[4];
#define H1_FETCH(item_, dir_) do { const int c_ = (item_) >> 3, h_ = (item_) & 7; const size_t oa_ = (size_t)(c_ * 64 + ((dir_) ? 63 - ja : ja)) * W_ + h_ * HD + k0, ob_ = (size_t)(c_ * 64 + ((dir_) ? 62 - ja : ja + 1)) * W_ + h_ * HD + k0; \
        pf[0] = *(const v4u*)(z + (size_t)(1 + (dir_)) * SEG + oa_); pf[1] = *(const v4u*)(z + (size_t)(1 + (dir_)) * SEG + ob_); pf[2] = *(const v4u*)(z + (size_t)3 * SEG + oa_); pf[3] = *(const v4u*)(z + (size_t)3 * SEG + ob_); } while (0)
    H1_FETCH(bid, 0);
    for (int item = bid; item < 256 * NHEAD; item += nb) { const int c = item >> 3, h = item & 7;
        if (!fixed_head) { __syncthreads(); if (tid < 256) LB[tid] = lbp[(tid >> 7) * W_ + h * HD + (tid & 127)]; __syncthreads(); }
#pragma unroll 1
        for (int dir = 0; dir < 2; ++dir) {
            const v4u f0 = pf[0], f1 = pf[1], i0 = pf[2], i1 = pf[3];
            if (dir == 0) H1_FETCH(item, 1); else if (item + nb < 256 * NHEAD) H1_FETCH(item + nb, 0);
            if (dir == 0 && item == bid) __syncthreads();
            float lf[16], kk[16]; hg_gate_scan(f0, f1, LB + dir * 128 + k0, lane, lf, kk);
            if (G == 3) { *(LAS f32x4*)(WT + wave * 128 + k0) = (f32x4){lf[8], lf[9], lf[10], lf[11]}; *(LAS f32x4*)(WT + wave * 128 + k0 + 4) = (f32x4){lf[12], lf[13], lf[14], lf[15]}; }
            __syncthreads();
            *(LAS v4u*)(IS + ja * 136 + k0) = i0; *(LAS v4u*)(IS + (ja + 1) * 136 + k0) = i1;
            { float pre[8], tot[8];
#pragma unroll
              for (int i = 0; i < 8; ++i) { pre[i] = 0.f; tot[i] = 0.f; }
#pragma unroll
              for (int w = 0; w < 8; ++w)
#pragma unroll
                  for (int q = 0; q < 2; ++q) { const f32x4 t4 = *(const LAS f32x4*)(WT + w * 128 + k0 + 4 * q);
#pragma unroll
                      for (int e = 0; e < 4; ++e) { tot[4 * q + e] += t4[e]; if (w < wave) pre[4 * q + e] += t4[e]; } }
              float kd[16];
#pragma unroll
              for (int e = 0; e < 16; ++e) kd[e] = kk[e] * __expf(tot[e & 7] - (lf[e] + pre[e & 7]));
              pack8_store(KD + ja * 136 + k0, kd); pack8_store(KD + (ja + 1) * 136 + k0, kd + 8);
              if (jp == 0) { float* hd = HDEC + (((size_t)dir * 256 + c) * 8 + h) * 128 + k0;
                  *(f32x4*)hd = (f32x4){__expf(tot[0]), __expf(tot[1]), __expf(tot[2]), __expf(tot[3])}; *(f32x4*)(hd + 4) = (f32x4){__expf(tot[4]), __expf(tot[5]), __expf(tot[6]), __expf(tot[7])}; } }
            __syncthreads();
            if (HG_EXP != 2) { const bf16x8 a0 = tr_frag(KD, 136, 0, 16 * wave, lane), a1 = tr_frag(KD, 136, 32, 16 * wave, lane);
              bf16* dst = HST + ((((size_t)dir * 256 + c) * 8 + h) * 128) * 128 + (wave >> 1) * 4096 + 16 * (wave & 1) + 4 * G;
#pragma unroll
              for (int vb = 0; vb < 8; ++vb) { const bf16x8 b0 = tr_frag(IS, 136, 0, 16 * vb, lane), b1 = tr_frag(IS, 136, 32, 16 * vb, lane);
                  f32x4 u = (f32x4){0.f, 0.f, 0.f, 0.f}; u = __builtin_amdgcn_mfma_f32_16x16x32_bf16(a0, b0, u, 0, 0, 0); u = __builtin_amdgcn_mfma_f32_16x16x32_bf16(a1, b1, u, 0, 0, 0);
                  v2u w; w.x = cvtpk(u[0], u[1]); w.y = cvtpk(u[2], u[3]); *(v2u*)(dst + (16 * vb + n) * 32) = w; } }
        }
    }
    __syncthreads();
#undef H1_FETCH
}
__device__ __forceinline__ void ph_hgrn_h2(unsigned char* ws, int bid, int nb, int tid) {
    unsigned* HST = (unsigned*)(ws + WS_HST); const float2* HDEC = (const float2*)(ws + WS_HDEC);
    for (int g = bid * NTHR + tid; g < 131072; g += nb * NTHR) { const int kp = g & 63, v = (g >> 6) & 127, h = (g >> 13) & 7, dir = g >> 16;
        const int kq = (((v >> 5) & 3) << 4) | (kp & 15);
        unsigned* base = HST + ((size_t)dir * 256 * 8 + h) * 8192 + v * 64 + kp; const float2* dec = HDEC + ((size_t)dir * 256 * 8 + h) * 64 + kq;
        float s0 = 0.f, s1 = 0.f;
        for (int cc = 0; cc < 256; cc += 8) { unsigned u[8]; float2 d[8];
#pragma unroll
            for (int j = 0; j < 8; ++j) { const int c = dir ? 255 - (cc + j) : cc + j; u[j] = base[(size_t)c * 65536]; d[j] = dec[(size_t)c * 512]; }
#pragma unroll
            for (int j = 0; j < 8; ++j) { const int c = dir ? 255 - (cc + j) : cc + j; s0 = d[j].x * s0 + bflo(u[j]); s1 = d[j].y * s1 + bfhi(u[j]); base[(size_t)c * 65536] = pk2(s0, s1); } }
    }
}
__device__ __forceinline__ void ph_hgrn_h3(unsigned char* ws, LAS unsigned char* lds, const float* onorm, int L, int bid, int nb, int tid, int wave, int lane) {
    const bf16* z = (const bf16*)(ws + WS_Z); const float* lbp = (const float*)(ws + WS_LB) + L * 2 * W_; const bf16* HST = (const bf16*)(ws + WS_HST); bf16* br = (bf16*)(ws + WS_BR);
    LAS float* WT = (LAS float*)lds; LAS bf16* QB = (LAS bf16*)(lds + 4096); LAS bf16* QT = (LAS bf16*)(lds + 21504); LAS bf16* KT = (LAS bf16*)(lds + 38912); LAS bf16* IS = (LAS bf16*)(lds + 82432);
    LAS float* RED = (LAS float*)(lds + 99840); LAS float* LB = (LAS float*)(lds + 101888);
    const int jp = tid >> 4, ja = 2 * jp, k0 = (tid & 15) * 8, n = lane & 15, G = lane >> 4, si = wave >> 1;
    if (bid >= 256 * NHEAD) return;
    const bool fixed_head = (nb & 7) == 0;
    if (fixed_head && tid < 256) LB[tid] = lbp[(tid >> 7) * W_ + (bid & 7) * HD + (tid & 127)];
    v4u pf[6];
#define H3_FETCH(item_, dir_) do { const int c_ = (item_) >> 3, h_ = (item_) & 7; const size_t oa_ = (size_t)(c_ * 64 + ((dir_) ? 63 - ja : ja)) * W_ + h_ * HD + k0, ob_ = (size_t)(c_ * 64 + ((dir_) ? 62 - ja : ja + 1)) * W_ + h_ * HD + k0; \
        pf[0] = *(const v4u*)(z + (size_t)(1 + (dir_)) * SEG + oa_); pf[1] = *(const v4u*)(z + (size_t)(1 + (dir_)) * SEG + ob_); pf[2] = *(const v4u*)(z + oa_); pf[3] = *(const v4u*)(z + ob_); \
        pf[4] = *(const v4u*)(z + (size_t)3 * SEG + oa_); pf[5] = *(const v4u*)(z + (size_t)3 * SEG + ob_); } while (0)
    H3_FETCH(bid, 0);
    for (int item = bid; item < 256 * NHEAD; item += nb) { const int c = item >> 3, h = item & 7, t0 = c * 64;
        if (!fixed_head) { __syncthreads(); if (tid < 256) LB[tid] = lbp[(tid >> 7) * W_ + h * HD + (tid & 127)]; __syncthreads(); }
        v2u gpre[4];
#pragma unroll
        for (int x = 0; x < 4; ++x) gpre[x] = *(const v2u*)(z + (size_t)4 * SEG + (size_t)(t0 + 16 * x + n) * W_ + h * HD + 16 * wave + 4 * G);
        f32x4 acc[4];
#pragma unroll
        for (int x = 0; x < 4; ++x) acc[x] = (f32x4){0.f, 0.f, 0.f, 0.f};
#pragma unroll 1
        for (int dir = 0; dir < 2; ++dir) {
            const v4u f0 = pf[0], f1 = pf[1], q0 = pf[2], q1 = pf[3], i0 = pf[4], i1 = pf[5];
            if (dir == 0) H3_FETCH(item, 1); else if (item + nb < 256 * NHEAD) H3_FETCH(item + nb, 0);
            const int cs = dir ? c + 1 : c - 1; const bool has_state = (cs >= 0 && cs < 256);
            bf16x8 as[4];
            if (has_state) { const bf16* sp = HST + (((size_t)dir * 256 + cs) * 8 + h) * 16384 + (16 * wave + n) * 32 + 8 * G;
#pragma unroll
                for (int ks = 0; ks < 4; ++ks) as[ks] = *(const bf16x8*)(sp + 4096 * ks); }
            if (dir == 0 && item == bid) __syncthreads();
            float lf[16], kk[16]; hg_gate_scan(f0, f1, LB + dir * 128 + k0, lane, lf, kk);
            if (G == 3) { *(LAS f32x4*)(WT + wave * 128 + k0) = (f32x4){lf[8], lf[9], lf[10], lf[11]}; *(LAS f32x4*)(WT + wave * 128 + k0 + 4) = (f32x4){lf[12], lf[13], lf[14], lf[15]}; }
            __syncthreads();
            *(LAS v4u*)(IS + ja * 136 + k0) = i0; *(LAS v4u*)(IS + (ja + 1) * 136 + k0) = i1;
            { float qs[16]; unpack16(q0, q1, qs);
#pragma unroll
              for (int e = 0; e < 16; ++e) qs[e] = qs[e] * __builtin_amdgcn_rcpf(1.0f + __expf(-qs[e]));
#pragma unroll
              for (int w = 0; w < 7; ++w) { if (w < wave) {
#pragma unroll
                  for (int q = 0; q < 2; ++q) { const f32x4 t4 = *(const LAS f32x4*)(WT + w * 128 + k0 + 4 * q);
#pragma unroll
                      for (int e = 0; e < 4; ++e) { lf[4 * q + e] += t4[e]; lf[8 + 4 * q + e] += t4[e]; } } } }
              float tmp[16];
#pragma unroll
              for (int e = 0; e < 16; ++e) tmp[e] = qs[e] * __expf(lf[e]);
              pack8_store(QB + ja * 136 + k0, tmp); pack8_store(QB + (ja + 1) * 136 + k0, tmp + 8);
              float ref[8];
#pragma unroll
              for (int i = 0; i < 8; ++i) ref[i] = 0.f;
#pragma unroll
              for (int it = 0; it < 4; ++it) {
                  if (it > 0) {
#pragma unroll
                      for (int w = 2 * it - 2; w < 2 * it; ++w)
#pragma unroll
                          for (int q = 0; q < 2; ++q) { const f32x4 t4 = *(const LAS f32x4*)(WT + w * 128 + k0 + 4 * q); ref[4 * q] += t4[0]; ref[4 * q + 1] += t4[1]; ref[4 * q + 2] += t4[2]; ref[4 * q + 3] += t4[3]; } }
                  if (si == it) {
#pragma unroll
                      for (int e = 0; e < 16; ++e) tmp[e] = qs[e] * __expf(lf[e] - ref[e & 7]);
                      pack8_store(QT + ja * 136 + k0, tmp); pack8_store(QT + (ja + 1) * 136 + k0, tmp + 8); }
                  if (si <= it) {
#pragma unroll
                      for (int e = 0; e < 16; ++e) tmp[e] = kk[e] * __expf(fminf(ref[e & 7] - lf[e], 80.f));
                      pack8_store(KT + (8 * it * (it + 1) + ja) * 136 + k0, tmp); pack8_store(KT + (8 * it * (it + 1) + ja + 1) * 136 + k0, tmp + 8); } } }
            __syncthreads();
            if (has_state) {
#pragma unroll
                for (int x = 0; x < 4; ++x) { const int jt = dir ? 63 - 16 * x - n : 16 * x + n;
#pragma unroll
                    for (int ks = 0; ks < 4; ++ks) { const bf16x8 b = *(const LAS bf16x8*)(QB + jt * 136 + 32 * ks + 8 * G); acc[x] = __builtin_amdgcn_mfma_f32_16x16x32_bf16(as[ks], b, acc[x], 0, 0, 0); } } }
#pragma unroll
            for (int x = 0; x < 4; ++x) { const int jt = dir ? 63 - 16 * x - n : 16 * x + n; const int it = dir ? 3 - x : x; const int kb = 8 * it * (it + 1);
                bf16x8 bqt[4];
#pragma unroll
                for (int ks = 0; ks < 4; ++ks) bqt[ks] = *(const LAS bf16x8*)(QT + jt * 136 + 32 * ks + 8 * G);
#pragma unroll
                for (int p = 0; p < 2; ++p) { if (p <= (it >> 1)) {
                    float pv[8];
#pragma unroll
                    for (int b = 0; b < 2; ++b) { const int js = 32 * p + 8 * (n >> 2) + 4 * b + (n & 3); f32x4 sc = (f32x4){0.f, 0.f, 0.f, 0.f};
#pragma unroll
                        for (int ks = 0; ks < 4; ++ks) { const bf16x8 ak = *(const LAS bf16x8*)(KT + (kb + js) * 136 + 32 * ks + 8 * G); sc = __builtin_amdgcn_mfma_f32_16x16x32_bf16(ak, bqt[ks], sc, 0, 0, 0); }
#pragma unroll
                        for (int r = 0; r < 4; ++r) { const int jsr = 32 * p + 8 * G + 4 * b + r; pv[4 * b + r] = (jsr <= jt) ? sc[r] : 0.f; } }
                    v4u pw; pw.x = cvtpk(pv[0], pv[1]); pw.y = cvtpk(pv[2], pv[3]); pw.z = cvtpk(pv[4], pv[5]); pw.w = cvtpk(pv[6], pv[7]);
                    const bf16x8 av = tr_frag(IS, 136, 32 * p, 16 * wave, lane);
                    acc[x] = __builtin_amdgcn_mfma_f32_16x16x32_bf16(av, __builtin_bit_cast(bf16x8, pw), acc[x], 0, 0, 0); } } }
        }
#pragma unroll
        for (int x = 0; x < 4; ++x) { float ss = acc[x][0] * acc[x][0] + acc[x][1] * acc[x][1] + acc[x][2] * acc[x][2] + acc[x][3] * acc[x][3]; ss += mk_bperm(lane ^ 16, ss); ss += mk_bperm(lane ^ 32, ss); if (G == 0) RED[wave * 64 + 16 * x + n] = ss; }
        __syncthreads();
        { const int ch = h * HD + 16 * wave + 4 * G; const f32x4 on = *(const f32x4*)(onorm + ch);
#pragma unroll
          for (int x = 0; x < 4; ++x) { const int tl = 16 * x + n; float tot = 0.f;
#pragma unroll
            for (int w = 0; w < 8; ++w) tot += RED[w * 64 + tl];
            const float rs = rsqrtf(tot * (1.0f / HD) + RMS_EPS); const size_t o = (size_t)(t0 + tl) * W_ + ch; const v2u gw = gpre[x];
            v2u w; w.x = cvtpk(acc[x][0] * rs * on[0] * siluf_(bflo(gw.x)), acc[x][1] * rs * on[1] * siluf_(bfhi(gw.x))); w.y = cvtpk(acc[x][2] * rs * on[2] * siluf_(bflo(gw.y)), acc[x][3] * rs * on[3] * siluf_(bfhi(gw.y)));
            *(v2u*)(br + o) = w; } }
    }
    __syncthreads();
#undef H3_FETCH
}
template <int D> __device__ __forceinline__ float dpp_shr(float v, float old) { return __builtin_bit_cast(float, __builtin_amdgcn_update_dpp(__builtin_bit_cast(int, old), __builtin_bit_cast(int, v), 0x110 | D, 0xf, 0xf, false)); }
template <int D> __device__ __forceinline__ float dpp_shl(float v, float old) { return __builtin_bit_cast(float, __builtin_amdgcn_update_dpp(__builtin_bit_cast(int, old), __builtin_bit_cast(int, v), 0x100 | D, 0xf, 0xf, false)); }
template <bool BWD, int D> __device__ __forceinline__ void scan_step(float& av, float& uv) { const float al = BWD ? dpp_shl<D>(av, 1.0f) : dpp_shr<D>(av, 1.0f), ul = BWD ? dpp_shl<D>(uv, 0.0f) : dpp_shr<D>(uv, 0.0f); uv = av * ul + uv; av = al * av; }
template <bool FINAL>
__device__ __forceinline__ void ph_lru(const Args& a, unsigned char* ws, LAS unsigned char* lds, int L, int bid, int nb, int tid, int wave, int lane) {
    const bf16* zx = (const bf16*)(ws + WS_Z) + 5 * SEG; const bf16* zg = (const bf16*)(ws + WS_Z) + 6 * SEG; bf16* br = (bf16*)(ws + WS_BR) + SEG;
    const bf16* LW = (const bf16*)(ws + WS_LRUW); float2* LSUM = (float2*)(ws + WS_LSUM); const float* LCIN = (const float*)(ws + WS_LCIN);
    LAS bf16* XT = (LAS bf16*)lds; LAS bf16* XCB = (LAS bf16*)(lds + 19040); LAS float* CW = (LAS float*)(lds + 36448);
    const int tr = tid >> 3, c0 = (tid & 7) * 16, n = lane & 15, G = lane >> 4;
    if (bid >= 256 * NHEAD) return;
    const bool fixed_head = (nb & 7) == 0;
#define LRU_LOAD_PARAMS(hh_) do { for (int q = tid; q < 2 * 8 * 128; q += NTHR) { const int dir_ = q >> 10, j_ = (q >> 7) & 7, c_ = q & 127, ch_ = (hh_) * HD + c_, pi_ = (L * 2 + dir_) * W_ + ch_; float v_; \
            if (j_ < 4) v_ = a.lru_conv_w[((size_t)(L * 2 + dir_) * 4 + j_) * W_ + ch_]; else if (j_ == 4) v_ = a.lru_conv_b[pi_]; else if (j_ == 5) v_ = a.lru_ba[pi_]; else if (j_ == 6) v_ = a.lru_bx[pi_]; else v_ = log1pf(__expf(-a.lru_lambda[pi_])); \
            CW[q] = v_; } } while (0)
    if (fixed_head) LRU_LOAD_PARAMS(bid & 7);
    v4u xpre[3];
#define LRU_FETCH_X(item_) do { const int tile_ = (item_) >> 3, hh_ = (item_) & 7, t0_ = tile_ * 64; \
        _Pragma("unroll") for (int p = 0; p < 3; ++p) { const int q = tid + p * NTHR, row = q >> 4, c = q & 15, t = t0_ - 3 + row; xpre[p] = (v4u){0u, 0u, 0u, 0u}; \
            if (q < 70 * 16 && t >= 0 && t < S_) xpre[p] = *(const v4u*)(zx + (size_t)t * W_ + hh_ * HD + 8 * c); } } while (0)
    LRU_FETCH_X(bid);
    for (int item = bid; item < 256 * NHEAD; item += nb) { const int tile = item >> 3, hh = item & 7, t0 = tile * 64;
        if (!fixed_head) { __syncthreads(); LRU_LOAD_PARAMS(hh); }
#pragma unroll
        for (int p = 0; p < 3; ++p) { const int q = tid + p * NTHR, row = q >> 4, c = q & 15; if (q < 70 * 16) *(LAS v4u*)(XT + row * 136 + 8 * c) = xpre[p]; }
        if (item + nb < 256 * NHEAD) LRU_FETCH_X(item + nb);
        const int chl = hh * HD + 16 * wave + 4 * G;
        v2u gpre[4]; f32x4 cin[2];
        if (FINAL) {
#pragma unroll
            for (int tb = 0; tb < 4; ++tb) gpre[tb] = *(const v2u*)(zg + (size_t)(t0 + 16 * tb + n) * W_ + chl);
            cin[0] = *(const f32x4*)(LCIN + (size_t)(tile * 2 + 0) * W_ + chl); cin[1] = *(const f32x4*)(LCIN + (size_t)(tile * 2 + 1) * W_ + chl); }
        __syncthreads();
        f32x4 yacc[4];
#pragma unroll
        for (int tb = 0; tb < 4; ++tb) yacc[tb] = (f32x4){0.f, 0.f, 0.f, 0.f};
#pragma unroll 1
        for (int dir = 0; dir < 2; ++dir) {
            const bf16* wap = LW + ((size_t)((L * 2 + dir) * 8 + hh)) * 16384 + (16 * wave + n) * 128 + 8 * G; const bf16* wxp = wap + (size_t)64 * 16384;
            bf16x8 wA[4], wX[4];
#pragma unroll
            for (int ks = 0; ks < 4; ++ks) { wA[ks] = *(const bf16x8*)(wap + 32 * ks); wX[ks] = *(const bf16x8*)(wxp + 32 * ks); }
            { float xc[16]; const LAS float* cwl = CW + dir * 1024 + c0;
#pragma unroll
              for (int q = 0; q < 4; ++q) { const f32x4 b4 = *(const LAS f32x4*)(cwl + 4 * 128 + 4 * q); xc[4 * q] = b4[0]; xc[4 * q + 1] = b4[1]; xc[4 * q + 2] = b4[2]; xc[4 * q + 3] = b4[3]; }
#pragma unroll
              for (int j = 0; j < 4; ++j) { const int row = dir ? tr + 6 - j : tr + j;
                  const v4u w0 = *(const LAS v4u*)(XT + row * 136 + c0), w1 = *(const LAS v4u*)(XT + row * 136 + c0 + 8); const unsigned ww[8] = {w0.x, w0.y, w0.z, w0.w, w1.x, w1.y, w1.z, w1.w};
#pragma unroll
                  for (int q = 0; q < 4; ++q) { const f32x4 w4 = *(const LAS f32x4*)(cwl + j * 128 + 4 * q);
#pragma unroll
                      for (int e = 0; e < 4; ++e) { const int i = 4 * q + e; xc[i] += w4[e] * ((i & 1) ? bfhi(ww[i >> 1]) : bflo(ww[i >> 1])); } } }
              v4u o0, o1; o0.x = cvtpk(xc[0], xc[1]); o0.y = cvtpk(xc[2], xc[3]); o0.z = cvtpk(xc[4], xc[5]); o0.w = cvtpk(xc[6], xc[7]); o1.x = cvtpk(xc[8], xc[9]); o1.y = cvtpk(xc[10], xc[11]); o1.z = cvtpk(xc[12], xc[13]); o1.w = cvtpk(xc[14], xc[15]);
              *(LAS v4u*)(XCB + tr * 136 + c0) = o0; *(LAS v4u*)(XCB + tr * 136 + c0 + 8) = o1; }
            __syncthreads();
            { f32x4 ar[4], ai[4];
#pragma unroll
              for (int tb = 0; tb < 4; ++tb) { ar[tb] = (f32x4){0.f, 0.f, 0.f, 0.f}; ai[tb] = (f32x4){0.f, 0.f, 0.f, 0.f}; }
#pragma unroll
              for (int ks = 0; ks < 4; ++ks)
#pragma unroll
                  for (int tb = 0; tb < 4; ++tb) { const bf16x8 xf = *(const LAS bf16x8*)(XCB + (16 * tb + n) * 136 + 32 * ks + 8 * G);
                      ar[tb] = __builtin_amdgcn_mfma_f32_16x16x32_bf16(wA[ks], xf, ar[tb], 0, 0, 0); ai[tb] = __builtin_amdgcn_mfma_f32_16x16x32_bf16(wX[ks], xf, ai[tb], 0, 0, 0); }
              const LAS float* pl = CW + dir * 1024 + 16 * wave + 4 * G; const f32x4 ba = *(const LAS f32x4*)(pl + 5 * 128), bx = *(const LAS f32x4*)(pl + 6 * 128), sp = *(const LAS f32x4*)(pl + 7 * 128);
#pragma unroll
              for (int tb = 0; tb < 4; ++tb) { const v2u xw = *(const LAS v2u*)(XCB + (16 * tb + n) * 136 + 16 * wave + 4 * G); const float xv[4] = {bflo(xw.x), bfhi(xw.x), bflo(xw.y), bfhi(xw.y)};
#pragma unroll
                  for (int r = 0; r < 4; ++r) { const float rg = __builtin_amdgcn_rcpf(1.0f + __expf(-(ar[tb][r] + ba[r]))), ig = __builtin_amdgcn_rcpf(1.0f + __expf(-(ai[tb][r] + bx[r]))); const float la = -8.0f * rg * sp[r];
                      const float av = __expf(la); ar[tb][r] = av; ai[tb][r] = sqrtf(fmaxf(1.0f - av * av, 0.0f)) * (ig * xv[r]); } }
#pragma unroll
              for (int tb = 0; tb < 4; ++tb)
#pragma unroll
                  for (int r = 0; r < 4; ++r) { float av = ar[tb][r], uv = ai[tb][r];
                      if (dir == 0) { scan_step<false, 1>(av, uv); scan_step<false, 2>(av, uv); scan_step<false, 4>(av, uv); scan_step<false, 8>(av, uv); }
                      else { scan_step<true, 1>(av, uv); scan_step<true, 2>(av, uv); scan_step<true, 4>(av, uv); scan_step<true, 8>(av, uv); }
                      ar[tb][r] = av; ai[tb][r] = uv; }
              const int lastlane = (lane & 48) | (dir ? 0 : 15);
              f32x4 hc, pc = (f32x4){1.f, 1.f, 1.f, 1.f};
              if (FINAL) hc = dir ? cin[1] : cin[0]; else hc = (f32x4){0.f, 0.f, 0.f, 0.f};
#pragma unroll
              for (int s = 0; s < 4; ++s) { const int tb = dir ? 3 - s : s;
                  { f32x4 at;
#pragma unroll
                  for (int r = 0; r < 4; ++r) { const float h = ar[tb][r] * hc[r] + ai[tb][r]; yacc[tb][r] += h; hc[r] = mk_bperm(lastlane, h);
                      if (!FINAL) { at[r] = ar[tb][r] * pc[r]; pc[r] = mk_bperm(lastlane, at[r]); } }
                  if (!FINAL) { v2u w; w.x = cvtpk(at[0], at[1]); w.y = cvtpk(at[2], at[3]); *(v2u*)((bf16*)(ws + (dir ? WS_LAB : WS_LAF)) + (size_t)(t0 + 16 * tb + n) * W_ + chl) = w; } } }
              if (!FINAL && n == 0) {
#pragma unroll
                  for (int r = 0; r < 4; ++r) LSUM[(size_t)(tile * 2 + dir) * W_ + chl + r] = make_float2(pc[r], hc[r]); } }
            __syncthreads();
        }
        if (!FINAL) {
#pragma unroll
            for (int tb = 0; tb < 4; ++tb) { v2u w; w.x = cvtpk(yacc[tb][0], yacc[tb][1]); w.y = cvtpk(yacc[tb][2], yacc[tb][3]); *(v2u*)((bf16*)(ws + WS_LSU) + (size_t)(t0 + 16 * tb + n) * W_ + chl) = w; } }
        if (FINAL) {
#pragma unroll
            for (int tb = 0; tb < 4; ++tb) { const size_t o = (size_t)(t0 + 16 * tb + n) * W_ + chl; const v2u gw = gpre[tb];
                v2u w; w.x = cvtpk(yacc[tb][0] * gelu_tanh(bflo(gw.x)), yacc[tb][1] * gelu_tanh(bfhi(gw.x))); w.y = cvtpk(yacc[tb][2] * gelu_tanh(bflo(gw.y)), yacc[tb][3] * gelu_tanh(bfhi(gw.y)));
                *(v2u*)(br + o) = w; } }
    }
    __syncthreads();
}

__device__ __forceinline__ void ph_lru_out(unsigned char* ws, int bid, int nb, int tid) {
    const bf16* SU = (const bf16*)(ws + WS_LSU); const bf16* AF = (const bf16*)(ws + WS_LAF); const bf16* AB = (const bf16*)(ws + WS_LAB); const float* LCIN = (const float*)(ws + WS_LCIN);
    const bf16* zg = (const bf16*)(ws + WS_Z) + 6 * SEG; bf16* br = (bf16*)(ws + WS_BR) + SEG;
#pragma unroll 4
    for (size_t i = (size_t)bid * NTHR + tid; i < SEG / 8; i += (size_t)nb * NTHR) { const size_t e = i * 8; const int t = (int)(e >> 10), ch = (int)(e & (W_ - 1)), tile = t >> 6;
        const v4u su = __builtin_nontemporal_load((const v4u*)(SU + e)), af = __builtin_nontemporal_load((const v4u*)(AF + e)), ab = __builtin_nontemporal_load((const v4u*)(AB + e)), gw = __builtin_nontemporal_load((const v4u*)(zg + e));
        const f32x4 hf0 = *(const f32x4*)(LCIN + (size_t)(tile * 2) * W_ + ch), hf1 = *(const f32x4*)(LCIN + (size_t)(tile * 2) * W_ + ch + 4), hb0 = *(const f32x4*)(LCIN + (size_t)(tile * 2 + 1) * W_ + ch), hb1 = *(const f32x4*)(LCIN + (size_t)(tile * 2 + 1) * W_ + ch + 4);
        float s[8], f[8], b[8], g[8]; unpack8(su, s); unpack8(af, f); unpack8(ab, b); unpack8(gw, g);
        const float hf[8] = {hf0[0], hf0[1], hf0[2], hf0[3], hf1[0], hf1[1], hf1[2], hf1[3]}, hb[8] = {hb0[0], hb0[1], hb0[2], hb0[3], hb1[0], hb1[1], hb1[2], hb1[3]};
        float y[8];
#pragma unroll
        for (int j = 0; j < 8; ++j) y[j] = (s[j] + f[j] * hf[j] + b[j] * hb[j]) * gelu_tanh(g[j]);
        v4u o; o.x = cvtpk(y[0], y[1]); o.y = cvtpk(y[2], y[3]); o.z = cvtpk(y[4], y[5]); o.w = cvtpk(y[6], y[7]);
        *(v4u*)(br + e) = o; }
}
__device__ __forceinline__ void ph_lru_carry(unsigned char* ws, LAS unsigned char* lds, int bid, int tid, int wave, int lane) {
    if (bid >= 32) return;
    const int chain = bid * 64 + lane, dir = chain >> 10, ch = chain & (W_ - 1), seg = wave; const float2* LSUM = (const float2*)(ws + WS_LSUM); float* LCIN = (float*)(ws + WS_LCIN);
    LAS f32x2_t* SEGS = (LAS f32x2_t*)lds;
    float2 sv[32];
#pragma unroll
    for (int i = 0; i < 32; ++i) { const int kp = 32 * seg + i, k = dir ? 255 - kp : kp; sv[i] = LSUM[(size_t)(k * 2 + dir) * W_ + ch]; }
    float p = 1.f, h = 0.f;
#pragma unroll
    for (int i = 0; i < 32; ++i) { h = sv[i].x * h + sv[i].y; p *= sv[i].x; }
    SEGS[seg * 64 + lane] = (f32x2_t){p, h};
    __syncthreads();
    float c = 0.f;
#pragma unroll
    for (int s = 0; s < 7; ++s) { if (s < seg) { const f32x2_t q = SEGS[s * 64 + lane]; c = q[0] * c + q[1]; } }
#pragma unroll
    for (int i = 0; i < 32; ++i) { const int kp = 32 * seg + i, k = dir ? 255 - kp : kp; LCIN[(size_t)(k * 2 + dir) * W_ + ch] = c; c = sv[i].x * c + sv[i].y; }
    __syncthreads();
}
__device__ __forceinline__ void ph_pool(const Args& a, unsigned char* ws, LAS unsigned char* lds, int L, int bid, int nb, int tid, int wave, int lane) {
    const bf16* zp = (const bf16*)(ws + WS_Z) + 7 * SEG; bf16* br = (bf16*)(ws + WS_BR) + 2 * SEG; const bf16* PW = (const bf16*)(ws + WS_POOLW);
    LAS bf16* XP = (LAS bf16*)lds; LAS bf16* DT = (LAS bf16*)(lds + 42240);
    const int tr = tid >> 3, c0 = (tid & 7) * 32, n = lane & 15, G = lane >> 4;
    for (int item = bid; item < 256 * 4; item += nb) { const int tile = item >> 2, gi = item & 3, t0 = tile * 64, w2 = 1 << gi;
        for (int q = tid; q < 80 * 32; q += NTHR) { const int row = q >> 5, c = q & 31, t = t0 - 8 + row; v4u v = (v4u){0u, 0u, 0u, 0u};
            if (t >= 0 && t < S_) v = *(const v4u*)(zp + (size_t)t * W_ + gi * 256 + 8 * c);
            *(LAS v4u*)(XP + row * 264 + 8 * c) = v; }
        __syncthreads();
        { const int t = t0 + tr, lo = max(t - w2, 0), hi = min(t + w2, S_); const float ic = 1.0f / (float)(hi - lo); float sm[32];
#pragma unroll
          for (int i = 0; i < 32; ++i) sm[i] = 0.f;
          for (int tt = lo; tt < hi; ++tt) { const LAS bf16* xr = XP + (tt - t0 + 8) * 264 + c0;
#pragma unroll
              for (int q = 0; q < 4; ++q) { const v4u w = *(const LAS v4u*)(xr + 8 * q);
                  sm[8 * q + 0] += bflo(w.x); sm[8 * q + 1] += bfhi(w.x); sm[8 * q + 2] += bflo(w.y); sm[8 * q + 3] += bfhi(w.y); sm[8 * q + 4] += bflo(w.z); sm[8 * q + 5] += bfhi(w.z); sm[8 * q + 6] += bflo(w.w); sm[8 * q + 7] += bfhi(w.w); } }
          const LAS bf16* xs = XP + (tr + 8) * 264 + c0;
#pragma unroll
          for (int q = 0; q < 4; ++q) { const v4u w = *(const LAS v4u*)(xs + 8 * q); v4u o;
              o.x = cvtpk(sm[8 * q + 0] * ic - bflo(w.x), sm[8 * q + 1] * ic - bfhi(w.x)); o.y = cvtpk(sm[8 * q + 2] * ic - bflo(w.y), sm[8 * q + 3] * ic - bfhi(w.y));
              o.z = cvtpk(sm[8 * q + 4] * ic - bflo(w.z), sm[8 * q + 5] * ic - bfhi(w.z)); o.w = cvtpk(sm[8 * q + 6] * ic - bflo(w.w), sm[8 * q + 7] * ic - bfhi(w.w));
              *(LAS v4u*)(DT + tr * 264 + c0 + 8 * q) = o; } }
        __syncthreads();
        { f32x4 acc[2][4];
#pragma unroll
          for (int x = 0; x < 2; ++x)
#pragma unroll
              for (int y = 0; y < 4; ++y) acc[x][y] = (f32x4){0.f, 0.f, 0.f, 0.f};
          const bf16* wp = PW + ((size_t)(L * 4 + gi) * 256 + 32 * wave + n) * 256 + 8 * G;
#pragma unroll
          for (int ks = 0; ks < 8; ++ks) { const bf16x8 a0 = *(const bf16x8*)(wp + 32 * ks), a1 = *(const bf16x8*)(wp + 16 * 256 + 32 * ks);
#pragma unroll
              for (int y = 0; y < 4; ++y) { const bf16x8 bf = *(const LAS bf16x8*)(DT + (16 * y + n) * 264 + 32 * ks + 8 * G);
                  acc[0][y] = __builtin_amdgcn_mfma_f32_16x16x32_bf16(a0, bf, acc[0][y], 0, 0, 0); acc[1][y] = __builtin_amdgcn_mfma_f32_16x16x32_bf16(a1, bf, acc[1][y], 0, 0, 0); } }
#pragma unroll
          for (int x = 0; x < 2; ++x) { const int ch = gi * 256 + 32 * wave + 16 * x + 4 * G; const f32x4 sc = *(const f32x4*)(a.pool_scale + L * W_ + ch);
#pragma unroll
              for (int y = 0; y < 4; ++y) { const f32x4 o = acc[x][y] * sc; v2u w; w.x = cvtpk(o[0], o[1]); w.y = cvtpk(o[2], o[3]); *(v2u*)(br + (size_t)(t0 + 16 * y + n) * W_ + ch) = w; } } }
        __syncthreads();
    }
}
__device__ __forceinline__ void ph_merge(const Args& a, int bid, int nb, int tid) {
    const bf16* zg = (const bf16*)(a.ws + WS_ZG); const bf16* P = (const bf16*)(a.ws + WS_P); bf16* mg = (bf16*)(a.ws + WS_MERGED);
    for (size_t i = (size_t)bid * NTHR + tid; i < (size_t)S_ * (D_ / 8); i += (size_t)nb * NTHR) { const int t = (int)(i >> 8), c8 = (int)(i & 255) * 8; float acc[8];
#pragma unroll
        for (int j = 0; j < 8; ++j) acc[j] = 0.f;
#pragma unroll
        for (int g = 0; g < 4; ++g) { const v4u gw = *(const v4u*)(zg + (size_t)t * 4 * D_ + g * D_ + c8), pw = *(const v4u*)(P + (size_t)g * S_ * D_ + (size_t)t * D_ + c8);
            acc[0] += sigmoidf_(bflo(gw.x)) * bflo(pw.x); acc[1] += sigmoidf_(bfhi(gw.x)) * bfhi(pw.x); acc[2] += sigmoidf_(bflo(gw.y)) * bflo(pw.y); acc[3] += sigmoidf_(bfhi(gw.y)) * bfhi(pw.y);
            acc[4] += sigmoidf_(bflo(gw.z)) * bflo(pw.z); acc[5] += sigmoidf_(bfhi(gw.z)) * bfhi(pw.z); acc[6] += sigmoidf_(bflo(gw.w)) * bflo(pw.w); acc[7] += sigmoidf_(bfhi(gw.w)) * bfhi(pw.w); }
        v4u o; o.x = pk2(acc[0], acc[1]); o.y = pk2(acc[2], acc[3]); o.z = pk2(acc[4], acc[5]); o.w = pk2(acc[6], acc[7]);
        *(v4u*)(mg + (size_t)t * D_ + c8) = o; }
}
__device__ __forceinline__ void ph_convact(const Args& a, unsigned char* ws, int L, int bid, int nb, int tid) {
    const bf16* u = (const bf16*)(ws + WS_Z); bf16* act = (bf16*)(ws + WS_P);
    const float* cw = a.ffn_conv_w + (size_t)L * 3 * FF2; const float* cbp = a.ffn_conv_b + (size_t)L * FF2;
    constexpr int G8 = FF / 8, ROWS = 87;
    for (int g = bid * NTHR + tid; g < G8 * 190; g += nb * NTHR) { const int cg = g % G8, strip = g / G8, c8 = cg * 8, r0 = strip * ROWS, r1 = min(r0 + ROWS, S_);
        float wg[3][8], wv[3][8], bg[8], bv[8];
#pragma unroll
        for (int k = 0; k < 3; ++k) { const f32x4 x0 = *(const f32x4*)(cw + k * FF2 + c8), x1 = *(const f32x4*)(cw + k * FF2 + c8 + 4), y0 = *(const f32x4*)(cw + k * FF2 + FF + c8), y1 = *(const f32x4*)(cw + k * FF2 + FF + c8 + 4);
#pragma unroll
            for (int j = 0; j < 4; ++j) { wg[k][j] = x0[j]; wg[k][4 + j] = x1[j]; wv[k][j] = y0[j]; wv[k][4 + j] = y1[j]; } }
        { const f32x4 x0 = *(const f32x4*)(cbp + c8), x1 = *(const f32x4*)(cbp + c8 + 4), y0 = *(const f32x4*)(cbp + FF + c8), y1 = *(const f32x4*)(cbp + FF + c8 + 4);
#pragma unroll
          for (int j = 0; j < 4; ++j) { bg[j] = x0[j]; bg[4 + j] = x1[j]; bv[j] = y0[j]; bv[4 + j] = y1[j]; } }
        const v4u zero = (v4u){0u, 0u, 0u, 0u};
        const bf16* up = u + c8;
#define LDROW(t, G, V) do { if ((t) >= 0 && (t) < S_) { G = *(const v4u*)(up + (size_t)(t) * FF2); V = *(const v4u*)(up + (size_t)(t) * FF2 + FF); } else { G = zero; V = zero; } } while (0)
        v4u gp, vp, gc, vc, gn, vn, g2, v2, g3, v3;
        LDROW(r0 - 1, gp, vp); LDROW(r0, gc, vc); LDROW(r0 + 1, gn, vn); LDROW(r0 + 2, g2, v2); LDROW(r0 + 3, g3, v3);
        for (int t = r0; t < r1; ++t) {
            v4u g4, v4; LDROW(t + 4, g4, v4);
            float gpf[8], gcf[8], gnf[8], vpf[8], vcf[8], vnf[8]; unpack8(gp, gpf); unpack8(gc, gcf); unpack8(gn, gnf); unpack8(vp, vpf); unpack8(vc, vcf); unpack8(vn, vnf);
            float o[8];
#pragma unroll
            for (int j = 0; j < 8; ++j) { const float gt = bg[j] + wg[0][j] * gpf[j] + wg[1][j] * gcf[j] + wg[2][j] * gnf[j], vl = bv[j] + wv[0][j] * vpf[j] + wv[1][j] * vcf[j] + wv[2][j] * vnf[j];
                o[j] = gt * __builtin_amdgcn_rcpf(1.0f + __expf(-gt)) * vl; }
            v4u ow; ow.x = cvtpk(o[0], o[1]); ow.y = cvtpk(o[2], o[3]); ow.z = cvtpk(o[4], o[5]); ow.w = cvtpk(o[6], o[7]);
            *(v4u*)(act + (size_t)t * FF + c8) = ow;
            gp = gc; vp = vc; gc = gn; vc = vn; gn = g2; vn = v2; g2 = g3; v2 = v3; g3 = g4; v3 = v4; }
#undef LDROW
    }
}


__device__ __forceinline__ void ph_convfix(const Args& a, unsigned char* ws, int L, int bid, int nb, int tid) {
    const bf16* RAW = (const bf16*)(ws + WS_RAW); bf16* act = (bf16*)(ws + WS_P);
    const float* cw = a.ffn_conv_w + (size_t)L * 3 * FF2; const float* cbp = a.ffn_conv_b + (size_t)L * FF2;
    for (int i = bid * NTHR + tid; i < 65 * 2 * FF; i += nb * NTHR) { const int c = i % FF, rb = i / FF, b = rb >> 1, r = 256 * b - 1 + (rb & 1);
        if (r < 0 || r >= S_) continue;
        const int pn = c >> 7, cc = c & 127; float ug = cbp[c], uv = cbp[FF + c];
#pragma unroll
        for (int k = 0; k < 3; ++k) { const int t = r + k - 1; if (t < 0 || t >= S_) continue; const int tl = t & 255, ri = tl < 2 ? tl : tl - 252;
            const bf16* rp = RAW + (((size_t)(t >> 8) * 4 + ri) * 43 + pn) * 256 + cc; ug += cw[k * FF2 + c] * bf2f(rp[0]); uv += cw[k * FF2 + FF + c] * bf2f(rp[128]); }
        act[(size_t)r * FF + c] = (bf16)f2bf(siluf_(ug) * uv); }
}
constexpr int NPH = 11;
constexpr int NPHASES = 2 + DEPTH * NPH;
__global__ void __launch_bounds__(NTHR, 2) mk_fwd(Args a) {
    extern __shared__ __attribute__((aligned(16))) unsigned char lds_raw[];
    LAS unsigned char* lds = (LAS unsigned char*)lds_raw;
    const int wave_s = __builtin_amdgcn_readfirstlane((int)threadIdx.x >> 6);
    const int lane = mk_lane_id(), wave = wave_s, tid = wave_s * 64 + lane;
    const int bid = blockIdx.x, nb = gridDim.x;
    unsigned char* ws = a.ws;
    volatile LAS unsigned* MISC = (volatile LAS unsigned*)(lds + MISC_OFF);
    for (int u = tid; u < (LDS_BYTES - MISC_OFF) / 4; u += NTHR) ((LAS unsigned*)(lds + MISC_OFF))[u] = 0u;
    __syncthreads();
    XcdBarrier bar; bar.w0 = 0u; bar.bar = (unsigned*)(ws + WS_CTL) + CW_BAR; bar.x = 0; bar.st = nullptr;
    if (!MK_MULTI_LAUNCH) bar = xcd_barrier_post((unsigned*)(ws + WS_CTL) + CW_BAR, MISC + 8);
    bar.w0 = (wave_s == 0) ? 1u : 0u;
    const int lo = a.ph_lo, hi = a.ph_hi;
#define PH_LOCALS() size_t wsoff_ = 0; asm volatile("" : "+s"(wsoff_)); unsigned char* ws = a.ws + wsoff_;     \
    int tid = wave_s * 64 + mk_lane_id(); asm volatile("" : "+v"(tid)); const int lane = tid & 63, wave = __builtin_amdgcn_readfirstlane(tid >> 6); int bid = blockIdx.x, nb = gridDim.x; asm volatile("" : "+s"(bid), "+s"(nb)); (void)ws; (void)lane; (void)wave; (void)tid
#define IN(k) (lo <= (k) && (k) < hi)
#define SEAM(k) do { if (IN((k) + 1)) xcd_barrier(bar); } while (0)

    if (IN(0)) { PH_LOCALS(); ph_prologue(a, lds, bid, nb, tid, wave, lane); SEAM(0); }
    if (IN(1)) { PH_LOCALS(); ph_resnorm<false>(a, lds, bid, nb, tid, wave, lane, a.x, nullptr, nullptr, (bf16*)(ws + WS_H), 0, 0, 0, 0, 0, 1, 0); SEAM(1); }

    for (int L = 0; L < DEPTH; ++L) {
        const int pb = 2 + L * NPH;
        if (IN(pb + 0)) { PH_LOCALS();
            pg8::Gemm g{(const bf16*)(ws + WS_H), (const bf16*)(ws + WS_WIN) + (size_t)L * NIN * D_, S_, NIN, D_}; pg8::RotOrder so; so.so.init(S_, NIN, nb, bid);
            pg8::EpiZ8 E{(bf16*)(ws + WS_Z), W_, 4, 44, SEG, (bf16*)(ws + WS_ZG), 4 * D_};
            pg8::gemm_phase<pg8::EpiZ8, pg8::RotOrder, true, true>(lds, g, so, E, wave);
            SEAM(pb + 0);
        }
        if (IN(pb + 1)) { PH_LOCALS(); ph_pool(a, ws, lds, L, bid, nb, tid, wave, lane); ph_lru<false>(a, ws, lds, L, bid, nb, tid, wave, lane); ph_hgrn_h1(ws, lds, L, bid, nb, tid, wave, lane);
            ph_attn_prep(ws, bid, nb, tid); ph_attn_vt(ws, lds, bid, nb, tid, wave, lane); SEAM(pb + 1); }
        if (IN(pb + 2)) { PH_LOCALS(); ph_attn_main(ws, bid, nb, wave, lane); ph_lru_carry(ws, lds, bid, tid, wave, lane); ph_hgrn_h2(ws, bid, nb, tid); SEAM(pb + 2); }
        if (IN(pb + 3)) { PH_LOCALS(); ph_hgrn_h3(ws, lds, a.hgrn_onorm + L * W_, L, bid, nb, tid, wave, lane); ph_lru_out(ws, bid, nb, tid); ph_attn_comb(ws, bid, nb, tid); SEAM(pb + 3); }
        if (IN(pb + 4)) { PH_LOCALS();
            pg8::Gemm g{(const bf16*)(ws + WS_BR), (const bf16*)(ws + WS_WBR) + (size_t)L * 4 * D_ * W_, 4 * S_, 4 * D_, W_}; pg8::GateOrder so; so.so.init(S_, D_, nb, bid);
            pg8::EpiGate E{(const unsigned char*)(ws + WS_ZG), (bf16*)(ws + WS_MERGED)};
            pg8::gemm_phase<pg8::EpiGate, pg8::GateOrder, true, true>(lds, g, so, E, wave);
            SEAM(pb + 4);
        }
        if (IN(pb + 5)) { PH_LOCALS();
            pg8::Gemm g{(const bf16*)(ws + WS_MERGED), (const bf16*)(ws + WS_WOUT) + (size_t)L * D_ * D_, S_, D_, D_}; pg8::StaticOrder so; so.init(S_, D_, nb, bid);
            pg8::EpiBf16R E{(bf16*)(ws + WS_Y), D_, 8, 8, 0, nullptr, 0};
            pg8::gemm_phase<pg8::EpiBf16R, pg8::StaticOrder, true, true>(lds, g, so, E, wave);
            SEAM(pb + 5);
        }
        if (IN(pb + 6)) { PH_LOCALS(); ph_resnorm<true>(a, lds, bid, nb, tid, wave, lane, a.x, a.out, (const bf16*)(ws + WS_Y), (bf16*)(ws + WS_H), L, 2, 1, L, 2, 4, 3, L == 0 ? nullptr : (const bf16*)(ws + WS_XR), (bf16*)(ws + WS_XR)); SEAM(pb + 6); }
        if (IN(pb + 7)) { PH_LOCALS();
            pg8::Gemm g{(const bf16*)(ws + WS_H), (const bf16*)(ws + WS_WUP) + (size_t)L * FF2 * D_, S_, FF2, D_}; pg8::StaticOrder so; so.init(S_, FF2, nb, bid);
            pg8::EpiConvAct E{(bf16*)(ws + WS_P), (bf16*)(ws + WS_RAW), (const float*)(ws + WS_CWT) + (size_t)L * 43 * 8 * 128, (LAS float*)(lds + RING_BYTES)};
            pg8::gemm_phase<pg8::EpiConvAct, pg8::StaticOrder, true, true>(lds, g, so, E, wave);
            SEAM(pb + 7);
        }
        if (IN(pb + 8)) { PH_LOCALS(); ph_convfix(a, ws, L, bid, nb, tid); SEAM(pb + 8); }
        if (IN(pb + 9)) { PH_LOCALS();
            pg8::Gemm g{(const bf16*)(ws + WS_P), (const bf16*)(ws + WS_WDN) + (size_t)L * D_ * FF, S_, D_, FF}; pg8::StaticOrder so; so.init(S_, D_, nb, bid);
            pg8::EpiBf16R E{(bf16*)(ws + WS_Y), D_, 8, 8, 0, nullptr, 0};
            pg8::gemm_phase<pg8::EpiBf16R, pg8::StaticOrder, true, true>(lds, g, so, E, wave);
            SEAM(pb + 9);
        }
        if (IN(pb + 10)) { PH_LOCALS(); ph_resnorm<true>(a, lds, bid, nb, tid, wave, lane, a.x, a.out, (const bf16*)(ws + WS_Y), L + 1 < DEPTH ? (bf16*)(ws + WS_H) : nullptr, L, 5, 3, L + 1 < DEPTH ? L + 1 : L, 0, 1, 0, (const bf16*)(ws + WS_XR), L + 1 < DEPTH ? (bf16*)(ws + WS_XR) : nullptr); SEAM(pb + 10); }
    }
#undef IN
#undef SEAM
}

extern "C" void kernel_launch(void* const* d_in, const int* in_sizes, int n_in, void* d_out, int out_size, void* d_ws, size_t ws_size, hipStream_t stream) {
    static int grid = 0;
    if (grid == 0) {
        if (n_in != 24 || in_sizes[0] != S_ * D_ || out_size != S_ * D_ || ws_size < WS_END) { fprintf(stderr, "kernel_launch: unexpected shapes (n_in %d, in0 %d, out %d, ws %zu < %zu); nothing launched\n", n_in, n_in > 0 ? in_sizes[0] : -1, out_size, ws_size, (size_t)WS_END); grid = -1; return; }
        int dev = 0, cus = 0, per_cu = 0;
        if (hipGetDevice(&dev) != hipSuccess || hipDeviceGetAttribute(&cus, hipDeviceAttributeMultiprocessorCount, dev) != hipSuccess) { grid = -1; return; }
        if (hipFuncSetAttribute((const void*)mk_fwd, hipFuncAttributeMaxDynamicSharedMemorySize, LDS_BYTES) != hipSuccess) { fprintf(stderr, "kernel_launch: hipFuncSetAttribute failed\n"); grid = -1; return; }
        if (hipOccupancyMaxActiveBlocksPerMultiprocessor(&per_cu, (const void*)mk_fwd, NTHR, LDS_BYTES) != hipSuccess || per_cu < 1) fprintf(stderr, "kernel_launch: occupancy query reports %d\n", per_cu);
        (void)hipGetLastError();
        grid = cus;
    }
    if (grid < 0) return;
    if (hipMemsetAsync((char*)d_ws + WS_CTL, 0, CTL_ZERO_BYTES, stream) != hipSuccess) return;
    Args a{};
    a.x = (const float*)d_in[0]; a.c = (const float*)d_in[1]; a.pos = (const int*)d_in[2]; a.ada_w = (const float*)d_in[3]; a.ada_b = (const float*)d_in[4]; a.norm_g = (const float*)d_in[5];
    a.w_in = (const float*)d_in[6]; a.hgrn_lb = (const float*)d_in[7]; a.hgrn_onorm = (const float*)d_in[8]; a.lru_conv_w = (const float*)d_in[9]; a.lru_conv_b = (const float*)d_in[10];
    a.lru_wa = (const float*)d_in[11]; a.lru_ba = (const float*)d_in[12]; a.lru_wx = (const float*)d_in[13]; a.lru_bx = (const float*)d_in[14]; a.lru_lambda = (const float*)d_in[15];
    a.pool_w = (const float*)d_in[16]; a.pool_scale = (const float*)d_in[17]; a.w_branch = (const float*)d_in[18]; a.w_out = (const float*)d_in[19]; a.ffn_up = (const float*)d_in[20];
    a.ffn_conv_w = (const float*)d_in[21]; a.ffn_conv_b = (const float*)d_in[22]; a.ffn_down = (const float*)d_in[23];
    a.out = (float*)d_out; a.ws = (unsigned char*)d_ws;
#if MK_MULTI_LAUNCH
    for (int p = 0; p < NPHASES; ++p) { a.ph_lo = p; a.ph_hi = p + 1; hipLaunchKernelGGL(mk_fwd, dim3(grid), dim3(NTHR), LDS_BYTES, stream, a); }
#else
    a.ph_lo = 0; a.ph_hi = NPHASES; hipLaunchKernelGGL(mk_fwd, dim3(grid), dim3(NTHR), LDS_BYTES, stream, a);
#endif
}
```

```cpp
#include <hip/hip_runtime.h>
#include <cstdio>
#include <cstdint>
#ifndef MK_MULTI_LAUNCH
#define MK_MULTI_LAUNCH 0
#endif
#ifndef GATE_EXP
#define GATE_EXP 0
#endif
__device__ __forceinline__ int mk_lane_id() { int l; asm volatile("v_mbcnt_lo_u32_b32 %0, -1, 0\n\tv_mbcnt_hi_u32_b32 %0, -1, %0" : "=v"(l)); return l; }
#define GAS __attribute__((address_space(1)))
#define LAS __attribute__((address_space(3)))
namespace pg8 {
#define PG8_LAS __attribute__((address_space(3)))
typedef unsigned short bf16_t;
typedef short bf16x8 __attribute__((ext_vector_type(8)));
typedef float f32x4 __attribute__((ext_vector_type(4)));
typedef unsigned u32x4 __attribute__((ext_vector_type(4)));
constexpr int BM = 256, BK = 64, HALF = 128, HTB = HALF * BK * 2  , STAGE_BYTES = 8 * HTB, NXCD = 8, WGM = 8;

__host__ __device__ __forceinline__ int lds_byte(int r, int c) { const int st = (r >> 4) * 2 + (c >> 5), rr = r & 15, cc = c & 31, ob = rr * 64 + cc * 2; return st * 1024 + (ob ^ (((ob >> 9) & 1) << 5)); }
__host__ __device__ __forceinline__ void stage_rc(int b, int& R, int& C) { const int st = b / 1024, sb = b % 1024, swz = sb ^ (((sb >> 9) & 1) << 5); R = (st >> 1) * 16 + swz / 64; C = (st & 1) * 32 + (swz % 64) / 2; }
__host__ __device__ __forceinline__ int perm32(int rho) { const int n = rho >> 4, i = rho & 15; return 8 * (i >> 2) + 4 * n + (i & 3); }

struct Unit { int pm, pn; };
struct Gemm { const bf16_t* A; const bf16_t* Bt; int M, N, K; };

struct StaticOrder {
    int nM, nN, nwg, G, c;
    __host__ __device__ void init(int M, int N, int G_, int c_) { nM = M / BM; nN = N / BM; nwg = nM * nN; G = G_; c = c_; }
    __host__ __device__ bool next(int i, Unit& u) const {
        const long L = (long)i * G + c; if (L >= nwg) return false;
        int wgid = (int)L; { const int q = nwg / NXCD, r = nwg % NXCD, xcd = wgid % NXCD, off = wgid / NXCD; wgid = (xcd < r ? xcd * (q + 1) : r * (q + 1) + (xcd - r) * q) + off; }
        const int nig = WGM * nN, gid = wgid / nig, fm = gid * WGM, gsz = (nM - fm) < WGM ? (nM - fm) : WGM;
        u.pm = fm + ((wgid % nig) % gsz); u.pn = (wgid % nig) / gsz; return true;
    }
    __device__ __forceinline__ void a_ready(const Unit&) const {}
    __device__ __forceinline__ void done(const Unit&) const {}
};

typedef __bf16 bf16x2_t __attribute__((ext_vector_type(2)));
typedef float f32x2_t __attribute__((ext_vector_type(2)));
__device__ __forceinline__ unsigned cvt_pk_bf16(float lo, float hi) { const f32x2_t v = {lo, hi}; return __builtin_bit_cast(unsigned, __builtin_convertvector(v, bf16x2_t)); }

struct EpiBf16R {
    static constexpr bool PERM = true, AFTER_DRAIN = false, INPLACE = false;
    bf16_t* O; int ldc_seg; int tiles_per_seg; int nseg_tiles; size_t seg_stride; bf16_t* O2; int ldc2;
    __device__ __forceinline__ void operator()(const f32x4 (&acc)[2][2][4][2], const Unit& u, int wr, int wc, int fr, int fq) const {
        const int row0 = u.pm * BM + wr * 64 + fr; bf16_t* base; int ldc, colt;
        if (u.pn < nseg_tiles) { const int sg = u.pn / tiles_per_seg; base = O + (size_t)sg * seg_stride; ldc = ldc_seg; colt = (u.pn - sg * tiles_per_seg) * BM; }
        else { base = O2; ldc = ldc2; colt = (u.pn - nseg_tiles) * BM; }
        const int col0 = colt + wc * 32 + 8 * fq;
#pragma unroll
        for (int ai = 0; ai < 2; ++ai)
#pragma unroll
            for (int m = 0; m < 4; ++m) { bf16_t* rowp = base + (size_t)(row0 + ai * HALF + m * 16) * ldc + col0;
#pragma unroll
                for (int bj = 0; bj < 2; ++bj) { const f32x4 v0 = acc[ai][bj][m][0], v1 = acc[ai][bj][m][1];
                    u32x4 w; w.x = cvt_pk_bf16(v0[0], v0[1]); w.y = cvt_pk_bf16(v0[2], v0[3]); w.z = cvt_pk_bf16(v1[0], v1[1]); w.w = cvt_pk_bf16(v1[2], v1[3]);
                    *(u32x4*)(rowp + bj * HALF) = w; } }
    }
};
struct EpiZ8 {
    static constexpr bool PERM = true, AFTER_DRAIN = false, INPLACE = false;
    bf16_t* O; int ldc_seg; int tiles_per_seg; int nseg_tiles; size_t seg_stride; bf16_t* O2; int ldc2;
    __device__ __forceinline__ void operator()(const f32x4 (&acc)[2][2][4][2], const Unit& u, int wr, int wc, int fr, int fq) const {
        const int row0 = u.pm * BM + wr * 64 + fr; bf16_t* base; int ldc, colt;
        if (u.pn < nseg_tiles) { const int sg = u.pn / tiles_per_seg; base = O + (size_t)sg * seg_stride; ldc = ldc_seg; colt = (u.pn - sg * tiles_per_seg) * BM; }
        else { base = O2; ldc = ldc2; colt = (u.pn - nseg_tiles) * BM; }
        const int col0 = colt + wc * 32 + 8 * fq;
        if (u.pn >= nseg_tiles) {
            unsigned char* gb = (unsigned char*)O2;
#pragma unroll
            for (int ai = 0; ai < 2; ++ai)
#pragma unroll
                for (int m = 0; m < 4; ++m) { unsigned char* rowp = gb + (size_t)(u.pm * 32 + (u.pn - nseg_tiles)) * 65536 + (unsigned)(((wr * 4 + wc) * 64 + fq * 16 + fr) * 8);
#pragma unroll
                    for (int bj = 0; bj < 2; ++bj) { unsigned w2[2];
#pragma unroll
                        for (int hh = 0; hh < 2; ++hh) { const f32x4 v = acc[ai][bj][m][hh]; unsigned q = 0;
#pragma unroll
                            for (int j = 0; j < 4; ++j) q |= (unsigned)max((int)(255.0f * __builtin_amdgcn_rcpf(1.0f + __expf(-v[j])) + 0.5f), 1) << (8 * j);
                            w2[hh] = q; }
                        typedef unsigned u32x2 __attribute__((ext_vector_type(2))); u32x2 w; w.x = w2[0]; w.y = w2[1];
                        *(u32x2*)(rowp + ((ai * 4 + m) * 2 + bj) * 4096) = w; } }
            return; }
#pragma unroll
        for (int ai = 0; ai < 2; ++ai)
#pragma unroll
            for (int m = 0; m < 4; ++m) { bf16_t* rowp = base + (size_t)(row0 + ai * HALF + m * 16) * ldc + col0;
#pragma unroll
                for (int bj = 0; bj < 2; ++bj) { const f32x4 v0 = acc[ai][bj][m][0], v1 = acc[ai][bj][m][1];
                    u32x4 w; w.x = cvt_pk_bf16(v0[0], v0[1]); w.y = cvt_pk_bf16(v0[2], v0[3]); w.z = cvt_pk_bf16(v1[0], v1[1]); w.w = cvt_pk_bf16(v1[2], v1[3]);
                    *(u32x4*)(rowp + bj * HALF) = w; } }
    }
};

struct RotOrder { StaticOrder so;
    __device__ __forceinline__ bool next(int i, Unit& u) const { if (!so.next(i, u)) return false; u.pn = (u.pn < 32) ? u.pn + 44 : u.pn - 32; return true; }
    __device__ __forceinline__ void a_ready(const Unit&) const {}
    __device__ __forceinline__ void done(const Unit&) const {}
};
struct GateOrder { StaticOrder so;
    __device__ __forceinline__ bool next(int i, Unit& u) const { Unit t; if (!so.next(i >> 2, t)) return false; const int g = i & 3; u.pm = g * 64 + t.pm; u.pn = g * 8 + t.pn; return true; }
    __device__ __forceinline__ void a_ready(const Unit&) const {}
    __device__ __forceinline__ void done(const Unit&) const {}
};
struct EpiGate {
    static constexpr bool PERM = true, AFTER_DRAIN = false, INPLACE = true;
    const unsigned char* ZG; bf16_t* MG;
    static __device__ __forceinline__ bool keep(const Unit& u) { return (u.pn >> 3) < 3; }
    __device__ __forceinline__ void operator()(f32x4 (&acc)[2][2][4][2], const Unit& u, int wr, int wc, int fr, int fq) const {
        typedef unsigned u32x2 __attribute__((ext_vector_type(2)));
        const int g = u.pn >> 3, pn0 = u.pn & 7, pm0 = u.pm - g * 64;
        const unsigned tix = (unsigned)((wr * 4 + wc) * 64 + fq * 16 + fr);
        const unsigned char* gtile = ZG + (size_t)(pm0 * 32 + g * 8 + pn0) * 65536 + tix * 8;
        if (g < 3) { u32x2 gwa[2][4][2], gna[2][4][2];
#pragma unroll
            for (int ai = 0; ai < 2; ++ai)
#pragma unroll
                for (int m = 0; m < 4; ++m)
#pragma unroll
                    for (int bj = 0; bj < 2; ++bj) { gwa[ai][m][bj] = *(const u32x2*)(gtile + ((ai * 4 + m) * 2 + bj) * 4096); gna[ai][m][bj] = *(const u32x2*)(gtile + 8 * 65536 + ((ai * 4 + m) * 2 + bj) * 4096); }
#pragma unroll
            for (int ai = 0; ai < 2; ++ai) { const u32x2 (&gw)[4][2] = gwa[ai]; const u32x2 (&gn)[4][2] = gna[ai];
#pragma unroll
                for (int m = 0; m < 4; ++m)
#pragma unroll
                    for (int bj = 0; bj < 2; ++bj)
#pragma unroll
                        for (int j = 0; j < 4; ++j) { const unsigned gword = (j < 2) ? gw[m][bj].x : gw[m][bj].y, nword = (j < 2) ? gn[m][bj].x : gn[m][bj].y; const int sh = 16 * (j & 1);
                            const float r0 = (float)((gword >> sh) & 0xffu) * __builtin_amdgcn_rcpf((float)((nword >> sh) & 0xffu)), r1 = (float)((gword >> (sh + 8)) & 0xffu) * __builtin_amdgcn_rcpf((float)((nword >> (sh + 8)) & 0xffu));
                            if (j < 2) { acc[ai][bj][m][0][2 * j] *= r0; acc[ai][bj][m][0][2 * j + 1] *= r1; } else { acc[ai][bj][m][1][2 * j - 4] *= r0; acc[ai][bj][m][1][2 * j - 3] *= r1; } } }
        } else {
            const int row0 = pm0 * BM + wr * 64 + fr, col0 = pn0 * BM + wc * 32 + 8 * fq;
#pragma unroll
            for (int ai = 0; ai < 2; ++ai) { u32x2 gw[4][2];
#pragma unroll
                for (int m = 0; m < 4; ++m)
#pragma unroll
                    for (int bj = 0; bj < 2; ++bj) gw[m][bj] = *(const u32x2*)(gtile + ((ai * 4 + m) * 2 + bj) * 4096);
#pragma unroll
                for (int m = 0; m < 4; ++m)
#pragma unroll
                    for (int bj = 0; bj < 2; ++bj) { const size_t row = (size_t)(row0 + ai * HALF + m * 16); const int col = col0 + bj * HALF; float v[8];
#pragma unroll
                        for (int j = 0; j < 4; ++j) { const unsigned gword = (j < 2) ? gw[m][bj].x : gw[m][bj].y; const int sh = 16 * (j & 1);
                            const float g0 = (float)((gword >> sh) & 0xffu) * (1.0f / 255.0f), g1 = (float)((gword >> (sh + 8)) & 0xffu) * (1.0f / 255.0f);
                            const float a0 = (j < 2) ? acc[ai][bj][m][0][2 * j] : acc[ai][bj][m][1][2 * j - 4], a1 = (j < 2) ? acc[ai][bj][m][0][2 * j + 1] : acc[ai][bj][m][1][2 * j - 3];
                            v[2 * j] = a0 * g0; v[2 * j + 1] = a1 * g1; }
                        u32x4 w; w.x = cvt_pk_bf16(v[0], v[1]); w.y = cvt_pk_bf16(v[2], v[3]); w.z = cvt_pk_bf16(v[4], v[5]); w.w = cvt_pk_bf16(v[6], v[7]);
                        *(u32x4*)(MG + row * 2048 + col) = w; } }
        }
    }
};

template <int ROT> __device__ __forceinline__ float dpp_ror(float v) { return __builtin_bit_cast(float, __builtin_amdgcn_update_dpp(0, __builtin_bit_cast(int, v), 0x120 | ROT, 0xf, 0xf, true)); }
struct EpiConvAct {
    static constexpr bool PERM = true, AFTER_DRAIN = false, INPLACE = false;
    bf16_t* ACT; bf16_t* RAW; const float* cwt; PG8_LAS float* XA;
    __device__ __forceinline__ void operator()(const f32x4 (&acc)[2][2][4][2], const Unit& u, int wr, int wc, int fr, int fq) const {
        const int FFc = 5504;
        PG8_LAS float* CW = XA + 2048;
        { const int t8 = ((wr * 4 + wc) * 64 + fq * 16 + fr) * 2; typedef float f32x2l __attribute__((ext_vector_type(2)));
          const f32x2l v = *(const f32x2l*)(cwt + (unsigned)(u.pn * 1024 + t8)); *(PG8_LAS f32x2l*)(CW + t8) = v; }
#pragma unroll
        for (int ai = 0; ai < 2; ++ai) { PG8_LAS float* xs = XA + (((ai * 2 + wr) * 4 + wc) * 2) * 64 + fq * 8;
            if (fr == 0) {
#pragma unroll
                for (int bj = 0; bj < 2; ++bj) { *(PG8_LAS f32x4*)(xs + bj * 32) = acc[ai][bj][0][0]; *(PG8_LAS f32x4*)(xs + bj * 32 + 4) = acc[ai][bj][0][1]; } }
            if (fr == 15) {
#pragma unroll
                for (int bj = 0; bj < 2; ++bj) { *(PG8_LAS f32x4*)(xs + 64 + bj * 32) = acc[ai][bj][3][0]; *(PG8_LAS f32x4*)(xs + 64 + bj * 32 + 4) = acc[ai][bj][3][1]; } } }
        asm volatile("s_waitcnt lgkmcnt(0)" ::: "memory"); __builtin_amdgcn_s_barrier(); asm volatile("" ::: "memory");
        int fqw = fq; asm volatile("" : "+v"(fqw));
        const int chan0 = u.pn * 128 + wc * 32 + fq * 8;
#pragma unroll
        for (int ai = 0; ai < 2; ++ai) {
            const bool has_top = (ai == 1) || (wr == 1), has_bot = (ai == 0) || (wr == 0);
            const int ts = (wr == 1) ? ((ai * 2 + 0) * 4 + wc) * 2 + 1 : (((ai - 1) * 2 + 1) * 4 + wc) * 2 + 1;
            const int bs = (wr == 0) ? ((ai * 2 + 1) * 4 + wc) * 2 + 0 : (((ai + 1) * 2 + 0) * 4 + wc) * 2 + 0;
#pragma unroll
            for (int nn = 0; nn < 2; ++nn) {
                float actv[4][4];
#pragma unroll
                for (int bj = 0; bj < 2; ++bj) {
                    __builtin_amdgcn_sched_barrier(0);
                    const PG8_LAS float* wp = CW + (bj * 512 + wc * 32 + fqw * 8 + 4 * nn);
                    const f32x4 bb = *(const PG8_LAS f32x4*)wp, w0 = *(const PG8_LAS f32x4*)(wp + 128), w1 = *(const PG8_LAS f32x4*)(wp + 256), w2 = *(const PG8_LAS f32x4*)(wp + 384);
                    f32x4 ht = (f32x4){0.f, 0.f, 0.f, 0.f}, hb = ht;
                    if (has_top) ht = *(const PG8_LAS f32x4*)(XA + ts * 64 + bj * 32 + fq * 8 + 4 * nn);
                    if (has_bot) hb = *(const PG8_LAS f32x4*)(XA + bs * 64 + bj * 32 + fq * 8 + 4 * nn);
#pragma unroll
                    for (int e = 0; e < 4; ++e) {
                        float r1[4], r15[4];
#pragma unroll
                        for (int m = 0; m < 4; ++m) { r1[m] = dpp_ror<1>(acc[ai][bj][m][nn][e]); r15[m] = dpp_ror<15>(acc[ai][bj][m][nn][e]); }
#pragma unroll
                        for (int m = 0; m < 4; ++m) {
                            const float pv = (fr != 0) ? r1[m] : (m > 0 ? r1[m > 0 ? m - 1 : 0] : ht[e]), nx = (fr != 15) ? r15[m] : (m < 3 ? r15[m < 3 ? m + 1 : 3] : hb[e]);
                            const float uc = bb[e] + w0[e] * pv + w1[e] * acc[ai][bj][m][nn][e] + w2[e] * nx;
                            if (bj == 0) actv[m][e] = uc * __builtin_amdgcn_rcpf(1.0f + __expf(-uc)); else actv[m][e] *= uc; } } }
#pragma unroll
                for (int m = 0; m < 4; ++m) { const unsigned aoff = (unsigned)(u.pm * BM + ai * HALF + wr * 64 + m * 16 + fr) * (unsigned)FFc + (unsigned)(chan0 + 4 * nn);
                    typedef unsigned u32x2 __attribute__((ext_vector_type(2))); u32x2 w; w.x = cvt_pk_bf16(actv[m][0], actv[m][1]); w.y = cvt_pk_bf16(actv[m][2], actv[m][3]);
                    *(u32x2*)(ACT + aoff) = w; } } }
        { int frl = fr, fql = fq; asm volatile("" : "+v"(frl), "+v"(fql));
          if (wr == 0 && frl < 2) { bf16_t* rp = RAW + (unsigned)(((u.pm * 4 + frl) * 43 + u.pn) * 256 + wc * 32 + fql * 8);
#pragma unroll
              for (int bj = 0; bj < 2; ++bj) { const f32x4 v0 = acc[0][bj][0][0], v1 = acc[0][bj][0][1]; u32x4 w; w.x = cvt_pk_bf16(v0[0], v0[1]); w.y = cvt_pk_bf16(v0[2], v0[3]); w.z = cvt_pk_bf16(v1[0], v1[1]); w.w = cvt_pk_bf16(v1[2], v1[3]); *(u32x4*)(rp + bj * 128) = w; } }
          if (wr == 1 && frl >= 14) { bf16_t* rp = RAW + (unsigned)(((u.pm * 4 + frl - 12) * 43 + u.pn) * 256 + wc * 32 + fql * 8);
#pragma unroll
              for (int bj = 0; bj < 2; ++bj) { const f32x4 v0 = acc[1][bj][3][0], v1 = acc[1][bj][3][1]; u32x4 w; w.x = cvt_pk_bf16(v0[0], v0[1]); w.y = cvt_pk_bf16(v0[2], v0[3]); w.z = cvt_pk_bf16(v1[0], v1[1]); w.w = cvt_pk_bf16(v1[2], v1[3]); *(u32x4*)(rp + bj * 128) = w; } } }
    }
};
struct EpiF32 {
    static constexpr bool PERM = false, AFTER_DRAIN = false, INPLACE = false;
    float* C; int ldc; const float* bias;
    __device__ __forceinline__ void operator()(const f32x4 (&acc)[2][2][4][2], const Unit& u, int wr, int wc, int fr, int fq) const {
        const int row0 = u.pm * BM + wr * 64 + fr, col0 = u.pn * BM + wc * 32 + 4 * fq;
        f32x4 bv[2][2];
#pragma unroll
        for (int bj = 0; bj < 2; ++bj)
#pragma unroll
            for (int n = 0; n < 2; ++n) bv[bj][n] = bias ? *(const f32x4*)(bias + col0 + bj * HALF + n * 16) : (f32x4){0.f, 0.f, 0.f, 0.f};
#pragma unroll
        for (int ai = 0; ai < 2; ++ai)
#pragma unroll
            for (int m = 0; m < 4; ++m) { float* rowp = C + (size_t)(row0 + ai * HALF + m * 16) * ldc + col0;
#pragma unroll
                for (int bj = 0; bj < 2; ++bj)
#pragma unroll
                    for (int n = 0; n < 2; ++n) *(f32x4*)(rowp + bj * HALF + n * 16) = acc[ai][bj][m][n] + bv[bj][n]; }
    }
};
template <class Epi, class Sched, bool ALIGN_EPI = false, bool SP2 = false>
__device__ __forceinline__ void gemm_phase(PG8_LAS unsigned char* lds, const Gemm g, const Sched& S, const Epi& E, const int wave_in) {
    int tid = wave_in * 64 + mk_lane_id(); asm volatile("" : "+v"(tid));
    const int wid = __builtin_amdgcn_readfirstlane(tid >> 6), lane = tid & 63, wr = wid >> 2, wc = wid & 3, fr = lane & 15, fq = lane >> 4;
    const int K = g.K, nt = K / BK;
    unsigned voffA[2], voffB[2];
#pragma unroll
    for (int i = 0; i < 2; ++i) { int R, C; stage_rc(tid * 16 + i * 8192, R, C); const int Rb = Epi::PERM ? ((R & ~31) + perm32(R & 31)) : R;
        voffA[i] = (unsigned)(R * K + C) * 2u; voffB[i] = (unsigned)(Rb * K + C) * 2u; }
    const size_t kstep = (size_t)(BK * 2);
    const size_t hstep = (size_t)HALF * K * 2;
    const size_t tstep = 2 * hstep;
    const unsigned ldsw = (unsigned)wid * 1024u;
    const int aoff = lds_byte(wr * 64 + fr, fq * 8), boff = lds_byte(wc * 32 + fr, fq * 8);
#define PG8_SA(b, h) (((b) * 2 + (h)) * HTB)
#define PG8_SB(b, h) ((4 + (b) * 2 + (h)) * HTB)
#define PG8_STAGE(bufoff, gbase, voff) do { _Pragma("unroll") for (int _i = 0; _i < 2; ++_i) \
        __builtin_amdgcn_global_load_lds((const unsigned*)((const char*)(gbase) + (voff)[_i]), (PG8_LAS unsigned*)(lds + (bufoff) + ldsw + _i * 8192), 16, 0, 0); } while (0)
#define PG8_LDA(dst, b, h) do { _Pragma("unroll") for (int m = 0; m < 4; ++m) _Pragma("unroll") for (int k = 0; k < 2; ++k) dst[m][k] = *(const PG8_LAS bf16x8*)(lds + PG8_SA(b, h) + aoff + m * 2048 + k * 1024); } while (0)
#define PG8_LDB(dst, b, h) do { _Pragma("unroll") for (int n = 0; n < 2; ++n) _Pragma("unroll") for (int k = 0; k < 2; ++k) dst[n][k] = *(const PG8_LAS bf16x8*)(lds + PG8_SB(b, h) + boff + n * 2048 + k * 1024); } while (0)
#define PG8_MMA(ai, bj, At, Bt) do { __builtin_amdgcn_s_setprio(1); _Pragma("unroll") for (int m = 0; m < 4; ++m) _Pragma("unroll") for (int n = 0; n < 2; ++n) _Pragma("unroll") for (int k = 0; k < 2; ++k) \
        acc[ai][bj][m][n] = __builtin_amdgcn_mfma_f32_16x16x32_bf16(Bt[n][k], At[m][k], acc[ai][bj][m][n], 0, 0, 0); __builtin_amdgcn_s_setprio(0); } while (0)
#define PG8_WAIT_V(n) asm volatile("s_waitcnt vmcnt(" #n ")" ::: "memory")
#define PG8_WAIT_L(n) asm volatile("s_waitcnt lgkmcnt(" #n ")" ::: "memory")
#define PG8_BAR __builtin_amdgcn_s_barrier()
#define PG8_SCHED __builtin_amdgcn_sched_barrier(0)
    Unit cur, nxt; int ui = 0;
    if (!S.next(0, cur)) return;
    f32x4 acc[2][2][4][2];
#pragma unroll
    for (int a = 0; a < 2; ++a)
#pragma unroll
        for (int b = 0; b < 2; ++b)
#pragma unroll
            for (int m = 0; m < 4; ++m)
#pragma unroll
                for (int n = 0; n < 2; ++n) acc[a][b][m][n] = (f32x4){0.f, 0.f, 0.f, 0.f};
    bf16x8 At[4][2], B0[2][2], B1[2][2];
    const char* cA = (const char*)g.A + (size_t)cur.pm * tstep; const char* cB = (const char*)g.Bt + (size_t)cur.pn * tstep;
    S.a_ready(cur);
    if constexpr (SP2) {
        PG8_STAGE(PG8_SB(0, 0), cB, voffB); PG8_STAGE(PG8_SB(0, 1), cB + hstep, voffB); PG8_STAGE(PG8_SA(0, 0), cA, voffA); PG8_STAGE(PG8_SA(0, 1), cA + hstep, voffA);
        if (wr == 1) PG8_BAR;
        PG8_WAIT_V(2); PG8_BAR;
        PG8_STAGE(PG8_SB(1, 0), cB + kstep, voffB); PG8_STAGE(PG8_SA(1, 0), cA + kstep, voffA); PG8_STAGE(PG8_SB(1, 1), cB + hstep + kstep, voffB);
        PG8_WAIT_V(6); PG8_BAR;
    } else {
        PG8_STAGE(PG8_SB(0, 0), cB, voffB); PG8_STAGE(PG8_SA(0, 0), cA, voffA); PG8_STAGE(PG8_SB(0, 1), cB + hstep, voffB); PG8_STAGE(PG8_SA(0, 1), cA + hstep, voffA);
        if (wr == 1) PG8_BAR;
        PG8_WAIT_V(4); PG8_BAR;
        PG8_STAGE(PG8_SB(1, 0), cB + kstep, voffB); PG8_STAGE(PG8_SA(1, 0), cA + kstep, voffA); PG8_STAGE(PG8_SB(1, 1), cB + hstep + kstep, voffB);
        PG8_WAIT_V(6); PG8_BAR;
    }
    for (;;) {
        const bool has_next = S.next(ui + 1, nxt);
        const char* nA = has_next ? (const char*)g.A + (size_t)nxt.pm * tstep : cA; const char* nB = has_next ? (const char*)g.Bt + (size_t)nxt.pn * tstep : cB;
        for (int t = 0; t < nt; t += 2) {
            const bool last = (t == nt - 2);
            const char* a1 = cA + (size_t)(t + 1) * kstep;
            const char* a2 = last ? nA : cA + (size_t)(t + 2) * kstep; const char* b2 = last ? nB : cB + (size_t)(t + 2) * kstep;
            const char* a3 = a2 + kstep; const char* b3 = b2 + kstep;
            if (last && has_next) S.a_ready(nxt);
            if constexpr (SP2) {
            PG8_LDB(B0, 0, 0); PG8_LDB(B1, 0, 1); PG8_SCHED; PG8_LDA(At, 0, 0); PG8_STAGE(PG8_SA(1, 1), a1 + hstep, voffA);
            PG8_WAIT_V(8); PG8_WAIT_L(0); PG8_BAR; PG8_MMA(0, 0, At, B0); PG8_MMA(0, 1, At, B1); PG8_BAR; PG8_SCHED;
            PG8_LDA(At, 0, 1); PG8_STAGE(PG8_SB(0, 0), b2, voffB); PG8_STAGE(PG8_SB(0, 1), b2 + hstep, voffB); PG8_STAGE(PG8_SA(0, 0), a2, voffA);
            PG8_WAIT_V(8); PG8_WAIT_L(0); PG8_BAR; PG8_MMA(1, 0, At, B0); PG8_MMA(1, 1, At, B1); PG8_BAR; PG8_SCHED;
            PG8_LDB(B0, 1, 0); PG8_LDB(B1, 1, 1); PG8_SCHED; PG8_LDA(At, 1, 0); PG8_STAGE(PG8_SA(0, 1), a2 + hstep, voffA);
            PG8_WAIT_V(8); PG8_WAIT_L(0); PG8_BAR; PG8_MMA(0, 0, At, B0); PG8_MMA(0, 1, At, B1); PG8_BAR; PG8_SCHED;
            PG8_LDA(At, 1, 1); PG8_STAGE(PG8_SB(1, 0), b3, voffB); PG8_STAGE(PG8_SB(1, 1), b3 + hstep, voffB); PG8_STAGE(PG8_SA(1, 0), a3, voffA);
            PG8_WAIT_V(8); PG8_WAIT_L(0); PG8_BAR; PG8_MMA(1, 0, At, B0); PG8_MMA(1, 1, At, B1); PG8_BAR; PG8_SCHED;
            } else {
            PG8_LDB(B0, 0, 0); PG8_SCHED; PG8_LDA(At, 0, 0); PG8_STAGE(PG8_SA(1, 1), a1 + hstep, voffA);
            PG8_WAIT_L(8); PG8_BAR; PG8_WAIT_L(0); PG8_MMA(0, 0, At, B0); PG8_BAR; PG8_SCHED;
            PG8_LDB(B1, 0, 1); PG8_STAGE(PG8_SB(0, 0), b2, voffB);
            PG8_BAR; PG8_WAIT_L(0); PG8_MMA(0, 1, At, B1); PG8_BAR;
            PG8_LDA(At, 0, 1); PG8_STAGE(PG8_SA(0, 0), a2, voffA);
            PG8_BAR; PG8_WAIT_L(0); PG8_MMA(1, 0, At, B0); PG8_BAR; PG8_SCHED;
            PG8_STAGE(PG8_SB(0, 1), b2 + hstep, voffB);
            PG8_WAIT_V(6); PG8_BAR; PG8_MMA(1, 1, At, B1); PG8_BAR;
            PG8_LDB(B0, 1, 0); PG8_SCHED; PG8_LDA(At, 1, 0); PG8_STAGE(PG8_SA(0, 1), a2 + hstep, voffA);
            PG8_WAIT_L(8); PG8_BAR; PG8_WAIT_L(0); PG8_MMA(0, 0, At, B0); PG8_BAR; PG8_SCHED;
            PG8_LDB(B1, 1, 1); PG8_STAGE(PG8_SB(1, 0), b3, voffB);
            PG8_BAR; PG8_WAIT_L(0); PG8_MMA(0, 1, At, B1); PG8_BAR;
            PG8_LDA(At, 1, 1); PG8_STAGE(PG8_SA(1, 0), a3, voffA);
            PG8_BAR; PG8_WAIT_L(0); PG8_MMA(1, 0, At, B0); PG8_BAR; PG8_SCHED;
            PG8_STAGE(PG8_SB(1, 1), b3 + hstep, voffB);
            PG8_WAIT_V(6); PG8_BAR; PG8_MMA(1, 1, At, B1); PG8_BAR;
            }
        }
        if constexpr (ALIGN_EPI) { if (wr == 0) PG8_BAR; }
        if constexpr (!Epi::AFTER_DRAIN) { E(acc, cur, wr, wc, fr, fq); S.done(cur); }
        if (!has_next) break;
        bool keep = false; if constexpr (Epi::INPLACE) keep = Epi::keep(cur);
        if (!keep) {
#pragma unroll
        for (int a = 0; a < 2; ++a)
#pragma unroll
            for (int b = 0; b < 2; ++b)
#pragma unroll
                for (int m = 0; m < 4; ++m)
#pragma unroll
                    for (int n = 0; n < 2; ++n) acc[a][b][m][n] = (f32x4){0.f, 0.f, 0.f, 0.f};
        }
        cur = nxt; cA = nA; cB = nB; ++ui;
        if constexpr (ALIGN_EPI) { if (wr == 1) PG8_BAR; }
    }
    PG8_WAIT_V(0);
    if constexpr (!ALIGN_EPI) { if (wr == 0) PG8_BAR; }
    PG8_BAR;
    if constexpr (Epi::AFTER_DRAIN) { E.fused(acc, cur, wr, wc, fr, fq, lds, wid, lane); S.done(cur); }
#undef PG8_SA
#undef PG8_SB
#undef PG8_STAGE
#undef PG8_LDA
#undef PG8_LDB
#undef PG8_MMA
#undef PG8_WAIT_V
#undef PG8_WAIT_L
#undef PG8_BAR
#undef PG8_SCHED
}
}

#define XB_TMO      128
#define XB_XCNT(j)  (256  + 64 * (j))
#define XB_XSUB(j)  (1280 + 64 * (j))
#define XB_XGEN(j)  (2304 + 64 * (j))
#define XB_TOP      3328
#define XB_TOPGEN   3392
#define XCD_BAR_WORDS 3456
#define XB_SPIN_CAP (1u << 18)

__device__ __forceinline__ unsigned xb_ld(unsigned* p)              { return __hip_atomic_load(p, __ATOMIC_RELAXED, __HIP_MEMORY_SCOPE_AGENT); }
__device__ __forceinline__ unsigned xb_add(unsigned* p, unsigned v) { return __hip_atomic_fetch_add(p, v, __ATOMIC_RELAXED, __HIP_MEMORY_SCOPE_AGENT); }
__device__ __forceinline__ unsigned xb_xcc_id() { return (unsigned)__builtin_amdgcn_s_getreg((3 << 11) | 20) & 0xFu; }
#define XB_SPIN(cond, bar) do { unsigned _sp = 0; while (cond) { __builtin_amdgcn_s_sleep(1); \
    if ((++_sp & 255u) == 0u) { if (xb_ld(&(bar)[XB_TMO])) break; if (_sp > XB_SPIN_CAP) { atomicAdd(&(bar)[XB_TMO], 1u); break; } } } } while (0)

struct XcdBarrier {
    unsigned w0;
    unsigned* bar; unsigned x;
    volatile LAS unsigned* st;
};

__device__ __forceinline__ XcdBarrier xcd_barrier_post(unsigned* bar, volatile LAS unsigned* st) {
    XcdBarrier b; b.w0 = 0u; b.bar = bar; b.x = xb_xcc_id(); b.st = st;
    if (threadIdx.x == 0) (void)xb_add(&bar[XB_XCNT(b.x)], 1u);
    return b;
}
__device__ __forceinline__ void xcd_barrier_complete(unsigned* bar, unsigned x, unsigned& nloc, unsigned& nx) {
    const unsigned G = gridDim.x * gridDim.y * gridDim.z;
    unsigned sum, cnt, mine, sp = 0u;
    for (;;) {
        sum = 0u; cnt = 0u; mine = 0u;
#pragma unroll
        for (unsigned j = 0; j < 16; ++j) { const unsigned c = xb_ld(&bar[XB_XCNT(j)]); sum += c; cnt += (c > 0u) ? 1u : 0u; mine = (j == x) ? c : mine; }
        if (sum == G) break;
        __builtin_amdgcn_s_sleep(1);
        if ((++sp & 255u) == 0u) { if (xb_ld(&bar[XB_TMO])) break; if (sp > XB_SPIN_CAP) { atomicAdd(&bar[XB_TMO], 1u); break; } }
    }
    nloc = mine > 0u ? mine : 1u; nx = cnt > 0u ? cnt : 1u;
}

__device__ __forceinline__ void xcd_barrier(const XcdBarrier& b) {
    asm volatile("s_waitcnt vmcnt(0)" ::: "memory");
    __syncthreads();
    if (b.w0 != 0u && (unsigned)mk_lane_id() == 0u) {
        unsigned* bar = b.bar;
        __builtin_amdgcn_s_waitcnt(0);
        unsigned nloc = b.st[0], nx = b.st[1];
        if (nloc == 0u) { xcd_barrier_complete(bar, b.x, nloc, nx); b.st[0] = nloc; b.st[1] = nx; }
        const unsigned old = xb_add(&bar[XB_XSUB(b.x)], 1u);
        const unsigned gen = old / nloc;
        if (old + 1u == (gen + 1u) * nloc) {
            __builtin_amdgcn_fence(__ATOMIC_RELEASE, "agent");
            asm volatile("s_waitcnt vmcnt(0)" ::: "memory");
            const unsigned og = xb_add(&bar[XB_TOP], 1u);
            const unsigned tg = og / nx;
            if (og + 1u == (tg + 1u) * nx) xb_add(&bar[XB_TOPGEN], 1u);
            else XB_SPIN(xb_ld(&bar[XB_TOPGEN]) == tg, bar);
            __builtin_amdgcn_fence(__ATOMIC_ACQUIRE, "agent");
            xb_add(&bar[XB_XGEN(b.x)], 1u);
            asm volatile("s_waitcnt vmcnt(0)" ::: "memory");
        } else {
            XB_SPIN(xb_ld(&bar[XB_XGEN(b.x)]) == gen, bar);
            __builtin_amdgcn_fence(__ATOMIC_ACQUIRE, "agent");
            asm volatile("s_waitcnt vmcnt(0)" ::: "memory");
        }
    }
    __syncthreads();
}

#ifndef ATT_EXP
#define ATT_EXP 0
#endif
#ifndef HG_EXP
#define HG_EXP 0
#endif
constexpr int S_ = 16384, D_ = 2048, W_ = 1024, NIN = 19456, FF = 5504, FF2 = 11008, DEPTH = 4, NHEAD = 8, HD = 128;
constexpr float RMS_EPS = 1e-6f;
constexpr int NWAVES = 8, NTHR = 512;
constexpr size_t MiB = 1u << 20;
constexpr size_t WS_CTL = 0, CTL_ZERO_BYTES = 1 * MiB;
constexpr size_t WS_MOD = 1 * MiB;
constexpr size_t WS_LB = WS_MOD + 256 * 1024;
constexpr size_t WS_ROT = 2 * MiB;
constexpr size_t WS_WIN = 10 * MiB;
constexpr size_t WS_WBR = WS_WIN + 304 * MiB;
constexpr size_t WS_WOUT = WS_WBR + 64 * MiB;
constexpr size_t WS_WUP = WS_WOUT + 32 * MiB;
constexpr size_t WS_WDN = WS_WUP + 172 * MiB;
constexpr size_t WS_H = WS_WDN + 86 * MiB;
constexpr size_t WS_Z = WS_H + 64 * MiB;
constexpr size_t WS_ZG = WS_Z + 352 * MiB;
constexpr size_t WS_BR = WS_Z + 608 * MiB;
constexpr size_t WS_P = WS_BR + 128 * MiB;
constexpr size_t WS_MERGED = WS_P + 256 * MiB;
constexpr size_t WS_Y = WS_MERGED + 64 * MiB;
constexpr size_t WS_N2 = WS_Y + 128 * MiB;
constexpr size_t WS_VT = WS_N2 + 384 * MiB;
constexpr size_t WS_LRUW = WS_VT + 96 * MiB;
constexpr size_t WS_POOLW = WS_LRUW + 4 * MiB;
constexpr size_t WS_RAW = WS_POOLW + 2 * MiB;
constexpr size_t WS_CWT = WS_RAW + 6 * MiB;
constexpr size_t WS_END = WS_CWT + 1 * MiB;
constexpr size_t WS_LSUM = WS_N2;
constexpr size_t WS_LCIN = WS_N2 + 4 * MiB;
constexpr size_t WS_LSU = WS_N2 + 8 * MiB;
constexpr size_t WS_LAF = WS_N2 + 40 * MiB;
constexpr size_t WS_LAB = WS_N2 + 72 * MiB;
constexpr size_t WS_XR = WS_N2 + 128 * MiB;
constexpr size_t WS_OP01 = WS_H;
constexpr size_t WS_OP2 = WS_Y + 64 * MiB;
constexpr size_t WS_ML = WS_Y + 96 * MiB;
constexpr size_t SEG = (size_t)S_ * W_;
constexpr size_t WS_HQS = WS_P;
constexpr size_t WS_HF = WS_P + 64 * MiB;
constexpr size_t WS_HO = WS_P + 192 * MiB;
constexpr size_t WS_PD = WS_P + 320 * MiB;
constexpr size_t WS_HST = WS_P;
constexpr size_t WS_HDEC = WS_P + 128 * MiB;
constexpr int CW_BAR = 4096;
constexpr int RING_BYTES = 131072, MISC_OFF = 143360, LDS_BYTES = 147456;

typedef unsigned short bf16;
typedef unsigned v4u __attribute__((ext_vector_type(4)));
typedef unsigned v2u __attribute__((ext_vector_type(2)));
typedef float f32x4 __attribute__((ext_vector_type(4)));
#define LDS_WAIT() asm volatile("s_waitcnt lgkmcnt(0)" ::: "memory")
__device__ __forceinline__ unsigned f2bf(float f) { unsigned u = __builtin_bit_cast(unsigned, f); return (u + 0x7fffu + ((u >> 16) & 1u)) >> 16; }
__device__ __forceinline__ unsigned pk2(float lo, float hi) { return f2bf(lo) | (f2bf(hi) << 16); }
typedef __bf16 bf16x2_t __attribute__((ext_vector_type(2)));
typedef float f32x2_t __attribute__((ext_vector_type(2)));
__device__ __forceinline__ unsigned cvtpk(float lo, float hi) { const f32x2_t v = {lo, hi}; return __builtin_bit_cast(unsigned, __builtin_convertvector(v, bf16x2_t)); }
__device__ __forceinline__ float bf2f(unsigned b) { return __builtin_bit_cast(float, b << 16); }
__device__ __forceinline__ float bflo(unsigned w) { return __builtin_bit_cast(float, w << 16); }
__device__ __forceinline__ float bfhi(unsigned w) { return __builtin_bit_cast(float, w & 0xffff0000u); }
__device__ __forceinline__ void unpack8(const v4u w, float (&o)[8]) { o[0] = bflo(w.x); o[1] = bfhi(w.x); o[2] = bflo(w.y); o[3] = bfhi(w.y); o[4] = bflo(w.z); o[5] = bfhi(w.z); o[6] = bflo(w.w); o[7] = bfhi(w.w); }
__device__ __forceinline__ float sigmoidf_(float x) { return __builtin_amdgcn_rcpf(1.0f + __expf(-x)); }
__device__ __forceinline__ float siluf_(float x) { return x * __builtin_amdgcn_rcpf(1.0f + __expf(-x)); }
__device__ __forceinline__ float gelu_tanh(float x) { const float u = 0.7978845608028654f * (x + 0.044715f * x * x * x); const float e = __expf(-2.0f * u); return x * __builtin_amdgcn_rcpf(1.0f + e); }
__device__ __forceinline__ float mk_bperm(int srclane, float v) { return __builtin_bit_cast(float, __builtin_amdgcn_ds_bpermute(srclane << 2, __builtin_bit_cast(int, v))); }
__device__ __forceinline__ float wave_sum(float v) { const int l = mk_lane_id();
#pragma unroll
    for (int o = 1; o < 64; o <<= 1) v += mk_bperm(l ^ o, v);
    return v;
}
__device__ __forceinline__ float wave_max(float v) { const int l = mk_lane_id();
#pragma unroll
    for (int o = 1; o < 64; o <<= 1) v = fmaxf(v, mk_bperm(l ^ o, v));
    return v;
}

struct Args {
    const float *x, *c; const int* pos; const float *ada_w, *ada_b, *norm_g, *w_in, *hgrn_lb, *hgrn_onorm, *lru_conv_w, *lru_conv_b, *lru_wa, *lru_ba, *lru_wx, *lru_bx, *lru_lambda,
        *pool_w, *pool_scale, *w_branch, *w_out, *ffn_up, *ffn_conv_w, *ffn_conv_b, *ffn_down;
    float* out; unsigned char* ws; int ph_lo, ph_hi;
};

struct TJob { const float* W; bf16* WT; int K, N, item, up; };
__device__ __forceinline__ void tr_load(const TJob& j, f32x4 (&v)[16], int lane) { const int nblk = j.N / 64, kb = j.item / nblk, nb = j.item % nblk, k0 = 64 * kb, n0 = 64 * nb;
#pragma unroll
    for (int i = 0; i < 16; ++i) v[i] = *(const f32x4*)(j.W + (size_t)(k0 + 4 * i + (lane >> 4)) * j.N + n0 + 4 * (lane & 15)); }
__device__ __forceinline__ void tr_to_lds(const f32x4 (&v)[16], LAS float* scr, int lane) {
#pragma unroll
    for (int i = 0; i < 16; ++i) { LAS float* s = scr + (4 * i + (lane >> 4)) * 65 + 4 * (lane & 15); s[0] = v[i][0]; s[1] = v[i][1]; s[2] = v[i][2]; s[3] = v[i][3]; }
    LDS_WAIT(); asm volatile("" ::: "memory"); }
__device__ __forceinline__ void tr_store(const TJob& j, LAS float* scr, int lane) { const int nblk = j.N / 64, kb = j.item / nblk, nb = j.item % nblk, k0 = 64 * kb, n0 = 64 * nb;
    int d0 = n0; if (j.up) { const int isv = n0 >= FF ? 1 : 0, c = n0 - isv * FF; d0 = 256 * (c >> 7) + 128 * isv + (c & 127); }
    const int c = lane & 7;
#pragma unroll
    for (int jj = 0; jj < 8; ++jj) { const int n = (lane >> 3) + 8 * jj; const LAS float* s = scr + (8 * c) * 65 + n;
        v4u o; o.x = cvtpk(s[0 * 65], s[1 * 65]); o.y = cvtpk(s[2 * 65], s[3 * 65]); o.z = cvtpk(s[4 * 65], s[5 * 65]); o.w = cvtpk(s[6 * 65], s[7 * 65]);
        *(GAS v4u*)(j.WT + (size_t)(d0 + n) * j.K + k0 + 8 * c) = o; }
    LDS_WAIT(); asm volatile("" ::: "memory"); }
__device__ __forceinline__ TJob tr_job(const Args& a, unsigned char* ws, int it) {
    constexpr int I_IN = (D_ / 64) * (NIN / 64), I_BR1 = (W_ / 64) * (D_ / 64), I_BR = 4 * I_BR1, I_OUT = (D_ / 64) * (D_ / 64), I_UP = (D_ / 64) * (FF2 / 64), I_DN = (FF / 64) * (D_ / 64);
    constexpr int I_LAYER = I_IN + I_BR + I_OUT + I_UP + I_DN, I_BIG = DEPTH * I_LAYER;
    TJob j; j.up = 0;
    if (it < I_BIG) { const int L = it / I_LAYER; int r = it - L * I_LAYER;
        if (r < I_IN) { j.W = a.w_in + (size_t)L * D_ * NIN; j.K = D_; j.N = NIN; j.WT = (bf16*)(ws + WS_WIN) + (size_t)L * NIN * D_; j.item = r; return j; } r -= I_IN;
        if (r < I_BR) { const int g = r / I_BR1; j.W = a.w_branch + ((size_t)L * 4 + g) * W_ * D_; j.K = W_; j.N = D_; j.WT = (bf16*)(ws + WS_WBR) + ((size_t)L * 4 + g) * D_ * W_; j.item = r - g * I_BR1; return j; } r -= I_BR;
        if (r < I_OUT) { j.W = a.w_out + (size_t)L * D_ * D_; j.K = D_; j.N = D_; j.WT = (bf16*)(ws + WS_WOUT) + (size_t)L * D_ * D_; j.item = r; return j; } r -= I_OUT;
        if (r < I_UP) { j.W = a.ffn_up + (size_t)L * D_ * FF2; j.K = D_; j.N = FF2; j.WT = (bf16*)(ws + WS_WUP) + (size_t)L * FF2 * D_; j.item = r; j.up = 1; return j; } r -= I_UP;
        j.W = a.ffn_down + (size_t)L * FF * D_; j.K = FF; j.N = D_; j.WT = (bf16*)(ws + WS_WDN) + (size_t)L * D_ * FF; j.item = r; return j; }
    const int s = it - I_BIG;
    if (s < 512) { const int blk = s >> 2, sel = blk >> 6, rest = blk & 63;
        j.W = (sel ? a.lru_wx : a.lru_wa) + (size_t)rest * 16384; j.K = 128; j.N = 128; j.WT = (bf16*)(ws + WS_LRUW) + (size_t)blk * 16384; j.item = s & 3; return j; }
    const int r = s - 512, blk = r >> 4; j.W = a.pool_w + (size_t)blk * 65536; j.K = 256; j.N = 256; j.WT = (bf16*)(ws + WS_POOLW) + (size_t)blk * 65536; j.item = r & 15; return j;
}
__device__ __forceinline__ void ph_prologue(const Args& a, LAS unsigned char* lds, int bid, int nb, int tid, int wave, int lane) {
    unsigned char* ws = a.ws;
    LAS float* scr = (LAS float*)(lds + wave * 16640);
    const int gw = bid * NWAVES + wave, NGW = nb * NWAVES;
    constexpr int N_ITEMS = DEPTH * ((D_ / 64) * (NIN / 64) + 4 * (W_ / 64) * (D_ / 64) + (D_ / 64) * (D_ / 64) + (D_ / 64) * (FF2 / 64) + (FF / 64) * (D_ / 64)) + 512 + 256;
    if (gw < N_ITEMS) { f32x4 v[16]; TJob cur = tr_job(a, ws, gw); tr_load(cur, v, lane);
        for (int it = gw; it < N_ITEMS; it += NGW) { tr_to_lds(v, scr, lane);
            const bool hn = it + NGW < N_ITEMS; TJob nx = cur; if (hn) { nx = tr_job(a, ws, it + NGW); tr_load(nx, v, lane); }
            tr_store(cur, scr, lane); cur = nx; } }
    __syncthreads();
    LAS float* red = (LAS float*)lds;
    float* mod = (float*)(ws + WS_MOD);
    for (int it = bid; it < DEPTH * 192; it += nb) {
        const int L = it / 192, j0 = (it % 192) * 64;
        const float* wp = a.ada_w + (size_t)L * D_ * 6 * D_ + (size_t)(wave * 256) * 6 * D_ + j0 + lane;
        float acc = 0.f;
        for (int k0 = 0; k0 < 256; k0 += 32) { float wv[32];
#pragma unroll
            for (int k = 0; k < 32; ++k) wv[k] = wp[(size_t)(k0 + k) * 6 * D_];
#pragma unroll
            for (int k = 0; k < 32; ++k) { const float cv = a.c[wave * 256 + k0 + k]; acc += siluf_(cv) * wv[k]; } }
        red[wave * 64 + lane] = acc;
        __syncthreads();
        if (wave == 0) { float s = a.ada_b[L * 6 * D_ + j0 + lane];
#pragma unroll
            for (int w = 0; w < 8; ++w) s += red[w * 64 + lane];
            mod[L * 6 * D_ + j0 + lane] = s; }
        __syncthreads();
    }
    { float* cwt = (float*)(ws + WS_CWT);
      for (int i = bid * NTHR + tid; i < DEPTH * 43 * 8 * 128; i += nb * NTHR) { const int c = i & 127, r = (i >> 7) & 7, pn = (i >> 10) % 43, L = (i >> 10) / 43, ch = (r >> 2) * FF + pn * 128 + c, k = r & 3;
          cwt[i] = k == 0 ? a.ffn_conv_b[(size_t)L * FF2 + ch] : a.ffn_conv_w[((size_t)L * 3 + (k - 1)) * FF2 + ch]; } }
    if (bid == 0) { float* lb = (float*)(ws + WS_LB);
        for (int i = tid; i < 2 * W_; i += NTHR) { float e[DEPTH], s = 0.f;
#pragma unroll
            for (int L = 0; L < DEPTH; ++L) e[L] = a.hgrn_lb[L * 2 * W_ + i];
            const float mx = fmaxf(fmaxf(e[0], e[1]), fmaxf(e[2], e[3]));
#pragma unroll
            for (int L = 0; L < DEPTH; ++L) { e[L] = expf(e[L] - mx); s += e[L]; }
            float cum = 0.f; lb[i] = 0.f;
#pragma unroll
            for (int L = 1; L < DEPTH; ++L) { cum += e[L] / s; lb[L * 2 * W_ + i] = cum; } } }
    { float2* rot = (float2*)(ws + WS_ROT);
      for (int i = bid * NTHR + tid; i < S_ * 64; i += nb * NTHR) { const int t = i >> 6, d = i & 63;
          const float inv = powf(10000.0f, -(float)d / 64.0f); const float ang = (float)a.pos[t] * inv; float sn, cs; sincosf(ang, &sn, &cs); rot[i] = make_float2(cs, sn); } }
}

template <bool HAS_Y>
__device__ __forceinline__ void ph_resnorm(const Args& a, LAS unsigned char* lds, int bid, int nb, int tid, int wave, int lane,
                                           const float* xsrc, float* xdst, const bf16* y, bf16* hdst, int L, int gsel, int ysel, int Lh, int hsel, int scsel, int shsel, const bf16* xsrcb = nullptr, bf16* xdstb = nullptr) {
    const float* mod = (const float*)(a.ws + WS_MOD);
    LAS float* cy = (LAS float*)lds; LAS float* ca = cy + D_; LAS float* cb = ca + D_;
    for (int c = tid; c < D_; c += NTHR) {
        if (HAS_Y) cy[c] = mod[L * 6 * D_ + gsel * D_ + c] * a.norm_g[(L * 4 + ysel) * D_ + c];
        if (hdst) { ca[c] = a.norm_g[(Lh * 4 + hsel) * D_ + c] * (1.0f + mod[Lh * 6 * D_ + scsel * D_ + c]); cb[c] = mod[Lh * 6 * D_ + shsel * D_ + c]; }
    }
    __syncthreads();
#pragma unroll 2
    for (int row = bid * NWAVES + wave; row < S_; row += nb * NWAVES) {
        f32x4 xv[8];
        if (xsrcb) { const v2u* xb = (const v2u*)(xsrcb + (size_t)row * D_) + lane;
#pragma unroll
            for (int j = 0; j < 8; ++j) { const v2u w = __builtin_nontemporal_load(&xb[64 * j]); xv[j] = (f32x4){bflo(w.x), bfhi(w.x), bflo(w.y), bfhi(w.y)}; } }
        else { const f32x4* xr = (const f32x4*)(xsrc + (size_t)row * D_) + lane;
#pragma unroll
            for (int j = 0; j < 8; ++j) xv[j] = __builtin_nontemporal_load(&xr[64 * j]); }
        if (HAS_Y) {
            const v2u* yr = (const v2u*)(y + (size_t)row * D_) + lane; f32x4 yv[8]; float ss = 0.f;
#pragma unroll
            for (int j = 0; j < 8; ++j) { const v2u yw = __builtin_nontemporal_load(&yr[64 * j]); yv[j] = (f32x4){bflo(yw.x), bfhi(yw.x), bflo(yw.y), bfhi(yw.y)}; ss += (yv[j].x * yv[j].x + yv[j].y * yv[j].y) + (yv[j].z * yv[j].z + yv[j].w * yv[j].w); }
            const float r = rsqrtf(wave_sum(ss) * (1.0f / D_) + RMS_EPS);
            if (xdstb) { v2u* xo = (v2u*)(xdstb + (size_t)row * D_) + lane;
#pragma unroll
                for (int j = 0; j < 8; ++j) { const f32x4 cv = *(const LAS f32x4*)(cy + 4 * (lane + 64 * j)); xv[j] = xv[j] + yv[j] * r * cv; v2u w; w.x = pk2(xv[j].x, xv[j].y); w.y = pk2(xv[j].z, xv[j].w); __builtin_nontemporal_store(w, &xo[64 * j]); } }
            else { f32x4* xo = (f32x4*)(xdst + (size_t)row * D_) + lane;
#pragma unroll
                for (int j = 0; j < 8; ++j) { const f32x4 cv = *(const LAS f32x4*)(cy + 4 * (lane + 64 * j)); xv[j] = xv[j] + yv[j] * r * cv; __builtin_nontemporal_store(xv[j], &xo[64 * j]); } }
        }
        if (hdst) {
            float ss = 0.f;
#pragma unroll
            for (int j = 0; j < 8; ++j) ss += (xv[j].x * xv[j].x + xv[j].y * xv[j].y) + (xv[j].z * xv[j].z + xv[j].w * xv[j].w);
            const float r = rsqrtf(wave_sum(ss) * (1.0f / D_) + RMS_EPS);
            v2u* ho = (v2u*)(hdst + (size_t)row * D_) + lane;
#pragma unroll
            for (int j = 0; j < 8; ++j) { const f32x4 av = *(const LAS f32x4*)(ca + 4 * (lane + 64 * j)), bv = *(const LAS f32x4*)(cb + 4 * (lane + 64 * j)); const f32x4 h = xv[j] * r * av + bv;
                v2u w; w.x = pk2(h.x, h.y); w.y = pk2(h.z, h.w); ho[64 * j] = w; }
        }
    }
    __syncthreads();
}

__device__ __forceinline__ void ph_hgrn_prep(const Args& a, int L, int bid, int nb, int tid) {
    const bf16* z = (const bf16*)(a.ws + WS_Z); const float* lb = (const float*)(a.ws + WS_LB) + L * 2 * W_;
    float* QS = (float*)(a.ws + WS_HQS); float* F = (float*)(a.ws + WS_HF);
    for (size_t i = (size_t)bid * NTHR + tid; i < SEG; i += (size_t)nb * NTHR) { const int ch = (int)(i & (W_ - 1));
        QS[i] = siluf_(bf2f(z[0 * SEG + i]));
        const float l0 = lb[ch], l1 = lb[W_ + ch];
        F[i] = l0 + (1.0f - l0) * sigmoidf_(bf2f(z[1 * SEG + i])); F[SEG + i] = l1 + (1.0f - l1) * sigmoidf_(bf2f(z[2 * SEG + i])); }
}
__device__ __forceinline__ void ph_hgrn_rec(const Args& a, LAS unsigned char* lds, int bid, int tid) {
    if (bid >= 16) return;
    const int dir = bid >> 3, head = bid & 7, kq = tid >> 7, v = tid & 127;
    const bf16* zi = (const bf16*)(a.ws + WS_Z) + 3 * SEG; const float* QS = (const float*)(a.ws + WS_HQS); const float* F = (const float*)(a.ws + WS_HF) + (size_t)dir * SEG;
    float* HO = (float*)(a.ws + WS_HO) + (size_t)dir * SEG;
    LAS float* part = (LAS float*)lds;
    float st[32];
#pragma unroll
    for (int j = 0; j < 32; ++j) st[j] = 0.f;
    for (int n0 = 0; n0 < S_; n0 += 8) {
#pragma unroll 1
        for (int s = 0; s < 8; ++s) { const int n = n0 + s, t = dir ? S_ - 1 - n : n;
            const float iv = bf2f(zi[(size_t)t * W_ + head * HD + v]);
            const f32x4* fp = (const f32x4*)(F + (size_t)t * W_ + head * HD + kq * 32); const f32x4* qp = (const f32x4*)(QS + (size_t)t * W_ + head * HD + kq * 32);
            float o = 0.f;
#pragma unroll
            for (int j = 0; j < 8; ++j) { const f32x4 f = fp[j], q = qp[j];
                st[4 * j + 0] = f.x * st[4 * j + 0] + (1.0f - f.x) * iv; o += q.x * st[4 * j + 0];
                st[4 * j + 1] = f.y * st[4 * j + 1] + (1.0f - f.y) * iv; o += q.y * st[4 * j + 1];
                st[4 * j + 2] = f.z * st[4 * j + 2] + (1.0f - f.z) * iv; o += q.z * st[4 * j + 2];
                st[4 * j + 3] = f.w * st[4 * j + 3] + (1.0f - f.w) * iv; o += q.w * st[4 * j + 3]; }
            part[(kq * 8 + s) * 128 + v] = o; }
        __syncthreads();
#pragma unroll
        for (int h = 0; h < 2; ++h) { const int s = (tid >> 7) + 4 * h; const int n = n0 + s, t = dir ? S_ - 1 - n : n;
            HO[(size_t)t * W_ + head * HD + v] = (part[(0 * 8 + s) * 128 + v] + part[(1 * 8 + s) * 128 + v]) + (part[(2 * 8 + s) * 128 + v] + part[(3 * 8 + s) * 128 + v]); }
        __syncthreads();
    }
}
__device__ __forceinline__ void ph_hgrn_fin(const Args& a, int L, int bid, int nb, int wave, int lane) {
    const float* HO = (const float*)(a.ws + WS_HO); const bf16* zg = (const bf16*)(a.ws + WS_Z) + 4 * SEG; bf16* br = (bf16*)(a.ws + WS_BR);
    for (int it = bid * NWAVES + wave; it < S_ * NHEAD; it += nb * NWAVES) { const int t = it >> 3, h = it & 7; const size_t o0 = (size_t)t * W_ + h * HD + 2 * lane;
        const float o_a = HO[o0] + HO[SEG + o0], o_b = HO[o0 + 1] + HO[SEG + o0 + 1];
        const float r = rsqrtf(wave_sum(o_a * o_a + o_b * o_b) * (1.0f / HD) + RMS_EPS);
        const unsigned gw = *(const unsigned*)(zg + o0); const float* on = a.hgrn_onorm + L * W_ + h * HD + 2 * lane;
        *(unsigned*)(br + o0) = pk2(o_a * r * on[0] * siluf_(bflo(gw)), o_b * r * on[1] * siluf_(bfhi(gw))); }
}
__device__ __forceinline__ void ph_lru_xc(const Args& a, int L, int bid, int nb, int tid) {
    const bf16* zx = (const bf16*)(a.ws + WS_Z) + 5 * SEG; float* XC = (float*)(a.ws + WS_N2);
    const float* cw = a.lru_conv_w + (size_t)L * 2 * 4 * W_; const float* cbp = a.lru_conv_b + (size_t)L * 2 * W_;
    for (size_t i = (size_t)bid * NTHR + tid; i < SEG; i += (size_t)nb * NTHR) { const int ch = (int)(i & (W_ - 1)), t = (int)(i >> 10);
        float f = cbp[ch], b = cbp[W_ + ch];
#pragma unroll
        for (int j = 0; j < 4; ++j) { const int tf = t - 3 + j, tb = t + 3 - j;
            if (tf >= 0) f += cw[(0 * 4 + j) * W_ + ch] * bf2f(zx[(size_t)tf * W_ + ch]);
            if (tb < S_) b += cw[(1 * 4 + j) * W_ + ch] * bf2f(zx[(size_t)tb * W_ + ch]); }
        XC[i] = f; XC[SEG + i] = b; }
}
__device__ __forceinline__ void ph_lru_gates(const Args& a, int L, int bid, int nb, int tid) {
    const float* XC = (const float*)(a.ws + WS_N2); float* A = (float*)(a.ws + WS_N2 + 128 * MiB); float* U = (float*)(a.ws + WS_N2 + 256 * MiB);
    for (size_t i = (size_t)bid * NTHR + tid; i < 2 * SEG; i += (size_t)nb * NTHR) { const int dir = (int)(i / SEG); const size_t r = i - (size_t)dir * SEG; const int t = (int)(r >> 10), ch = (int)(r & (W_ - 1)), hh = ch >> 7, jj = ch & 127;
        const float* xr = XC + (size_t)dir * SEG + (size_t)t * W_ + hh * 128;
        const float* wa = a.lru_wa + (((size_t)L * 2 + dir) * 8 + hh) * 128 * 128 + jj; const float* wx = a.lru_wx + (((size_t)L * 2 + dir) * 8 + hh) * 128 * 128 + jj;
        float ra = a.lru_ba[(L * 2 + dir) * W_ + ch], rx = a.lru_bx[(L * 2 + dir) * W_ + ch];
#pragma unroll 8
        for (int k = 0; k < 128; ++k) { const float xv = xr[k]; ra += xv * wa[k * 128]; rx += xv * wx[k * 128]; }
        const float rg = sigmoidf_(ra), ig = sigmoidf_(rx);
        const float lam = a.lru_lambda[(L * 2 + dir) * W_ + ch]; const float sp = log1pf(expf(-lam));
        const float la = -8.0f * rg * sp;
        A[i] = expf(la); U[i] = sqrtf(-expm1f(2.0f * la)) * (ig * xr[jj]); }
}
__device__ __forceinline__ void ph_lru_scan(const Args& a, int bid, int tid) {
    const int id = bid * NTHR + tid; if (id >= 2 * W_) return;
    const int dir = id >> 10, ch = id & (W_ - 1);
    const float* A = (const float*)(a.ws + WS_N2 + 128 * MiB) + (size_t)dir * SEG + ch; float* U = (float*)(a.ws + WS_N2 + 256 * MiB) + (size_t)dir * SEG + ch;
    float h = 0.f;
    for (int n0 = 0; n0 < S_; n0 += 8) { float av[8], uv[8];
#pragma unroll
        for (int s = 0; s < 8; ++s) { const int n = n0 + s, t = dir ? S_ - 1 - n : n; av[s] = A[(size_t)t * W_]; uv[s] = U[(size_t)t * W_]; }
#pragma unroll
        for (int s = 0; s < 8; ++s) { const int n = n0 + s, t = dir ? S_ - 1 - n : n; h = av[s] * h + uv[s]; U[(size_t)t * W_] = h; } }
}
__device__ __forceinline__ void ph_lru_fin(const Args& a, int bid, int nb, int tid) {
    const float* U = (const float*)(a.ws + WS_N2 + 256 * MiB); const bf16* zg = (const bf16*)(a.ws + WS_Z) + 6 * SEG; bf16* br = (bf16*)(a.ws + WS_BR) + SEG;
    for (size_t i = (size_t)bid * NTHR + tid; i < SEG; i += (size_t)nb * NTHR) br[i] = (bf16)f2bf((U[i] + U[SEG + i]) * gelu_tanh(bf2f(zg[i])));
}
__device__ __forceinline__ void ph_pool_d(const Args& a, int bid, int nb, int tid) {
    const bf16* zp = (const bf16*)(a.ws + WS_Z) + 7 * SEG; float* PD = (float*)(a.ws + WS_PD);
    for (size_t i = (size_t)bid * NTHR + tid; i < SEG; i += (size_t)nb * NTHR) { const int ch = (int)(i & (W_ - 1)), t = (int)(i >> 10), w2 = 1 << (ch >> 8);
        const int lo = max(t - w2, 0), hi = min(t + w2, S_); float s = 0.f;
        for (int tt = lo; tt < hi; ++tt) s += bf2f(zp[(size_t)tt * W_ + ch]);
        PD[i] = s / (float)(hi - lo) - bf2f(zp[i]); }
}
__device__ __forceinline__ void ph_pool_mm(const Args& a, int L, int bid, int nb, int tid) {
    const float* PD = (const float*)(a.ws + WS_PD); bf16* br = (bf16*)(a.ws + WS_BR) + 2 * SEG;
    for (size_t i = (size_t)bid * NTHR + tid; i < SEG; i += (size_t)nb * NTHR) { const int ch = (int)(i & (W_ - 1)), t = (int)(i >> 10), gi = ch >> 8, jj = ch & 255;
        const float* dr = PD + (size_t)t * W_ + gi * 256; const float* pw = a.pool_w + ((size_t)L * 4 + gi) * 256 * 256 + jj; float s = 0.f;
#pragma unroll 8
        for (int k = 0; k < 256; ++k) s += dr[k] * pw[k * 256];
        br[i] = (bf16)f2bf(s * a.pool_scale[L * W_ + ch]); }
}
__device__ __forceinline__ void ph_attn_prep(unsigned char* ws, int bid, int nb, int tid) {
    bf16* zq = (bf16*)(ws + WS_Z) + 8 * SEG; bf16* zk = zq + SEG; const float2* rot = (const float2*)(ws + WS_ROT);
#pragma unroll 4
    for (int i = bid * NTHR + tid; i < S_ * NHEAD * 8; i += nb * NTHR) { const int d8 = (i & 7) * 8, h = (i >> 3) & 7, t = i >> 6;
        const size_t o = (size_t)t * W_ + h * HD + d8;
        const v4u q1 = *(const v4u*)(zq + o), q2 = *(const v4u*)(zq + o + 64), k1 = *(const v4u*)(zk + o), k2 = *(const v4u*)(zk + o + 64);
        const f32x4* rp = (const f32x4*)(rot + t * 64 + d8); const f32x4 r0 = rp[0], r1 = rp[1], r2 = rp[2], r3 = rp[3];
        const float cs[8] = {r0[0], r0[2], r1[0], r1[2], r2[0], r2[2], r3[0], r3[2]}, sn[8] = {r0[1], r0[3], r1[1], r1[3], r2[1], r2[3], r3[1], r3[3]};
        const unsigned qa[4] = {q1.x, q1.y, q1.z, q1.w}, qb[4] = {q2.x, q2.y, q2.z, q2.w}, ka[4] = {k1.x, k1.y, k1.z, k1.w}, kb[4] = {k2.x, k2.y, k2.z, k2.w};
        unsigned oq1[4], oq2[4], ok1[4], ok2[4]; const float sc = 0.08838834764831845f;
#pragma unroll
        for (int j = 0; j < 4; ++j) { const float c0 = cs[2 * j], s0 = sn[2 * j], c1 = cs[2 * j + 1], s1 = sn[2 * j + 1];
            const float a0 = bflo(qa[j]), a1 = bfhi(qa[j]), b0 = bflo(qb[j]), b1 = bfhi(qb[j]);
            oq1[j] = cvtpk((a0 * c0 - b0 * s0) * sc, (a1 * c1 - b1 * s1) * sc); oq2[j] = cvtpk((b0 * c0 + a0 * s0) * sc, (b1 * c1 + a1 * s1) * sc);
            const float e0 = bflo(ka[j]), e1 = bfhi(ka[j]), f0 = bflo(kb[j]), f1 = bfhi(kb[j]);
            ok1[j] = cvtpk(e0 * c0 - f0 * s0, e1 * c1 - f1 * s1); ok2[j] = cvtpk(f0 * c0 + e0 * s0, f1 * c1 + e1 * s1); }
        *(v4u*)(zq + o) = (v4u){oq1[0], oq1[1], oq1[2], oq1[3]}; *(v4u*)(zq + o + 64) = (v4u){oq2[0], oq2[1], oq2[2], oq2[3]};
        *(v4u*)(zk + o) = (v4u){ok1[0], ok1[1], ok1[2], ok1[3]}; *(v4u*)(zk + o + 64) = (v4u){ok2[0], ok2[1], ok2[2], ok2[3]}; }
}
__device__ __forceinline__ void ph_attn_naive(const Args& a, LAS unsigned char* lds, int bid, int nb, int wave, int lane) {
    const bf16* zq = (const bf16*)(a.ws + WS_Z) + 8 * SEG; const bf16* zk = zq + SEG; const bf16* zv = zk + SEG; bf16* br = (bf16*)(a.ws + WS_BR) + 3 * SEG;
    LAS float* qs = (LAS float*)(lds + wave * 4096); LAS float* ps = qs + 128;
    for (int it = bid * NWAVES + wave; it < S_ * NHEAD; it += nb * NWAVES) { const int t = it >> 3, h = it & 7;
        { const unsigned qw = *(const unsigned*)(zq + (size_t)t * W_ + h * HD + 2 * lane); qs[2 * lane] = bflo(qw); qs[2 * lane + 1] = bfhi(qw); }
        LDS_WAIT(); asm volatile("" ::: "memory");
        float sv[7]; float mx = -1e30f;
#pragma unroll
        for (int i = 0; i < 7; ++i) { const int e = lane + 64 * i; float s = -1e30f;
            if (e < 387) { const int g = e / 129, o = e - g * 129 - 64, dil = (g == 0) ? 1 : (g == 1 ? 4 : 16), p = t + dil * o;
                if (p >= 0 && p < S_) { const v4u* kr = (const v4u*)(zk + (size_t)p * W_ + h * HD); float d = 0.f;
#pragma unroll 4
                    for (int c = 0; c < 16; ++c) { const v4u kw = kr[c]; const LAS float* qq = qs + 8 * c;
                        d += qq[0] * bflo(kw.x) + qq[1] * bfhi(kw.x) + qq[2] * bflo(kw.y) + qq[3] * bfhi(kw.y) + qq[4] * bflo(kw.z) + qq[5] * bfhi(kw.z) + qq[6] * bflo(kw.w) + qq[7] * bfhi(kw.w); }
                    s = d; } }
            sv[i] = s; mx = fmaxf(mx, s); }
        mx = wave_max(mx); float l = 0.f;
#pragma unroll
        for (int i = 0; i < 7; ++i) { const float p = (sv[i] > -1e29f) ? __expf(sv[i] - mx) : 0.f; l += p; ps[lane + 64 * i] = p; }
        l = wave_sum(l);
        LDS_WAIT(); asm volatile("" ::: "memory");
        float o0 = 0.f, o1 = 0.f;
        for (int e = 0; e < 387; ++e) { const float p = ps[e]; if (p != 0.f) { const int g = e / 129, o = e - g * 129 - 64, dil = (g == 0) ? 1 : (g == 1 ? 4 : 16), pp = t + dil * o;
                const unsigned vw = *(const unsigned*)(zv + (size_t)pp * W_ + h * HD + 2 * lane); o0 += p * bflo(vw); o1 += p * bfhi(vw); } }
        const float il = 1.0f / l;
        *(unsigned*)(br + (size_t)t * W_ + h * HD + 2 * lane) = pk2(o0 * il, o1 * il);
        LDS_WAIT(); asm volatile("" ::: "memory");
    }
}

typedef short bf16x8 __attribute__((ext_vector_type(8)));
__device__ __forceinline__ bf16* op_ptr(unsigned char* ws, int g) { return g < 2 ? (bf16*)(ws + WS_OP01) + (size_t)g * SEG : (bf16*)(ws + WS_OP2); }
typedef short s16x4 __attribute__((ext_vector_type(4)));
__device__ __forceinline__ bf16x8 tr_frag(const LAS bf16* T, int pitch, int r0, int c0, int lane) {
    const LAS bf16* p = T + (r0 + 8 * (lane >> 4) + ((lane & 15) >> 2)) * pitch + c0 + 4 * (lane & 3);
    const s16x4 x = __builtin_amdgcn_ds_read_tr16_b64_v4i16((LAS s16x4*)p), y = __builtin_amdgcn_ds_read_tr16_b64_v4i16((LAS s16x4*)(p + 4 * pitch));
    return __builtin_shufflevector(x, y, 0, 1, 2, 3, 4, 5, 6, 7);
}
__device__ __forceinline__ bf16x8 tr_frag_rs(const LAS bf16* T, int pitch, int r0, int rs, int c0, int lane) {
    const LAS bf16* p = T + (r0 + rs * (8 * (lane >> 4) + ((lane & 15) >> 2))) * pitch + c0 + 4 * (lane & 3);
    const s16x4 x = __builtin_amdgcn_ds_read_tr16_b64_v4i16((LAS s16x4*)p), y = __builtin_amdgcn_ds_read_tr16_b64_v4i16((LAS s16x4*)(p + 4 * rs * pitch));
    return __builtin_shufflevector(x, y, 0, 1, 2, 3, 4, 5, 6, 7);
}
__device__ __forceinline__ size_t vt_off(int g, int h, int d, int rr, int Lg, int l) { return ((size_t)g * NHEAD + h) * ((size_t)S_ * HD) + (size_t)rr * Lg * HD + (size_t)(l >> 5) * (32 * HD) + d * 32 + (l & 31); }
__device__ __forceinline__ void ph_attn_vt(unsigned char* ws, LAS unsigned char* lds, int bid, int nb, int tid, int wave, int lane) {
    const bf16* zv = (const bf16*)(ws + WS_Z) + 10 * SEG; bf16* VT = (bf16*)(ws + WS_VT);
    LAS bf16* T = (LAS bf16*)lds; const int n = lane & 15, G = lane >> 4;
    for (int unit = bid; unit < NHEAD * (S_ / 256); unit += nb) { const int h = unit & 7, t0 = (unit >> 3) * 256;
#pragma unroll
        for (int ps = 0; ps < 8; ++ps) { const int i = (tid >> 4) + 32 * ps, c = tid & 15;
            *(LAS v4u*)(T + i * 136 + 8 * c) = *(const v4u*)(zv + (size_t)(t0 + i) * W_ + h * HD + 8 * c); }
        __syncthreads();
#pragma unroll
        for (int g = 0; g < 3; ++g) { const int dsh = 2 * g, dil = 1 << dsh, Lg = S_ >> dsh;
#pragma unroll
            for (int q = 0; q < 8; ++q) {
                const int runs = 8 >> dsh;
                if (g < 2) { const int rr = q / runs, run = q % runs;
                    const bf16x8 v = tr_frag_rs(T, 136, rr + 32 * run * dil, dil, 16 * wave, lane);
                    *(v4u*)(VT + vt_off(g, h, 16 * wave + n, rr, Lg, (t0 >> dsh) + 32 * run + 8 * G)) = __builtin_bit_cast(v4u, v); }
                else {
                    const int rr = 2 * q + (G >> 1);
                    const LAS bf16* p = T + (rr + 16 * (8 * (G & 1) + ((lane & 15) >> 2))) * 136 + 16 * wave + 4 * (lane & 3);
                    const s16x4 x = __builtin_amdgcn_ds_read_tr16_b64_v4i16((LAS s16x4*)p), y = __builtin_amdgcn_ds_read_tr16_b64_v4i16((LAS s16x4*)(p + 4 * 16 * 136));
                    const bf16x8 v = __builtin_shufflevector(x, y, 0, 1, 2, 3, 4, 5, 6, 7);
                    *(v4u*)(VT + vt_off(g, h, 16 * wave + n, rr, Lg, (t0 >> dsh) + 8 * (G & 1))) = __builtin_bit_cast(v4u, v); } } }
        __syncthreads();
    }
}
__device__ __forceinline__ void ph_attn_main(unsigned char* ws, int bid, int nb, int wave, int lane) {
    const bf16* QR = (const bf16*)(ws + WS_Z) + 8 * SEG; const bf16* KR = QR + SEG; const bf16* VT = (const bf16*)(ws + WS_VT); float2* ML = (float2*)(ws + WS_ML);
    const int n = lane & 15, G = lane >> 4;
    const int vb = (nb & 7) == 0 ? (bid & 7) * (nb >> 3) + (bid >> 3) : bid;
    for (int unit = vb * NWAVES + wave; unit < 3 * 4096; unit += nb * NWAVES) {
        const int g = unit >> 12, u = unit & 4095, dsh = 2 * g, Lg = S_ >> dsh, nqb = Lg >> 5, h = u >> 9, rr = (u & 511) / nqb, qb = (u & 511) - rr * nqb;
        bf16x8 bq[2][4];
#pragma unroll
        for (int qk = 0; qk < 2; ++qk) { const unsigned qofs = (unsigned)((((32 * qb + 16 * qk + n) << dsh) + rr) * (W_ * 2) + h * (HD * 2) + 16 * G);
#pragma unroll
            for (int kk = 0; kk < 4; ++kk) bq[qk][kk] = *(const bf16x8*)((const char*)QR + qofs + 64 * kk); }
        f32x4 acc[8][2]; float mrun[2] = {-1e30f, -1e30f}, lsum[2] = {0.f, 0.f};
#pragma unroll
        for (int db = 0; db < 8; ++db) { acc[db][0] = (f32x4){0.f, 0.f, 0.f, 0.f}; acc[db][1] = (f32x4){0.f, 0.f, 0.f, 0.f}; }
        const bf16* vtb = VT + vt_off(g, h, n, rr, Lg, 8 * G);
#define ATT_LDK(dst, kbase_) do { _Pragma("unroll") for (int b = 0; b < 2; ++b) { int lk = (kbase_) + 8 * (n >> 2) + 4 * b + (n & 3); lk = lk < 0 ? 0 : (lk >= Lg ? Lg - 1 : lk); \
            const unsigned kofs_ = (unsigned)(((lk << dsh) + rr) * (W_ * 2) + h * (HD * 2) + 16 * G); _Pragma("unroll") for (int kk = 0; kk < 4; ++kk) dst[b][kk] = *(const bf16x8*)((const char*)KR + kofs_ + 64 * kk); } } while (0)
        bf16x8 ak[2][2][4];
        const int koff = (5 - qb % 5) % 5;
#define ATT_SIDX(i_) (((i_) + koff) >= 5 ? (i_) + koff - 5 : (i_) + koff)
        ATT_LDK(ak[0], 32 * qb - 64 + 32 * ATT_SIDX(0));
#pragma unroll
        for (int step = 0; step < 5; ++step) { const int kbase = 32 * qb - 64 + 32 * ATT_SIDX(step), cb = step & 1;
            int kblk = kbase >> 5; kblk = kblk < 0 ? 0 : (kblk > (Lg >> 5) - 1 ? (Lg >> 5) - 1 : kblk);
            bf16x8 av[8]; const bf16* vstep = vtb + (size_t)kblk * (32 * HD);
#pragma unroll
            for (int db = 0; db < 8; ++db) av[db] = *(const bf16x8*)(vstep + db * 512);
#if ATT_EXP == 1
            if (step < 4) { _Pragma("unroll") for (int b_ = 0; b_ < 2; ++b_) _Pragma("unroll") for (int k_ = 0; k_ < 4; ++k_) ak[cb ^ 1][b_][k_] = ak[cb][b_][k_]; }
#else
            if (step < 4) ATT_LDK(ak[cb ^ 1], 32 * qb - 64 + 32 * ATT_SIDX(step + 1));
#endif
            f32x4 st[2][2];
#pragma unroll
            for (int b = 0; b < 2; ++b)
#pragma unroll
                for (int qk = 0; qk < 2; ++qk) { f32x4 s = (f32x4){0.f, 0.f, 0.f, 0.f};
#pragma unroll
                    for (int kk = 0; kk < 4; ++kk) s = __builtin_amdgcn_mfma_f32_16x16x32_bf16(ak[cb][b][kk], bq[qk][kk], s, 0, 0, 0);
                    st[qk][b] = s; }
            bf16x8 pb[2];
#pragma unroll
            for (int qk = 0; qk < 2; ++qk) { const int lq = 32 * qb + 16 * qk + n; float sv[8]; float mx = mrun[qk];
#pragma unroll
                for (int j = 0; j < 8; ++j) { const int lk = kbase + 8 * G + j; const int df = lk - lq; const bool valid = (lk >= 0) && (lk < Lg) && (df <= 64) && (df >= -64);
                    sv[j] = valid ? st[qk][j >> 2][j & 3] : -1e30f; mx = fmaxf(mx, sv[j]); }
                mx = fmaxf(mx, mk_bperm(lane ^ 16, mx)); mx = fmaxf(mx, mk_bperm(lane ^ 32, mx));
                const float alpha = __expf(mrun[qk] - mx); mrun[qk] = mx; float ps = 0.f; float p[8];
#pragma unroll
                for (int j = 0; j < 8; ++j) { p[j] = sv[j] > -1e29f ? __expf(sv[j] - mx) : 0.f; ps += p[j]; }
                lsum[qk] = lsum[qk] * alpha + ps;
                v4u pw; pw.x = cvtpk(p[0], p[1]); pw.y = cvtpk(p[2], p[3]); pw.z = cvtpk(p[4], p[5]); pw.w = cvtpk(p[6], p[7]); pb[qk] = __builtin_bit_cast(bf16x8, pw);
#pragma unroll
                for (int db = 0; db < 8; ++db) acc[db][qk] = acc[db][qk] * alpha; }
#pragma unroll
            for (int db = 0; db < 8; ++db) {
                acc[db][0] = __builtin_amdgcn_mfma_f32_16x16x32_bf16(av[db], pb[0], acc[db][0], 0, 0, 0); acc[db][1] = __builtin_amdgcn_mfma_f32_16x16x32_bf16(av[db], pb[1], acc[db][1], 0, 0, 0); }
        }
#undef ATT_LDK
#undef ATT_SIDX
        bf16* OP = op_ptr(ws, g);
#pragma unroll
        for (int qk = 0; qk < 2; ++qk) { float l = lsum[qk]; l += mk_bperm(lane ^ 16, l); l += mk_bperm(lane ^ 32, l); const float il = 1.0f / l;
            const size_t tq = ((size_t)(32 * qb + 16 * qk + n) << dsh) + rr;
#pragma unroll
            for (int db = 0; db < 8; ++db) { const f32x4 o = acc[db][qk] * il; v2u w; w.x = cvtpk(o[0], o[1]); w.y = cvtpk(o[2], o[3]); *(v2u*)(OP + tq * W_ + h * HD + 16 * db + 4 * G) = w; }
            if (G == 0) ML[((size_t)g * S_ + tq) * NHEAD + h] = make_float2(mrun[qk], l); }
    }
}
__device__ __forceinline__ void ph_attn_comb(unsigned char* ws, int bid, int nb, int tid) {
    const float2* ML = (const float2*)(ws + WS_ML); bf16* br = (bf16*)(ws + WS_BR) + 3 * SEG;
    const bf16* O0 = op_ptr(ws, 0); const bf16* O1 = op_ptr(ws, 1); const bf16* O2 = op_ptr(ws, 2);
#pragma unroll 4
    for (size_t i = (size_t)bid * NTHR + tid; i < SEG / 8; i += (size_t)nb * NTHR) { const size_t e = i * 8; const int t = (int)(e >> 10), h = (int)((e >> 7) & 7);
        const float2 a0 = ML[((size_t)0 * S_ + t) * NHEAD + h], a1 = ML[((size_t)1 * S_ + t) * NHEAD + h], a2 = ML[((size_t)2 * S_ + t) * NHEAD + h];
        const float M = fmaxf(a0.x, fmaxf(a1.x, a2.x)); float w0 = __expf(a0.x - M) * a0.y, w1 = __expf(a1.x - M) * a1.y, w2 = __expf(a2.x - M) * a2.y; const float iw = 1.0f / (w0 + w1 + w2); w0 *= iw; w1 *= iw; w2 *= iw;
        const v4u x0 = *(const v4u*)(O0 + e), x1 = *(const v4u*)(O1 + e), x2 = *(const v4u*)(O2 + e); v4u o;
        o.x = pk2(w0 * bflo(x0.x) + w1 * bflo(x1.x) + w2 * bflo(x2.x), w0 * bfhi(x0.x) + w1 * bfhi(x1.x) + w2 * bfhi(x2.x));
        o.y = pk2(w0 * bflo(x0.y) + w1 * bflo(x1.y) + w2 * bflo(x2.y), w0 * bfhi(x0.y) + w1 * bfhi(x1.y) + w2 * bfhi(x2.y));
        o.z = pk2(w0 * bflo(x0.z) + w1 * bflo(x1.z) + w2 * bflo(x2.z), w0 * bfhi(x0.z) + w1 * bfhi(x1.z) + w2 * bfhi(x2.z));
        o.w = pk2(w0 * bflo(x0.w) + w1 * bflo(x1.w) + w2 * bflo(x2.w), w0 * bfhi(x0.w) + w1 * bfhi(x1.w) + w2 * bfhi(x2.w));
        *(v4u*)(br + e) = o; }
}

__device__ __forceinline__ void unpack16(const v4u w0, const v4u w1, float (&o)[16]) { const unsigned ww[8] = {w0.x, w0.y, w0.z, w0.w, w1.x, w1.y, w1.z, w1.w};
#pragma unroll
    for (int i = 0; i < 8; ++i) { o[2 * i] = bflo(ww[i]); o[2 * i + 1] = bfhi(ww[i]); } }
__device__ __forceinline__ void pack16_store(LAS bf16* dst, const float (&v)[16]) { v4u o0, o1; o0.x = cvtpk(v[0], v[1]); o0.y = cvtpk(v[2], v[3]); o0.z = cvtpk(v[4], v[5]); o0.w = cvtpk(v[6], v[7]);
    o1.x = cvtpk(v[8], v[9]); o1.y = cvtpk(v[10], v[11]); o1.z = cvtpk(v[12], v[13]); o1.w = cvtpk(v[14], v[15]); *(LAS v4u*)dst = o0; *(LAS v4u*)(dst + 8) = o1; }
__device__ __forceinline__ void pack8_store(LAS bf16* dst, const float* v) { v4u o; o.x = cvtpk(v[0], v[1]); o.y = cvtpk(v[2], v[3]); o.z = cvtpk(v[4], v[5]); o.w = cvtpk(v[6], v[7]); *(LAS v4u*)dst = o; }
__device__ __forceinline__ void hg_gate_scan(const v4u za, const v4u zb, const LAS float* lb8, int lane, float (&lf)[16], float (&kk)[16]) {
    float zv[16]; unpack16(za, zb, zv);
    const f32x4 l0 = *(const LAS f32x4*)lb8, l1 = *(const LAS f32x4*)(lb8 + 4); const float lb[8] = {l0[0], l0[1], l0[2], l0[3], l1[0], l1[1], l1[2], l1[3]};
#pragma unroll
    for (int e = 0; e < 16; ++e) { const float l = lb[e & 7]; const float f = l + (1.0f - l) * __builtin_amdgcn_rcpf(1.0f + __expf(-zv[e])); kk[e] = 1.0f - f; lf[e] = __logf(f); }
#pragma unroll
    for (int i = 0; i < 8; ++i) { lf[8 + i] += lf[i]; float t = lf[8 + i];
        float v = mk_bperm((lane - 16) & 63, t); t += (lane >= 16) ? v : 0.f; v = mk_bperm((lane - 32) & 63, t); t += (lane >= 32) ? v : 0.f;
        const float ex = t - lf[8 + i]; lf[i] += ex; lf[8 + i] = t; }
}
__device__ __forceinline__ void ph_hgrn_h1(unsigned char* ws, LAS unsigned char* lds, int L, int bid, int nb, int tid, int wave, int lane) {
    const bf16* z = (const bf16*)(ws + WS_Z); const float* lbp = (const float*)(ws + WS_LB) + L * 2 * W_;
    bf16* HST = (bf16*)(ws + WS_HST); float* HDEC = (float*)(ws + WS_HDEC);
    LAS float* WT = (LAS float*)lds; LAS bf16* KD = (LAS bf16*)(lds + 4096); LAS bf16* IS = (LAS bf16*)(lds + 21504); LAS float* LB = (LAS float*)(lds + 38912);
    const int jp = tid >> 4, ja = 2 * jp, k0 = (tid & 15) * 8, n = lane & 15, G = lane >> 4;
    if (bid >= 256 * NHEAD) return;
    const bool fixed_head = (nb & 7) == 0;
    if (fixed_head && tid < 256) LB[tid] = lbp[(tid >> 7) * W_ + (bid & 7) * HD + (tid & 127)];
    v4u pf[4];
#define H1_FETCH(item_, dir_) do { const int c_ = (item_) >> 3, h_ = (item_) & 7; const size_t oa_ = (size_t)(c_ * 64 + ((dir_) ? 63 - ja : ja)) * W_ + h_ * HD + k0, ob_ = (size_t)(c_ * 64 + ((dir_) ? 62 - ja : ja + 1)) * W_ + h_ * HD + k0; \
        pf[0] = *(const v4u*)(z + (size_t)(1 + (dir_)) * SEG + oa_); pf[1] = *(const v4u*)(z + (size_t)(1 + (dir_)) * SEG + ob_); pf[2] = *(const v4u*)(z + (size_t)3 * SEG + oa_); pf[3] = *(const v4u*)(z + (size_t)3 * SEG + ob_); } while (0)
    H1_FETCH(bid, 0);
    for (int item = bid; item < 256 * NHEAD; item += nb) { const int c = item >> 3, h = item & 7;
        if (!fixed_head) { __syncthreads(); if (tid < 256) LB[tid] = lbp[(tid >> 7) * W_ + h * HD + (tid & 127)]; __syncthreads(); }
#pragma unroll 1
        for (int dir = 0; dir < 2; ++dir) {
            const v4u f0 = pf[0], f1 = pf[1], i0 = pf[2], i1 = pf[3];
            if (dir == 0) H1_FETCH(item, 1); else if (item + nb < 256 * NHEAD) H1_FETCH(item + nb, 0);
            if (dir == 0 && item == bid) __syncthreads();
            float lf[16], kk[16]; hg_gate_scan(f0, f1, LB + dir * 128 + k0, lane, lf, kk);
            if (G == 3) { *(LAS f32x4*)(WT + wave * 128 + k0) = (f32x4){lf[8], lf[9], lf[10], lf[11]}; *(LAS f32x4*)(WT + wave * 128 + k0 + 4) = (f32x4){lf[12], lf[13], lf[14], lf[15]}; }
            __syncthreads();
            *(LAS v4u*)(IS + ja * 136 + k0) = i0; *(LAS v4u*)(IS + (ja + 1) * 136 + k0) = i1;
            { float pre[8], tot[8];
#pragma unroll
              for (int i = 0; i < 8; ++i) { pre[i] = 0.f; tot[i] = 0.f; }
#pragma unroll
              for (int w = 0; w < 8; ++w)
#pragma unroll
                  for (int q = 0; q < 2; ++q) { const f32x4 t4 = *(const LAS f32x4*)(WT + w * 128 + k0 + 4 * q);
#pragma unroll
                      for (int e = 0; e < 4; ++e) { tot[4 * q + e] += t4[e]; if (w < wave) pre[4 * q + e] += t4[e]; } }
              float kd[16];
#pragma unroll
              for (int e = 0; e < 16; ++e) kd[e] = kk[e] * __expf(tot[e & 7] - (lf[e] + pre[e & 7]));
              pack8_store(KD + ja * 136 + k0, kd); pack8_store(KD + (ja + 1) * 136 + k0, kd + 8);
              if (jp == 0) { float* hd = HDEC + (((size_t)dir * 256 + c) * 8 + h) * 128 + k0;
                  *(f32x4*)hd = (f32x4){__expf(tot[0]), __expf(tot[1]), __expf(tot[2]), __expf(tot[3])}; *(f32x4*)(hd + 4) = (f32x4){__expf(tot[4]), __expf(tot[5]), __expf(tot[6]), __expf(tot[7])}; } }
            __syncthreads();
            if (HG_EXP != 2) { const bf16x8 a0 = tr_frag(KD, 136, 0, 16 * wave, lane), a1 = tr_frag(KD, 136, 32, 16 * wave, lane);
              bf16* dst = HST + ((((size_t)dir * 256 + c) * 8 + h) * 128) * 128 + (wave >> 1) * 4096 + 16 * (wave & 1) + 4 * G;
#pragma unroll
              for (int vb = 0; vb < 8; ++vb) { const bf16x8 b0 = tr_frag(IS, 136, 0, 16 * vb, lane), b1 = tr_frag(IS, 136, 32, 16 * vb, lane);
                  f32x4 u = (f32x4){0.f, 0.f, 0.f, 0.f}; u = __builtin_amdgcn_mfma_f32_16x16x32_bf16(a0, b0, u, 0, 0, 0); u = __builtin_amdgcn_mfma_f32_16x16x32_bf16(a1, b1, u, 0, 0, 0);
                  v2u w; w.x = cvtpk(u[0], u[1]); w.y = cvtpk(u[2], u[3]); *(v2u*)(dst + (16 * vb + n) * 32) = w; } }
        }
    }
    __syncthreads();
#undef H1_FETCH
}
__device__ __forceinline__ void ph_hgrn_h2(unsigned char* ws, int bid, int nb, int tid) {
    unsigned* HST = (unsigned*)(ws + WS_HST); const float2* HDEC = (const float2*)(ws + WS_HDEC);
    for (int g = bid * NTHR + tid; g < 131072; g += nb * NTHR) { const int kp = g & 63, v = (g >> 6) & 127, h = (g >> 13) & 7, dir = g >> 16;
        const int kq = (((v >> 5) & 3) << 4) | (kp & 15);
        unsigned* base = HST + ((size_t)dir * 256 * 8 + h) * 8192 + v * 64 + kp; const float2* dec = HDEC + ((size_t)dir * 256 * 8 + h) * 64 + kq;
        float s0 = 0.f, s1 = 0.f;
        for (int cc = 0; cc < 256; cc += 8) { unsigned u[8]; float2 d[8];
#pragma unroll
            for (int j = 0; j < 8; ++j) { const int c = dir ? 255 - (cc + j) : cc + j; u[j] = base[(size_t)c * 65536]; d[j] = dec[(size_t)c * 512]; }
#pragma unroll
            for (int j = 0; j < 8; ++j) { const int c = dir ? 255 - (cc + j) : cc + j; s0 = d[j].x * s0 + bflo(u[j]); s1 = d[j].y * s1 + bfhi(u[j]); base[(size_t)c * 65536] = pk2(s0, s1); } }
    }
}
__device__ __forceinline__ void ph_hgrn_h3(unsigned char* ws, LAS unsigned char* lds, const float* onorm, int L, int bid, int nb, int tid, int wave, int lane) {
    const bf16* z = (const bf16*)(ws + WS_Z); const float* lbp = (const float*)(ws + WS_LB) + L * 2 * W_; const bf16* HST = (const bf16*)(ws + WS_HST); bf16* br = (bf16*)(ws + WS_BR);
    LAS float* WT = (LAS float*)lds; LAS bf16* QB = (LAS bf16*)(lds + 4096); LAS bf16* QT = (LAS bf16*)(lds + 21504); LAS bf16* KT = (LAS bf16*)(lds + 38912); LAS bf16* IS = (LAS bf16*)(lds + 82432);
    LAS float* RED = (LAS float*)(lds + 99840); LAS float* LB = (LAS float*)(lds + 101888);
    const int jp = tid >> 4, ja = 2 * jp, k0 = (tid & 15) * 8, n = lane & 15, G = lane >> 4, si = wave >> 1;
    if (bid >= 256 * NHEAD) return;
    const bool fixed_head = (nb & 7) == 0;
    if (fixed_head && tid < 256) LB[tid] = lbp[(tid >> 7) * W_ + (bid & 7) * HD + (tid & 127)];
    v4u pf[6];
#define H3_FETCH(item_, dir_) do { const int c_ = (item_) >> 3, h_ = (item_) & 7; const size_t oa_ = (size_t)(c_ * 64 + ((dir_) ? 63 - ja : ja)) * W_ + h_ * HD + k0, ob_ = (size_t)(c_ * 64 + ((dir_) ? 62 - ja : ja + 1)) * W_ + h_ * HD + k0; \
        pf[0] = *(const v4u*)(z + (size_t)(1 + (dir_)) * SEG + oa_); pf[1] = *(const v4u*)(z + (size_t)(1 + (dir_)) * SEG + ob_); pf[2] = *(const v4u*)(z + oa_); pf[3] = *(const v4u*)(z + ob_); \
        pf[4] = *(const v4u*)(z + (size_t)3 * SEG + oa_); pf[5] = *(const v4u*)(z + (size_t)3 * SEG + ob_); } while (0)
    H3_FETCH(bid, 0);
    for (int item = bid; item < 256 * NHEAD; item += nb) { const int c = item >> 3, h = item & 7, t0 = c * 64;
        if (!fixed_head) { __syncthreads(); if (tid < 256) LB[tid] = lbp[(tid >> 7) * W_ + h * HD + (tid & 127)]; __syncthreads(); }
        v2u gpre[4];
#pragma unroll
        for (int x = 0; x < 4; ++x) gpre[x] = *(const v2u*)(z + (size_t)4 * SEG + (size_t)(t0 + 16 * x + n) * W_ + h * HD + 16 * wave + 4 * G);
        f32x4 acc[4];
#pragma unroll
        for (int x = 0; x < 4; ++x) acc[x] = (f32x4){0.f, 0.f, 0.f, 0.f};
#pragma unroll 1
        for (int dir = 0; dir < 2; ++dir) {
            const v4u f0 = pf[0], f1 = pf[1], q0 = pf[2], q1 = pf[3], i0 = pf[4], i1 = pf[5];
            if (dir == 0) H3_FETCH(item, 1); else if (item + nb < 256 * NHEAD) H3_FETCH(item + nb, 0);
            const int cs = dir ? c + 1 : c - 1; const bool has_state = (cs >= 0 && cs < 256);
            bf16x8 as[4];
            if (has_state) { const bf16* sp = HST + (((size_t)dir * 256 + cs) * 8 + h) * 16384 + (16 * wave + n) * 32 + 8 * G;
#pragma unroll
                for (int ks = 0; ks < 4; ++ks) as[ks] = *(const bf16x8*)(sp + 4096 * ks); }
            if (dir == 0 && item == bid) __syncthreads();
            float lf[16], kk[16]; hg_gate_scan(f0, f1, LB + dir * 128 + k0, lane, lf, kk);
            if (G == 3) { *(LAS f32x4*)(WT + wave * 128 + k0) = (f32x4){lf[8], lf[9], lf[10], lf[11]}; *(LAS f32x4*)(WT + wave * 128 + k0 + 4) = (f32x4){lf[12], lf[13], lf[14], lf[15]}; }
            __syncthreads();
            *(LAS v4u*)(IS + ja * 136 + k0) = i0; *(LAS v4u*)(IS + (ja + 1) * 136 + k0) = i1;
            { float qs[16]; unpack16(q0, q1, qs);
#pragma unroll
              for (int e = 0; e < 16; ++e) qs[e] = qs[e] * __builtin_amdgcn_rcpf(1.0f + __expf(-qs[e]));
#pragma unroll
              for (int w = 0; w < 7; ++w) { if (w < wave) {
#pragma unroll
                  for (int q = 0; q < 2; ++q) { const f32x4 t4 = *(const LAS f32x4*)(WT + w * 128 + k0 + 4 * q);
#pragma unroll
                      for (int e = 0; e < 4; ++e) { lf[4 * q + e] += t4[e]; lf[8 + 4 * q + e] += t4[e]; } } } }
              float tmp[16];
#pragma unroll
              for (int e = 0; e < 16; ++e) tmp[e] = qs[e] * __expf(lf[e]);
              pack8_store(QB + ja * 136 + k0, tmp); pack8_store(QB + (ja + 1) * 136 + k0, tmp + 8);
              float ref[8];
#pragma unroll
              for (int i = 0; i < 8; ++i) ref[i] = 0.f;
#pragma unroll
              for (int it = 0; it < 4; ++it) {
                  if (it > 0) {
#pragma unroll
                      for (int w = 2 * it - 2; w < 2 * it; ++w)
#pragma unroll
                          for (int q = 0; q < 2; ++q) { const f32x4 t4 = *(const LAS f32x4*)(WT + w * 128 + k0 + 4 * q); ref[4 * q] += t4[0]; ref[4 * q + 1] += t4[1]; ref[4 * q + 2] += t4[2]; ref[4 * q + 3] += t4[3]; } }
                  if (si == it) {
#pragma unroll
                      for (int e = 0; e < 16; ++e) tmp[e] = qs[e] * __expf(lf[e] - ref[e & 7]);
                      pack8_store(QT + ja * 136 + k0, tmp); pack8_store(QT + (ja + 1) * 136 + k0, tmp + 8); }
                  if (si <= it) {
#pragma unroll
                      for (int e = 0; e < 16; ++e) tmp[e] = kk[e] * __expf(fminf(ref[e & 7] - lf[e], 80.f));
                      pack8_store(KT + (8 * it * (it + 1) + ja) * 136 + k0, tmp); pack8_store(KT + (8 * it * (it + 1) + ja + 1) * 136 + k0, tmp + 8); } } }
            __syncthreads();
            if (has_state) {
#pragma unroll
                for (int x = 0; x < 4; ++x) { const int jt = dir ? 63 - 16 * x - n : 16 * x + n;
#pragma unroll
                    for (int ks = 0; ks < 4; ++ks) { const bf16x8 b = *(const LAS bf16x8*)(QB + jt * 136 + 32 * ks + 8 * G); acc[x] = __builtin_amdgcn_mfma_f32_16x16x32_bf16(as[ks], b, acc[x], 0, 0, 0); } } }
#pragma unroll
            for (int x = 0; x < 4; ++x) { const int jt = dir ? 63 - 16 * x - n : 16 * x + n; const int it = dir ? 3 - x : x; const int kb = 8 * it * (it + 1);
                bf16x8 bqt[4];
#pragma unroll
                for (int ks = 0; ks < 4; ++ks) bqt[ks] = *(const LAS bf16x8*)(QT + jt * 136 + 32 * ks + 8 * G);
#pragma unroll
                for (int p = 0; p < 2; ++p) { if (p <= (it >> 1)) {
                    float pv[8];
#pragma unroll
                    for (int b = 0; b < 2; ++b) { const int js = 32 * p + 8 * (n >> 2) + 4 * b + (n & 3); f32x4 sc = (f32x4){0.f, 0.f, 0.f, 0.f};
#pragma unroll
                        for (int ks = 0; ks < 4; ++ks) { const bf16x8 ak = *(const LAS bf16x8*)(KT + (kb + js) * 136 + 32 * ks + 8 * G); sc = __builtin_amdgcn_mfma_f32_16x16x32_bf16(ak, bqt[ks], sc, 0, 0, 0); }
#pragma unroll
                        for (int r = 0; r < 4; ++r) { const int jsr = 32 * p + 8 * G + 4 * b + r; pv[4 * b + r] = (jsr <= jt) ? sc[r] : 0.f; } }
                    v4u pw; pw.x = cvtpk(pv[0], pv[1]); pw.y = cvtpk(pv[2], pv[3]); pw.z = cvtpk(pv[4], pv[5]); pw.w = cvtpk(pv[6], pv[7]);
                    const bf16x8 av = tr_frag(IS, 136, 32 * p, 16 * wave, lane);
                    acc[x] = __builtin_amdgcn_mfma_f32_16x16x32_bf16(av, __builtin_bit_cast(bf16x8, pw), acc[x], 0, 0, 0); } } }
        }
#pragma unroll
        for (int x = 0; x < 4; ++x) { float ss = acc[x][0] * acc[x][0] + acc[x][1] * acc[x][1] + acc[x][2] * acc[x][2] + acc[x][3] * acc[x][3]; ss += mk_bperm(lane ^ 16, ss); ss += mk_bperm(lane ^ 32, ss); if (G == 0) RED[wave * 64 + 16 * x + n] = ss; }
        __syncthreads();
        { const int ch = h * HD + 16 * wave + 4 * G; const f32x4 on = *(const f32x4*)(onorm + ch);
#pragma unroll
          for (int x = 0; x < 4; ++x) { const int tl = 16 * x + n; float tot = 0.f;
#pragma unroll
            for (int w = 0; w < 8; ++w) tot += RED[w * 64 + tl];
            const float rs = rsqrtf(tot * (1.0f / HD) + RMS_EPS); const size_t o = (size_t)(t0 + tl) * W_ + ch; const v2u gw = gpre[x];
            v2u w; w.x = cvtpk(acc[x][0] * rs * on[0] * siluf_(bflo(gw.x)), acc[x][1] * rs * on[1] * siluf_(bfhi(gw.x))); w.y = cvtpk(acc[x][2] * rs * on[2] * siluf_(bflo(gw.y)), acc[x][3] * rs * on[3] * siluf_(bfhi(gw.y)));
            *(v2u*)(br + o) = w; } }
    }
    __syncthreads();
#undef H3_FETCH
}
template <int D> __device__ __forceinline__ float dpp_shr(float v, float old) { return __builtin_bit_cast(float, __builtin_amdgcn_update_dpp(__builtin_bit_cast(int, old), __builtin_bit_cast(int, v), 0x110 | D, 0xf, 0xf, false)); }
template <int D> __device__ __forceinline__ float dpp_shl(float v, float old) { return __builtin_bit_cast(float, __builtin_amdgcn_update_dpp(__builtin_bit_cast(int, old), __builtin_bit_cast(int, v), 0x100 | D, 0xf, 0xf, false)); }
template <bool BWD, int D> __device__ __forceinline__ void scan_step(float& av, float& uv) { const float al = BWD ? dpp_shl<D>(av, 1.0f) : dpp_shr<D>(av, 1.0f), ul = BWD ? dpp_shl<D>(uv, 0.0f) : dpp_shr<D>(uv, 0.0f); uv = av * ul + uv; av = al * av; }
template <bool FINAL>
__device__ __forceinline__ void ph_lru(const Args& a, unsigned char* ws, LAS unsigned char* lds, int L, int bid, int nb, int tid, int wave, int lane) {
    const bf16* zx = (const bf16*)(ws + WS_Z) + 5 * SEG; const bf16* zg = (const bf16*)(ws + WS_Z) + 6 * SEG; bf16* br = (bf16*)(ws + WS_BR) + SEG;
    const bf16* LW = (const bf16*)(ws + WS_LRUW); float2* LSUM = (float2*)(ws + WS_LSUM); const float* LCIN = (const float*)(ws + WS_LCIN);
    LAS bf16* XT = (LAS bf16*)lds; LAS bf16* XCB = (LAS bf16*)(lds + 19040); LAS float* CW = (LAS float*)(lds + 36448);
    const int tr = tid >> 3, c0 = (tid & 7) * 16, n = lane & 15, G = lane >> 4;
    if (bid >= 256 * NHEAD) return;
    const bool fixed_head = (nb & 7) == 0;
#define LRU_LOAD_PARAMS(hh_) do { for (int q = tid; q < 2 * 8 * 128; q += NTHR) { const int dir_ = q >> 10, j_ = (q >> 7) & 7, c_ = q & 127, ch_ = (hh_) * HD + c_, pi_ = (L * 2 + dir_) * W_ + ch_; float v_; \
            if (j_ < 4) v_ = a.lru_conv_w[((size_t)(L * 2 + dir_) * 4 + j_) * W_ + ch_]; else if (j_ == 4) v_ = a.lru_conv_b[pi_]; else if (j_ == 5) v_ = a.lru_ba[pi_]; else if (j_ == 6) v_ = a.lru_bx[pi_]; else v_ = log1pf(__expf(-a.lru_lambda[pi_])); \
            CW[q] = v_; } } while (0)
    if (fixed_head) LRU_LOAD_PARAMS(bid & 7);
    v4u xpre[3];
#define LRU_FETCH_X(item_) do { const int tile_ = (item_) >> 3, hh_ = (item_) & 7, t0_ = tile_ * 64; \
        _Pragma("unroll") for (int p = 0; p < 3; ++p) { const int q = tid + p * NTHR, row = q >> 4, c = q & 15, t = t0_ - 3 + row; xpre[p] = (v4u){0u, 0u, 0u, 0u}; \
            if (q < 70 * 16 && t >= 0 && t < S_) xpre[p] = *(const v4u*)(zx + (size_t)t * W_ + hh_ * HD + 8 * c); } } while (0)
    LRU_FETCH_X(bid);
    for (int item = bid; item < 256 * NHEAD; item += nb) { const int tile = item >> 3, hh = item & 7, t0 = tile * 64;
        if (!fixed_head) { __syncthreads(); LRU_LOAD_PARAMS(hh); }
#pragma unroll
        for (int p = 0; p < 3; ++p) { const int q = tid + p * NTHR, row = q >> 4, c = q & 15; if (q < 70 * 16) *(LAS v4u*)(XT + row * 136 + 8 * c) = xpre[p]; }
        if (item + nb < 256 * NHEAD) LRU_FETCH_X(item + nb);
        const int chl = hh * HD + 16 * wave + 4 * G;
        v2u gpre[4]; f32x4 cin[2];
        if (FINAL) {
#pragma unroll
            for (int tb = 0; tb < 4; ++tb) gpre[tb] = *(const v2u*)(zg + (size_t)(t0 + 16 * tb + n) * W_ + chl);
            cin[0] = *(const f32x4*)(LCIN + (size_t)(tile * 2 + 0) * W_ + chl); cin[1] = *(const f32x4*)(LCIN + (size_t)(tile * 2 + 1) * W_ + chl); }
        __syncthreads();
        f32x4 yacc[4];
#pragma unroll
        for (int tb = 0; tb < 4; ++tb) yacc[tb] = (f32x4){0.f, 0.f, 0.f, 0.f};
#pragma unroll 1
        for (int dir = 0; dir < 2; ++dir) {
            const bf16* wap = LW + ((size_t)((L * 2 + dir) * 8 + hh)) * 16384 + (16 * wave + n) * 128 + 8 * G; const bf16* wxp = wap + (size_t)64 * 16384;
            bf16x8 wA[4], wX[4];
#pragma unroll
            for (int ks = 0; ks < 4; ++ks) { wA[ks] = *(const bf16x8*)(wap + 32 * ks); wX[ks] = *(const bf16x8*)(wxp + 32 * ks); }
            { float xc[16]; const LAS float* cwl = CW + dir * 1024 + c0;
#pragma unroll
              for (int q = 0; q < 4; ++q) { const f32x4 b4 = *(const LAS f32x4*)(cwl + 4 * 128 + 4 * q); xc[4 * q] = b4[0]; xc[4 * q + 1] = b4[1]; xc[4 * q + 2] = b4[2]; xc[4 * q + 3] = b4[3]; }
#pragma unroll
              for (int j = 0; j < 4; ++j) { const int row = dir ? tr + 6 - j : tr + j;
                  const v4u w0 = *(const LAS v4u*)(XT + row * 136 + c0), w1 = *(const LAS v4u*)(XT + row * 136 + c0 + 8); const unsigned ww[8] = {w0.x, w0.y, w0.z, w0.w, w1.x, w1.y, w1.z, w1.w};
#pragma unroll
                  for (int q = 0; q < 4; ++q) { const f32x4 w4 = *(const LAS f32x4*)(cwl + j * 128 + 4 * q);
#pragma unroll
                      for (int e = 0; e < 4; ++e) { const int i = 4 * q + e; xc[i] += w4[e] * ((i & 1) ? bfhi(ww[i >> 1]) : bflo(ww[i >> 1])); } } }
              v4u o0, o1; o0.x = cvtpk(xc[0], xc[1]); o0.y = cvtpk(xc[2], xc[3]); o0.z = cvtpk(xc[4], xc[5]); o0.w = cvtpk(xc[6], xc[7]); o1.x = cvtpk(xc[8], xc[9]); o1.y = cvtpk(xc[10], xc[11]); o1.z = cvtpk(xc[12], xc[13]); o1.w = cvtpk(xc[14], xc[15]);
              *(LAS v4u*)(XCB + tr * 136 + c0) = o0; *(LAS v4u*)(XCB + tr * 136 + c0 + 8) = o1; }
            __syncthreads();
            { f32x4 ar[4], ai[4];
#pragma unroll
              for (int tb = 0; tb < 4; ++tb) { ar[tb] = (f32x4){0.f, 0.f, 0.f, 0.f}; ai[tb] = (f32x4){0.f, 0.f, 0.f, 0.f}; }
#pragma unroll
              for (int ks = 0; ks < 4; ++ks)
#pragma unroll
                  for (int tb = 0; tb < 4; ++tb) { const bf16x8 xf = *(const LAS bf16x8*)(XCB + (16 * tb + n) * 136 + 32 * ks + 8 * G);
                      ar[tb] = __builtin_amdgcn_mfma_f32_16x16x32_bf16(wA[ks], xf, ar[tb], 0, 0, 0); ai[tb] = __builtin_amdgcn_mfma_f32_16x16x32_bf16(wX[ks], xf, ai[tb], 0, 0, 0); }
              const LAS float* pl = CW + dir * 1024 + 16 * wave + 4 * G; const f32x4 ba = *(const LAS f32x4*)(pl + 5 * 128), bx = *(const LAS f32x4*)(pl + 6 * 128), sp = *(const LAS f32x4*)(pl + 7 * 128);
#pragma unroll
              for (int tb = 0; tb < 4; ++tb) { const v2u xw = *(const LAS v2u*)(XCB + (16 * tb + n) * 136 + 16 * wave + 4 * G); const float xv[4] = {bflo(xw.x), bfhi(xw.x), bflo(xw.y), bfhi(xw.y)};
#pragma unroll
                  for (int r = 0; r < 4; ++r) { const float rg = __builtin_amdgcn_rcpf(1.0f + __expf(-(ar[tb][r] + ba[r]))), ig = __builtin_amdgcn_rcpf(1.0f + __expf(-(ai[tb][r] + bx[r]))); const float la = -8.0f * rg * sp[r];
                      const float av = __expf(la); ar[tb][r] = av; ai[tb][r] = sqrtf(fmaxf(1.0f - av * av, 0.0f)) * (ig * xv[r]); } }
#pragma unroll
              for (int tb = 0; tb < 4; ++tb)
#pragma unroll
                  for (int r = 0; r < 4; ++r) { float av = ar[tb][r], uv = ai[tb][r];
                      if (dir == 0) { scan_step<false, 1>(av, uv); scan_step<false, 2>(av, uv); scan_step<false, 4>(av, uv); scan_step<false, 8>(av, uv); }
                      else { scan_step<true, 1>(av, uv); scan_step<true, 2>(av, uv); scan_step<true, 4>(av, uv); scan_step<true, 8>(av, uv); }
                      ar[tb][r] = av; ai[tb][r] = uv; }
              const int lastlane = (lane & 48) | (dir ? 0 : 15);
              f32x4 hc, pc = (f32x4){1.f, 1.f, 1.f, 1.f};
              if (FINAL) hc = dir ? cin[1] : cin[0]; else hc = (f32x4){0.f, 0.f, 0.f, 0.f};
#pragma unroll
              for (int s = 0; s < 4; ++s) { const int tb = dir ? 3 - s : s;
                  { f32x4 at;
#pragma unroll
                  for (int r = 0; r < 4; ++r) { const float h = ar[tb][r] * hc[r] + ai[tb][r]; yacc[tb][r] += h; hc[r] = mk_bperm(lastlane, h);
                      if (!FINAL) { at[r] = ar[tb][r] * pc[r]; pc[r] = mk_bperm(lastlane, at[r]); } }
                  if (!FINAL) { v2u w; w.x = cvtpk(at[0], at[1]); w.y = cvtpk(at[2], at[3]); *(v2u*)((bf16*)(ws + (dir ? WS_LAB : WS_LAF)) + (size_t)(t0 + 16 * tb + n) * W_ + chl) = w; } } }
              if (!FINAL && n == 0) {
#pragma unroll
                  for (int r = 0; r < 4; ++r) LSUM[(size_t)(tile * 2 + dir) * W_ + chl + r] = make_float2(pc[r], hc[r]); } }
            __syncthreads();
        }
        if (!FINAL) {
#pragma unroll
            for (int tb = 0; tb < 4; ++tb) { v2u w; w.x = cvtpk(yacc[tb][0], yacc[tb][1]); w.y = cvtpk(yacc[tb][2], yacc[tb][3]); *(v2u*)((bf16*)(ws + WS_LSU) + (size_t)(t0 + 16 * tb + n) * W_ + chl) = w; } }
        if (FINAL) {
#pragma unroll
            for (int tb = 0; tb < 4; ++tb) { const size_t o = (size_t)(t0 + 16 * tb + n) * W_ + chl; const v2u gw = gpre[tb];
                v2u w; w.x = cvtpk(yacc[tb][0] * gelu_tanh(bflo(gw.x)), yacc[tb][1] * gelu_tanh(bfhi(gw.x))); w.y = cvtpk(yacc[tb][2] * gelu_tanh(bflo(gw.y)), yacc[tb][3] * gelu_tanh(bfhi(gw.y)));
                *(v2u*)(br + o) = w; } }
    }
    __syncthreads();
}

__device__ __forceinline__ void ph_lru_out(unsigned char* ws, int bid, int nb, int tid) {
    const bf16* SU = (const bf16*)(ws + WS_LSU); const bf16* AF = (const bf16*)(ws + WS_LAF); const bf16* AB = (const bf16*)(ws + WS_LAB); const float* LCIN = (const float*)(ws + WS_LCIN);
    const bf16* zg = (const bf16*)(ws + WS_Z) + 6 * SEG; bf16* br = (bf16*)(ws + WS_BR) + SEG;
#pragma unroll 4
    for (size_t i = (size_t)bid * NTHR + tid; i < SEG / 8; i += (size_t)nb * NTHR) { const size_t e = i * 8; const int t = (int)(e >> 10), ch = (int)(e & (W_ - 1)), tile = t >> 6;
        const v4u su = __builtin_nontemporal_load((const v4u*)(SU + e)), af = __builtin_nontemporal_load((const v4u*)(AF + e)), ab = __builtin_nontemporal_load((const v4u*)(AB + e)), gw = __builtin_nontemporal_load((const v4u*)(zg + e));
        const f32x4 hf0 = *(const f32x4*)(LCIN + (size_t)(tile * 2) * W_ + ch), hf1 = *(const f32x4*)(LCIN + (size_t)(tile * 2) * W_ + ch + 4), hb0 = *(const f32x4*)(LCIN + (size_t)(tile * 2 + 1) * W_ + ch), hb1 = *(const f32x4*)(LCIN + (size_t)(tile * 2 + 1) * W_ + ch + 4);
        float s[8], f[8], b[8], g[8]; unpack8(su, s); unpack8(af, f); unpack8(ab, b); unpack8(gw, g);
        const float hf[8] = {hf0[0], hf0[1], hf0[2], hf0[3], hf1[0], hf1[1], hf1[2], hf1[3]}, hb[8] = {hb0[0], hb0[1], hb0[2], hb0[3], hb1[0], hb1[1], hb1[2], hb1[3]};
        float y[8];
#pragma unroll
        for (int j = 0; j < 8; ++j) y[j] = (s[j] + f[j] * hf[j] + b[j] * hb[j]) * gelu_tanh(g[j]);
        v4u o; o.x = cvtpk(y[0], y[1]); o.y = cvtpk(y[2], y[3]); o.z = cvtpk(y[4], y[5]); o.w = cvtpk(y[6], y[7]);
        *(v4u*)(br + e) = o; }
}
__device__ __forceinline__ void ph_lru_carry(unsigned char* ws, LAS unsigned char* lds, int bid, int tid, int wave, int lane) {
    if (bid >= 32) return;
    const int chain = bid * 64 + lane, dir = chain >> 10, ch = chain & (W_ - 1), seg = wave; const float2* LSUM = (const float2*)(ws + WS_LSUM); float* LCIN = (float*)(ws + WS_LCIN);
    LAS f32x2_t* SEGS = (LAS f32x2_t*)lds;
    float2 sv[32];
#pragma unroll
    for (int i = 0; i < 32; ++i) { const int kp = 32 * seg + i, k = dir ? 255 - kp : kp; sv[i] = LSUM[(size_t)(k * 2 + dir) * W_ + ch]; }
    float p = 1.f, h = 0.f;
#pragma unroll
    for (int i = 0; i < 32; ++i) { h = sv[i].x * h + sv[i].y; p *= sv[i].x; }
    SEGS[seg * 64 + lane] = (f32x2_t){p, h};
    __syncthreads();
    float c = 0.f;
#pragma unroll
    for (int s = 0; s < 7; ++s) { if (s < seg) { const f32x2_t q = SEGS[s * 64 + lane]; c = q[0] * c + q[1]; } }
#pragma unroll
    for (int i = 0; i < 32; ++i) { const int kp = 32 * seg + i, k = dir ? 255 - kp : kp; LCIN[(size_t)(k * 2 + dir) * W_ + ch] = c; c = sv[i].x * c + sv[i].y; }
    __syncthreads();
}
__device__ __forceinline__ void ph_pool(const Args& a, unsigned char* ws, LAS unsigned char* lds, int L, int bid, int nb, int tid, int wave, int lane) {
    const bf16* zp = (const bf16*)(ws + WS_Z) + 7 * SEG; bf16* br = (bf16*)(ws + WS_BR) + 2 * SEG; const bf16* PW = (const bf16*)(ws + WS_POOLW);
    LAS bf16* XP = (LAS bf16*)lds; LAS bf16* DT = (LAS bf16*)(lds + 42240);
    const int tr = tid >> 3, c0 = (tid & 7) * 32, n = lane & 15, G = lane >> 4;
    for (int item = bid; item < 256 * 4; item += nb) { const int tile = item >> 2, gi = item & 3, t0 = tile * 64, w2 = 1 << gi;
        for (int q = tid; q < 80 * 32; q += NTHR) { const int row = q >> 5, c = q & 31, t = t0 - 8 + row; v4u v = (v4u){0u, 0u, 0u, 0u};
            if (t >= 0 && t < S_) v = *(const v4u*)(zp + (size_t)t * W_ + gi * 256 + 8 * c);
            *(LAS v4u*)(XP + row * 264 + 8 * c) = v; }
        __syncthreads();
        { const int t = t0 + tr, lo = max(t - w2, 0), hi = min(t + w2, S_); const float ic = 1.0f / (float)(hi - lo); float sm[32];
#pragma unroll
          for (int i = 0; i < 32; ++i) sm[i] = 0.f;
          for (int tt = lo; tt < hi; ++tt) { const LAS bf16* xr = XP + (tt - t0 + 8) * 264 + c0;
#pragma unroll
              for (int q = 0; q < 4; ++q) { const v4u w = *(const LAS v4u*)(xr + 8 * q);
                  sm[8 * q + 0] += bflo(w.x); sm[8 * q + 1] += bfhi(w.x); sm[8 * q + 2] += bflo(w.y); sm[8 * q + 3] += bfhi(w.y); sm[8 * q + 4] += bflo(w.z); sm[8 * q + 5] += bfhi(w.z); sm[8 * q + 6] += bflo(w.w); sm[8 * q + 7] += bfhi(w.w); } }
          const LAS bf16* xs = XP + (tr + 8) * 264 + c0;
#pragma unroll
          for (int q = 0; q < 4; ++q) { const v4u w = *(const LAS v4u*)(xs + 8 * q); v4u o;
              o.x = cvtpk(sm[8 * q + 0] * ic - bflo(w.x), sm[8 * q + 1] * ic - bfhi(w.x)); o.y = cvtpk(sm[8 * q + 2] * ic - bflo(w.y), sm[8 * q + 3] * ic - bfhi(w.y));
              o.z = cvtpk(sm[8 * q + 4] * ic - bflo(w.z), sm[8 * q + 5] * ic - bfhi(w.z)); o.w = cvtpk(sm[8 * q + 6] * ic - bflo(w.w), sm[8 * q + 7] * ic - bfhi(w.w));
              *(LAS v4u*)(DT + tr * 264 + c0 + 8 * q) = o; } }
        __syncthreads();
        { f32x4 acc[2][4];
#pragma unroll
          for (int x = 0; x < 2; ++x)
#pragma unroll
              for (int y = 0; y < 4; ++y) acc[x][y] = (f32x4){0.f, 0.f, 0.f, 0.f};
          const bf16* wp = PW + ((size_t)(L * 4 + gi) * 256 + 32 * wave + n) * 256 + 8 * G;
#pragma unroll
          for (int ks = 0; ks < 8; ++ks) { const bf16x8 a0 = *(const bf16x8*)(wp + 32 * ks), a1 = *(const bf16x8*)(wp + 16 * 256 + 32 * ks);
#pragma unroll
              for (int y = 0; y < 4; ++y) { const bf16x8 bf = *(const LAS bf16x8*)(DT + (16 * y + n) * 264 + 32 * ks + 8 * G);
                  acc[0][y] = __builtin_amdgcn_mfma_f32_16x16x32_bf16(a0, bf, acc[0][y], 0, 0, 0); acc[1][y] = __builtin_amdgcn_mfma_f32_16x16x32_bf16(a1, bf, acc[1][y], 0, 0, 0); } }
#pragma unroll
          for (int x = 0; x < 2; ++x) { const int ch = gi * 256 + 32 * wave + 16 * x + 4 * G; const f32x4 sc = *(const f32x4*)(a.pool_scale + L * W_ + ch);
#pragma unroll
              for (int y = 0; y < 4; ++y) { const f32x4 o = acc[x][y] * sc; v2u w; w.x = cvtpk(o[0], o[1]); w.y = cvtpk(o[2], o[3]); *(v2u*)(br + (size_t)(t0 + 16 * y + n) * W_ + ch) = w; } } }
        __syncthreads();
    }
}
__device__ __forceinline__ void ph_merge(const Args& a, int bid, int nb, int tid) {
    const bf16* zg = (const bf16*)(a.ws + WS_ZG); const bf16* P = (const bf16*)(a.ws + WS_P); bf16* mg = (bf16*)(a.ws + WS_MERGED);
    for (size_t i = (size_t)bid * NTHR + tid; i < (size_t)S_ * (D_ / 8); i += (size_t)nb * NTHR) { const int t = (int)(i >> 8), c8 = (int)(i & 255) * 8; float acc[8];
#pragma unroll
        for (int j = 0; j < 8; ++j) acc[j] = 0.f;
#pragma unroll
        for (int g = 0; g < 4; ++g) { const v4u gw = *(const v4u*)(zg + (size_t)t * 4 * D_ + g * D_ + c8), pw = *(const v4u*)(P + (size_t)g * S_ * D_ + (size_t)t * D_ + c8);
            acc[0] += sigmoidf_(bflo(gw.x)) * bflo(pw.x); acc[1] += sigmoidf_(bfhi(gw.x)) * bfhi(pw.x); acc[2] += sigmoidf_(bflo(gw.y)) * bflo(pw.y); acc[3] += sigmoidf_(bfhi(gw.y)) * bfhi(pw.y);
            acc[4] += sigmoidf_(bflo(gw.z)) * bflo(pw.z); acc[5] += sigmoidf_(bfhi(gw.z)) * bfhi(pw.z); acc[6] += sigmoidf_(bflo(gw.w)) * bflo(pw.w); acc[7] += sigmoidf_(bfhi(gw.w)) * bfhi(pw.w); }
        v4u o; o.x = pk2(acc[0], acc[1]); o.y = pk2(acc[2], acc[3]); o.z = pk2(acc[4], acc[5]); o.w = pk2(acc[6], acc[7]);
        *(v4u*)(mg + (size_t)t * D_ + c8) = o; }
}
__device__ __forceinline__ void ph_convact(const Args& a, unsigned char* ws, int L, int bid, int nb, int tid) {
    const bf16* u = (const bf16*)(ws + WS_Z); bf16* act = (bf16*)(ws + WS_P);
    const float* cw = a.ffn_conv_w + (size_t)L * 3 * FF2; const float* cbp = a.ffn_conv_b + (size_t)L * FF2;
    constexpr int G8 = FF / 8, ROWS = 87;
    for (int g = bid * NTHR + tid; g < G8 * 190; g += nb * NTHR) { const int cg = g % G8, strip = g / G8, c8 = cg * 8, r0 = strip * ROWS, r1 = min(r0 + ROWS, S_);
        float wg[3][8], wv[3][8], bg[8], bv[8];
#pragma unroll
        for (int k = 0; k < 3; ++k) { const f32x4 x0 = *(const f32x4*)(cw + k * FF2 + c8), x1 = *(const f32x4*)(cw + k * FF2 + c8 + 4), y0 = *(const f32x4*)(cw + k * FF2 + FF + c8), y1 = *(const f32x4*)(cw + k * FF2 + FF + c8 + 4);
#pragma unroll
            for (int j = 0; j < 4; ++j) { wg[k][j] = x0[j]; wg[k][4 + j] = x1[j]; wv[k][j] = y0[j]; wv[k][4 + j] = y1[j]; } }
        { const f32x4 x0 = *(const f32x4*)(cbp + c8), x1 = *(const f32x4*)(cbp + c8 + 4), y0 = *(const f32x4*)(cbp + FF + c8), y1 = *(const f32x4*)(cbp + FF + c8 + 4);
#pragma unroll
          for (int j = 0; j < 4; ++j) { bg[j] = x0[j]; bg[4 + j] = x1[j]; bv[j] = y0[j]; bv[4 + j] = y1[j]; } }
        const v4u zero = (v4u){0u, 0u, 0u, 0u};
        const bf16* up = u + c8;
#define LDROW(t, G, V) do { if ((t) >= 0 && (t) < S_) { G = *(const v4u*)(up + (size_t)(t) * FF2); V = *(const v4u*)(up + (size_t)(t) * FF2 + FF); } else { G = zero; V = zero; } } while (0)
        v4u gp, vp, gc, vc, gn, vn, g2, v2, g3, v3;
        LDROW(r0 - 1, gp, vp); LDROW(r0, gc, vc); LDROW(r0 + 1, gn, vn); LDROW(r0 + 2, g2, v2); LDROW(r0 + 3, g3, v3);
        for (int t = r0; t < r1; ++t) {
            v4u g4, v4; LDROW(t + 4, g4, v4);
            float gpf[8], gcf[8], gnf[8], vpf[8], vcf[8], vnf[8]; unpack8(gp, gpf); unpack8(gc, gcf); unpack8(gn, gnf); unpack8(vp, vpf); unpack8(vc, vcf); unpack8(vn, vnf);
            float o[8];
#pragma unroll
            for (int j = 0; j < 8; ++j) { const float gt = bg[j] + wg[0][j] * gpf[j] + wg[1][j] * gcf[j] + wg[2][j] * gnf[j], vl = bv[j] + wv[0][j] * vpf[j] + wv[1][j] * vcf[j] + wv[2][j] * vnf[j];
                o[j] = gt * __builtin_amdgcn_rcpf(1.0f + __expf(-gt)) * vl; }
            v4u ow; ow.x = cvtpk(o[0], o[1]); ow.y = cvtpk(o[2], o[3]); ow.z = cvtpk(o[4], o[5]); ow.w = cvtpk(o[6], o[7]);
            *(v4u*)(act + (size_t)t * FF + c8) = ow;
            gp = gc; vp = vc; gc = gn; vc = vn; gn = g2; vn = v2; g2 = g3; v2 = v3; g3 = g4; v3 = v4; }
#undef LDROW
    }
}


__device__ __forceinline__ void ph_convfix(const Args& a, unsigned char* ws, int L, int bid, int nb, int tid) {
    const bf16* RAW = (const bf16*)(ws + WS_RAW); bf16* act = (bf16*)(ws + WS_P);
    const float* cw = a.ffn_conv_w + (size_t)L * 3 * FF2; const float* cbp = a.ffn_conv_b + (size_t)L * FF2;
    for (int i = bid * NTHR + tid; i < 65 * 2 * FF; i += nb * NTHR) { const int c = i % FF, rb = i / FF, b = rb >> 1, r = 256 * b - 1 + (rb & 1);
        if (r < 0 || r >= S_) continue;
        const int pn = c >> 7, cc = c & 127; float ug = cbp[c], uv = cbp[FF + c];
#pragma unroll
        for (int k = 0; k < 3; ++k) { const int t = r + k - 1; if (t < 0 || t >= S_) continue; const int tl = t & 255, ri = tl < 2 ? tl : tl - 252;
            const bf16* rp = RAW + (((size_t)(t >> 8) * 4 + ri) * 43 + pn) * 256 + cc; ug += cw[k * FF2 + c] * bf2f(rp[0]); uv += cw[k * FF2 + FF + c] * bf2f(rp[128]); }
        act[(size_t)r * FF + c] = (bf16)f2bf(siluf_(ug) * uv); }
}
constexpr int NPH = 11;
constexpr int NPHASES = 2 + DEPTH * NPH;
__global__ void __launch_bounds__(NTHR, 2) mk_fwd(Args a) {
    extern __shared__ __attribute__((aligned(16))) unsigned char lds_raw[];
    LAS unsigned char* lds = (LAS unsigned char*)lds_raw;
    const int wave_s = __builtin_amdgcn_readfirstlane((int)threadIdx.x >> 6);
    const int lane = mk_lane_id(), wave = wave_s, tid = wave_s * 64 + lane;
    const int bid = blockIdx.x, nb = gridDim.x;
    unsigned char* ws = a.ws;
    volatile LAS unsigned* MISC = (volatile LAS unsigned*)(lds + MISC_OFF);
    for (int u = tid; u < (LDS_BYTES - MISC_OFF) / 4; u += NTHR) ((LAS unsigned*)(lds + MISC_OFF))[u] = 0u;
    __syncthreads();
    XcdBarrier bar; bar.w0 = 0u; bar.bar = (unsigned*)(ws + WS_CTL) + CW_BAR; bar.x = 0; bar.st = nullptr;
    if (!MK_MULTI_LAUNCH) bar = xcd_barrier_post((unsigned*)(ws + WS_CTL) + CW_BAR, MISC + 8);
    bar.w0 = (wave_s == 0) ? 1u : 0u;
    const int lo = a.ph_lo, hi = a.ph_hi;
#define PH_LOCALS() size_t wsoff_ = 0; asm volatile("" : "+s"(wsoff_)); unsigned char* ws = a.ws + wsoff_;     \
    int tid = wave_s * 64 + mk_lane_id(); asm volatile("" : "+v"(tid)); const int lane = tid & 63, wave = __builtin_amdgcn_readfirstlane(tid >> 6); int bid = blockIdx.x, nb = gridDim.x; asm volatile("" : "+s"(bid), "+s"(nb)); (void)ws; (void)lane; (void)wave; (void)tid
#define IN(k) (lo <= (k) && (k) < hi)
#define SEAM(k) do { if (IN((k) + 1)) xcd_barrier(bar); } while (0)

    if (IN(0)) { PH_LOCALS(); ph_prologue(a, lds, bid, nb, tid, wave, lane); SEAM(0); }
    if (IN(1)) { PH_LOCALS(); ph_resnorm<false>(a, lds, bid, nb, tid, wave, lane, a.x, nullptr, nullptr, (bf16*)(ws + WS_H), 0, 0, 0, 0, 0, 1, 0); SEAM(1); }

    for (int L = 0; L < DEPTH; ++L) {
        const int pb = 2 + L * NPH;
        if (IN(pb + 0)) { PH_LOCALS();
            pg8::Gemm g{(const bf16*)(ws + WS_H), (const bf16*)(ws + WS_WIN) + (size_t)L * NIN * D_, S_, NIN, D_}; pg8::RotOrder so; so.so.init(S_, NIN, nb, bid);
            pg8::EpiZ8 E{(bf16*)(ws + WS_Z), W_, 4, 44, SEG, (bf16*)(ws + WS_ZG), 4 * D_};
            pg8::gemm_phase<pg8::EpiZ8, pg8::RotOrder, true, true>(lds, g, so, E, wave);
            SEAM(pb + 0);
        }
        if (IN(pb + 1)) { PH_LOCALS(); ph_pool(a, ws, lds, L, bid, nb, tid, wave, lane); ph_lru<false>(a, ws, lds, L, bid, nb, tid, wave, lane); ph_hgrn_h1(ws, lds, L, bid, nb, tid, wave, lane);
            ph_attn_prep(ws, bid, nb, tid); ph_attn_vt(ws, lds, bid, nb, tid, wave, lane); SEAM(pb + 1); }
        if (IN(pb + 2)) { PH_LOCALS(); ph_attn_main(ws, bid, nb, wave, lane); ph_lru_carry(ws, lds, bid, tid, wave, lane); ph_hgrn_h2(ws, bid, nb, tid); SEAM(pb + 2); }
        if (IN(pb + 3)) { PH_LOCALS(); ph_hgrn_h3(ws, lds, a.hgrn_onorm + L * W_, L, bid, nb, tid, wave, lane); ph_lru_out(ws, bid, nb, tid); ph_attn_comb(ws, bid, nb, tid); SEAM(pb + 3); }
        if (IN(pb + 4)) { PH_LOCALS();
            pg8::Gemm g{(const bf16*)(ws + WS_BR), (const bf16*)(ws + WS_WBR) + (size_t)L * 4 * D_ * W_, 4 * S_, 4 * D_, W_}; pg8::GateOrder so; so.so.init(S_, D_, nb, bid);
            pg8::EpiGate E{(const unsigned char*)(ws + WS_ZG), (bf16*)(ws + WS_MERGED)};
            pg8::gemm_phase<pg8::EpiGate, pg8::GateOrder, true, true>(lds, g, so, E, wave);
            SEAM(pb + 4);
        }
        if (IN(pb + 5)) { PH_LOCALS();
            pg8::Gemm g{(const bf16*)(ws + WS_MERGED), (const bf16*)(ws + WS_WOUT) + (size_t)L * D_ * D_, S_, D_, D_}; pg8::StaticOrder so; so.init(S_, D_, nb, bid);
            pg8::EpiBf16R E{(bf16*)(ws + WS_Y), D_, 8, 8, 0, nullptr, 0};
            pg8::gemm_phase<pg8::EpiBf16R, pg8::StaticOrder, true, true>(lds, g, so, E, wave);
            SEAM(pb + 5);
        }
        if (IN(pb + 6)) { PH_LOCALS(); ph_resnorm<true>(a, lds, bid, nb, tid, wave, lane, a.x, a.out, (const bf16*)(ws + WS_Y), (bf16*)(ws + WS_H), L, 2, 1, L, 2, 4, 3, L == 0 ? nullptr : (const bf16*)(ws + WS_XR), (bf16*)(ws + WS_XR)); SEAM(pb + 6); }
        if (IN(pb + 7)) { PH_LOCALS();
            pg8::Gemm g{(const bf16*)(ws + WS_H), (const bf16*)(ws + WS_WUP) + (size_t)L * FF2 * D_, S_, FF2, D_}; pg8::StaticOrder so; so.init(S_, FF2, nb, bid);
            pg8::EpiConvAct E{(bf16*)(ws + WS_P), (bf16*)(ws + WS_RAW), (const float*)(ws + WS_CWT) + (size_t)L * 43 * 8 * 128, (LAS float*)(lds + RING_BYTES)};
            pg8::gemm_phase<pg8::EpiConvAct, pg8::StaticOrder, true, true>(lds, g, so, E, wave);
            SEAM(pb + 7);
        }
        if (IN(pb + 8)) { PH_LOCALS(); ph_convfix(a, ws, L, bid, nb, tid); SEAM(pb + 8); }
        if (IN(pb + 9)) { PH_LOCALS();
            pg8::Gemm g{(const bf16*)(ws + WS_P), (const bf16*)(ws + WS_WDN) + (size_t)L * D_ * FF, S_, D_, FF}; pg8::StaticOrder so; so.init(S_, D_, nb, bid);
            pg8::EpiBf16R E{(bf16*)(ws + WS_Y), D_, 8, 8, 0, nullptr, 0};
            pg8::gemm_phase<pg8::EpiBf16R, pg8::StaticOrder, true, true>(lds, g, so, E, wave);
            SEAM(pb + 9);
        }
        if (IN(pb + 10)) { PH_LOCALS(); ph_resnorm<true>(a, lds, bid, nb, tid, wave, lane, a.x, a.out, (const bf16*)(ws + WS_Y), L + 1 < DEPTH ? (bf16*)(ws + WS_H) : nullptr, L, 5, 3, L + 1 < DEPTH ? L + 1 : L, 0, 1, 0, (const bf16*)(ws + WS_XR), L + 1 < DEPTH ? (bf16*)(ws + WS_XR) : nullptr); SEAM(pb + 10); }
    }
#undef IN
#undef SEAM
}

extern "C" void kernel_launch(void* const* d_in, const int* in_sizes, int n_in, void* d_out, int out_size, void* d_ws, size_t ws_size, hipStream_t stream) {
    static int grid = 0;
    if (grid == 0) {
        if (n_in != 24 || in_sizes[0] != S_ * D_ || out_size != S_ * D_ || ws_size < WS_END) { fprintf(stderr, "kernel_launch: unexpected shapes (n_in %d, in0 %d, out %d, ws %zu < %zu); nothing launched\n", n_in, n_in > 0 ? in_sizes[0] : -1, out_size, ws_size, (size_t)WS_END); grid = -1; return; }
        int dev = 0, cus = 0, per_cu = 0;
        if (hipGetDevice(&dev) != hipSuccess || hipDeviceGetAttribute(&cus, hipDeviceAttributeMultiprocessorCount, dev) != hipSuccess) { grid = -1; return; }
        if (hipFuncSetAttribute((const void*)mk_fwd, hipFuncAttributeMaxDynamicSharedMemorySize, LDS_BYTES) != hipSuccess) { fprintf(stderr, "kernel_launch: hipFuncSetAttribute failed\n"); grid = -1; return; }
        if (hipOccupancyMaxActiveBlocksPerMultiprocessor(&per_cu, (const void*)mk_fwd, NTHR, LDS_BYTES) != hipSuccess || per_cu < 1) fprintf(stderr, "kernel_launch: occupancy query reports %d\n", per_cu);
        (void)hipGetLastError();
        grid = cus;
    }
    if (grid < 0) return;
    if (hipMemsetAsync((char*)d_ws + WS_CTL, 0, CTL_ZERO_BYTES, stream) != hipSuccess) return;
    Args a{};
    a.x = (const float*)d_in[0]; a.c = (const float*)d_in[1]; a.pos = (const int*)d_in[2]; a.ada_w = (const float*)d_in[3]; a.ada_b = (const float*)d_in[4]; a.norm_g = (const float*)d_in[5];
    a.w_in = (const float*)d_in[6]; a.hgrn_lb = (const float*)d_in[7]; a.hgrn_onorm = (const float*)d_in[8]; a.lru_conv_w = (const float*)d_in[9]; a.lru_conv_b = (const float*)d_in[10];
    a.lru_wa = (const float*)d_in[11]; a.lru_ba = (const float*)d_in[12]; a.lru_wx = (const float*)d_in[13]; a.lru_bx = (const float*)d_in[14]; a.lru_lambda = (const float*)d_in[15];
    a.pool_w = (const float*)d_in[16]; a.pool_scale = (const float*)d_in[17]; a.w_branch = (const float*)d_in[18]; a.w_out = (const float*)d_in[19]; a.ffn_up = (const float*)d_in[20];
    a.ffn_conv_w = (const float*)d_in[21]; a.ffn_conv_b = (const float*)d_in[22]; a.ffn_down = (const float*)d_in[23];
    a.out = (float*)d_out; a.ws = (unsigned char*)d_ws;
#if MK_MULTI_LAUNCH
    for (int p = 0; p < NPHASES; ++p) { a.ph_lo = p; a.ph_hi = p + 1; hipLaunchKernelGGL(mk_fwd, dim3(grid), dim3(NTHR), LDS_BYTES, stream, a); }
#else
    a.ph_lo = 0; a.ph_hi = NPHASES; hipLaunchKernelGGL(mk_fwd, dim3(grid), dim3(NTHR), LDS_BYTES, stream, a);
#endif
}
```
